# Optimizing an MI355X kernel written in HIP

```python
import jax, jax.numpy as jnp
from jax import lax
import numpy as np

D_MODEL = 2048
BATCH = 2
SEQ = 16384
DEPTH = 2

N_A_LAYERS = DEPTH // 2
N_B_LAYERS = DEPTH - N_A_LAYERS
D_RNN = D_MODEL
N_RNN_BLOCKS = 8
RNN_BLOCK = D_RNN // N_RNN_BLOCKS
CONV_WIDTH = 4
LRU_C = 8.0
N_HEADS = 16
HEAD_DIM = D_MODEL // N_HEADS
Q_BLOCK = 128
FORGET_BIAS_MEAN = 4.0
N_GROUPS = 8
EXPERTS_PER_GROUP = 8
N_EXPERTS = N_GROUPS * EXPERTS_PER_GROUP
TOP_K = 2
D_EXPERT = 512
ROW_BLOCK = 128
EPS = 1e-6

kernel_name = 'hybrid_rglru_fox_hmoe'


def rms_norm(x, gain):
    x32 = x.astype(jnp.float32)
    y = x32 * lax.rsqrt(jnp.mean(x32 * x32, axis=-1, keepdims=True) + EPS)
    return (y * gain.astype(jnp.float32)).astype(x.dtype)


def rglru_mixer(h, w_in, conv_w, conv_b, w_rec, b_rec, w_inp, b_inp, lam, w_out):
    B, S, _ = h.shape
    proj = h @ w_in
    u, y = proj[..., :D_RNN], proj[..., D_RNN:]
    u = lax.conv_general_dilated(u, conv_w[:, None, :], window_strides=(1,),
                                 padding=[(CONV_WIDTH - 1, 0)],
                                 dimension_numbers=('NWC', 'WIO', 'NWC'),
                                 feature_group_count=D_RNN) + conv_b
    ub = u.reshape(B, S, N_RNN_BLOCKS, RNN_BLOCK)
    r = jax.nn.sigmoid(jnp.einsum('bsnc,ncd->bsnd', ub, w_rec).reshape(B, S, D_RNN) + b_rec)
    i = jax.nn.sigmoid(jnp.einsum('bsnc,ncd->bsnd', ub, w_inp).reshape(B, S, D_RNN) + b_inp)
    log_a = (-LRU_C * r.astype(jnp.float32)) * jax.nn.softplus(-lam.astype(jnp.float32))
    a = jnp.exp(log_a)
    b = jnp.sqrt(-jnp.expm1(2.0 * log_a)) * (i * u).astype(jnp.float32)

    def combine(left, right):
        a1, b1 = left
        a2, b2 = right
        return a1 * a2, a2 * b1 + b2

    _, hs = lax.associative_scan(combine, (a, b), axis=1)
    out = hs.astype(h.dtype) * jax.nn.gelu(y)
    return out @ w_out


def shared_kv(x, kv_norm, kv_w, kv_b_forget):
    B, S, _ = x.shape
    HD = N_HEADS * HEAD_DIM
    h = rms_norm(x, kv_norm)
    p = h @ kv_w
    k = p[..., :HD].reshape(B, S, N_HEADS, HEAD_DIM).transpose(0, 2, 1, 3)
    v = p[..., HD:2 * HD].reshape(B, S, N_HEADS, HEAD_DIM).transpose(0, 2, 1, 3)
    f_logit = p[..., 2 * HD:].astype(jnp.float32) + kv_b_forget.astype(jnp.float32)
    cum = jnp.cumsum(jax.nn.log_sigmoid(f_logit), axis=1).transpose(0, 2, 1)
    return k, v, cum


def fox_mixer(h, w_qg, w_o, k, v, cum):
    B, S, _ = h.shape
    HD = N_HEADS * HEAD_DIM
    p = h @ w_qg
    q = p[..., :HD].reshape(B, S, N_HEADS, HEAD_DIM).transpose(0, 2, 1, 3)
    gate = p[..., HD:]
    scale = HEAD_DIM ** -0.5
    k32 = k.astype(jnp.float32)
    v32 = v.astype(jnp.float32)
    key_pos = jnp.arange(S)
    n_blocks = S // Q_BLOCK

    def block(i):
        start = i * Q_BLOCK
        qb = lax.dynamic_slice_in_dim(q, start, Q_BLOCK, axis=2).astype(jnp.float32)
        cb = lax.dynamic_slice_in_dim(cum, start, Q_BLOCK, axis=2)
        s = jnp.einsum('bhqd,bhkd->bhqk', qb, k32) * scale + (cb[..., :, None] - cum[..., None, :])
        q_pos = start + jnp.arange(Q_BLOCK)
        s = jnp.where(key_pos[None, :] <= q_pos[:, None], s, -jnp.inf)
        pr = jax.nn.softmax(s, axis=-1)
        return jnp.einsum('bhqk,bhkd->bhqd', pr, v32)

    o = lax.map(block, jnp.arange(n_blocks))
    o = o.transpose(1, 0, 3, 2, 4).reshape(B, S, HD)
    o = o.astype(h.dtype) * jax.nn.sigmoid(gate)
    return o @ w_o


def hierarchical_moe(h, w_group, b_group, w_router, b_router, w_in, w_out):
    B, S, D = h.shape
    N = B * S
    xf = h.reshape(N, D)
    gl = (xf @ w_group).astype(jnp.float32) + b_group.astype(jnp.float32)
    gp = jax.nn.softmax(gl, axis=-1)
    gp_top, g_idx = lax.top_k(gp, 1)
    el = ((xf @ w_router).astype(jnp.float32) + b_router.astype(jnp.float32)).reshape(N, N_GROUPS, EXPERTS_PER_GROUP)
    el_sel = el[jnp.arange(N), g_idx[:, 0]]
    ep = jax.nn.softmax(el_sel, axis=-1)
    ep_top, e_idx = lax.top_k(ep, TOP_K)
    wts = gp_top * ep_top / jnp.sum(ep_top, axis=-1, keepdims=True)
    eid = (g_idx * EXPERTS_PER_GROUP + e_idx).reshape(-1).astype(jnp.int32)

    A = N * TOP_K
    tok = jnp.repeat(jnp.arange(N, dtype=jnp.int32), TOP_K)
    order = jnp.argsort(eid)
    eid_s = eid[order]
    tok_s = tok[order]
    wt_s = wts.reshape(-1)[order]
    counts = jnp.bincount(eid, length=N_EXPERTS)
    starts = jnp.cumsum(counts) - counts
    padded = (counts + ROW_BLOCK - 1) // ROW_BLOCK * ROW_BLOCK
    pends = jnp.cumsum(padded)
    pstarts = pends - padded
    dest = pstarts[eid_s] + jnp.arange(A, dtype=jnp.int32) - starts[eid_s]
    n_rows = (-(-A // ROW_BLOCK)) * ROW_BLOCK + N_EXPERTS * ROW_BLOCK
    row_tok = jnp.zeros((n_rows,), jnp.int32).at[dest].set(tok_s)
    row_wt = jnp.zeros((n_rows,), wt_s.dtype).at[dest].set(wt_s)
    n_chunks = n_rows // ROW_BLOCK
    chunk_start = jnp.arange(n_chunks, dtype=pends.dtype) * ROW_BLOCK
    chunk_e = jnp.minimum(jnp.searchsorted(pends, chunk_start, side='right'), N_EXPERTS - 1)
    xs = xf[row_tok].reshape(n_chunks, ROW_BLOCK, D)

    def run(args):
        xc, e = args
        gu = xc @ w_in[e]
        return (jax.nn.silu(gu[:, :D_EXPERT]) * gu[:, D_EXPERT:]) @ w_out[e]

    ys = lax.map(run, (xs, chunk_e)).reshape(n_rows, D)
    out = jax.ops.segment_sum(ys * row_wt[:, None].astype(ys.dtype), row_tok, num_segments=N)
    return out.reshape(B, S, D).astype(h.dtype)


def setup_inputs(seed: int = 0) -> dict:
    key = jax.random.key(seed)
    ks = jax.random.split(key, 32)
    f32 = jnp.float32
    HD = N_HEADS * HEAD_DIM

    def nrm(k, shape, scale):
        return jax.random.normal(k, shape, f32) * scale

    x = nrm(ks[0], (BATCH, SEQ, D_MODEL), 1.0)
    a_norm = 1.0 + nrm(ks[1], (N_A_LAYERS, D_MODEL), 0.01)
    a_w_in = nrm(ks[2], (N_A_LAYERS, D_MODEL, 2 * D_RNN), D_MODEL ** -0.5)
    a_conv_w = nrm(ks[3], (N_A_LAYERS, CONV_WIDTH, D_RNN), CONV_WIDTH ** -0.5)
    a_conv_b = nrm(ks[4], (N_A_LAYERS, D_RNN), 0.01)
    a_w_rec = nrm(ks[5], (N_A_LAYERS, N_RNN_BLOCKS, RNN_BLOCK, RNN_BLOCK), RNN_BLOCK ** -0.5)
    a_b_rec = nrm(ks[6], (N_A_LAYERS, D_RNN), 0.01)
    a_w_inp = nrm(ks[7], (N_A_LAYERS, N_RNN_BLOCKS, RNN_BLOCK, RNN_BLOCK), RNN_BLOCK ** -0.5)
    a_b_inp = nrm(ks[8], (N_A_LAYERS, D_RNN), 0.01)
    a_base = jax.random.uniform(ks[9], (N_A_LAYERS, D_RNN), f32, 0.9, 0.999)
    s = a_base ** (1.0 / LRU_C)
    a_lambda = jnp.log(s) - jnp.log1p(-s)
    a_w_out = nrm(ks[10], (N_A_LAYERS, D_RNN, D_MODEL), D_RNN ** -0.5)
    kv_norm = 1.0 + nrm(ks[11], (D_MODEL,), 0.01)
    kv_w = jnp.concatenate([nrm(ks[12], (D_MODEL, 2 * HD), D_MODEL ** -0.5),
                            nrm(ks[13], (D_MODEL, N_HEADS), 0.1 * D_MODEL ** -0.5)], axis=1)
    kv_b_forget = FORGET_BIAS_MEAN + nrm(ks[14], (N_HEADS,), 0.5)
    b_norm = 1.0 + nrm(ks[15], (N_B_LAYERS, D_MODEL), 0.01)
    b_w_qg = nrm(ks[16], (N_B_LAYERS, D_MODEL, 2 * HD), D_MODEL ** -0.5)
    b_w_o = nrm(ks[17], (N_B_LAYERS, HD, D_MODEL), HD ** -0.5)
    m_norm = 1.0 + nrm(ks[18], (DEPTH, D_MODEL), 0.01)
    m_w_group = nrm(ks[19], (DEPTH, D_MODEL, N_GROUPS), D_MODEL ** -0.5)
    m_b_group = nrm(ks[20], (DEPTH, N_GROUPS), 0.01)
    m_w_router = nrm(ks[21], (DEPTH, D_MODEL, N_EXPERTS), D_MODEL ** -0.5)
    m_b_router = nrm(ks[22], (DEPTH, N_EXPERTS), 0.01)
    m_w_in = nrm(ks[23], (DEPTH, N_EXPERTS, D_MODEL, 2 * D_EXPERT), D_MODEL ** -0.5)
    m_w_out = nrm(ks[24], (DEPTH, N_EXPERTS, D_EXPERT, D_MODEL), D_EXPERT ** -0.5)
    final_norm = 1.0 + nrm(ks[25], (D_MODEL,), 0.01)
    return {'x': x, 'a_norm': a_norm, 'a_w_in': a_w_in, 'a_conv_w': a_conv_w, 'a_conv_b': a_conv_b,
            'a_w_rec': a_w_rec, 'a_b_rec': a_b_rec, 'a_w_inp': a_w_inp, 'a_b_inp': a_b_inp,
            'a_lambda': a_lambda, 'a_w_out': a_w_out, 'kv_norm': kv_norm, 'kv_w': kv_w,
            'kv_b_forget': kv_b_forget, 'b_norm': b_norm, 'b_w_qg': b_w_qg, 'b_w_o': b_w_o,
            'm_norm': m_norm, 'm_w_group': m_w_group, 'm_b_group': m_b_group,
            'm_w_router': m_w_router, 'm_b_router': m_b_router, 'm_w_in': m_w_in,
            'm_w_out': m_w_out, 'final_norm': final_norm}


def reference(x, a_norm, a_w_in, a_conv_w, a_conv_b, a_w_rec, a_b_rec, a_w_inp, a_b_inp,
              a_lambda, a_w_out, kv_norm, kv_w, kv_b_forget, b_norm, b_w_qg, b_w_o,
              m_norm, m_w_group, m_b_group, m_w_router, m_b_router, m_w_in, m_w_out,
              final_norm):
    k = v = cum = None
    for layer in range(DEPTH):
        if layer < N_A_LAYERS:
            i = layer
            x = x + rglru_mixer(rms_norm(x, a_norm[i]), a_w_in[i], a_conv_w[i], a_conv_b[i],
                                a_w_rec[i], a_b_rec[i], a_w_inp[i], a_b_inp[i],
                                a_lambda[i], a_w_out[i])
        else:
            j = layer - N_A_LAYERS
            x = x + fox_mixer(rms_norm(x, b_norm[j]), b_w_qg[j], b_w_o[j], k, v, cum)
        x = x + hierarchical_moe(rms_norm(x, m_norm[layer]), m_w_group[layer], m_b_group[layer],
                                 m_w_router[layer], m_b_router[layer], m_w_in[layer], m_w_out[layer])
        if layer == N_A_LAYERS - 1:
            k, v, cum = shared_kv(x, kv_norm, kv_w, kv_b_forget)
    return rms_norm(x, final_norm)
```

```cpp
#include <hip/hip_runtime.h>
#include <cstdio>
#include <cstdint>


#ifndef MK_PER_PHASE
#define MK_PER_PHASE 0
#endif

#define LAS __attribute__((address_space(3)))
#define GAS __attribute__((address_space(1)))
typedef unsigned short bf16_t;
typedef short bf16x8 __attribute__((ext_vector_type(8)));
typedef short s16x4 __attribute__((ext_vector_type(4)));
typedef float f32x4 __attribute__((ext_vector_type(4)));
typedef float f32x2 __attribute__((ext_vector_type(2)));
typedef float f32x16 __attribute__((ext_vector_type(16)));
typedef unsigned u32x4 __attribute__((ext_vector_type(4)));
typedef unsigned u32x2 __attribute__((ext_vector_type(2)));

constexpr int NB = 2, SEQ = 16384, DM = 2048, NTOK = NB * SEQ;
constexpr int NHEAD = 16, HDIM = 128;
constexpr int NEXP = 64, DEXP = 512, LCAP = 65536;
constexpr int NKVQG = 8448;
constexpr float RMS_EPS = 1e-6f;
constexpr int NWAVES = 8, NTHREADS = 512;

constexpr size_t MiB = (size_t)1 << 20;
constexpr size_t WS_CTL = 0, CTL_ZERO_BYTES = 1 * MiB;
constexpr size_t WS_WIN = 1 * MiB, WS_WG = 17 * MiB, WS_WOUT = 19 * MiB, WS_WKVQG = 27 * MiB, WS_WO = 60 * MiB, WS_WR = 68 * MiB;
constexpr size_t WS_WMI = 70 * MiB, WS_WMO = 582 * MiB, WS_LVEC = 838 * MiB;
constexpr size_t WS_H0 = 839 * MiB, WS_U = 967 * MiB, WS_GY = 1095 * MiB, WS_UC = 1223 * MiB, WS_LA = 1351 * MiB, WS_BB = 1479 * MiB, WS_HS = 1607 * MiB;
constexpr size_t WS_X1B = 1735 * MiB, WS_PART = 1863 * MiB, WS_CARRY = 1867 * MiB;
constexpr size_t WS_ASG = 1871 * MiB, WS_TOKL = 1873 * MiB, WS_RSL = 1889 * MiB, WS_ACT = 1905 * MiB, WS_YB = 1985 * MiB;
constexpr size_t WS_X2 = 2305 * MiB, WS_XN2 = 2561 * MiB;
constexpr size_t WS_KB = 2689 * MiB, WS_VB = 2817 * MiB, WS_QB = 2945 * MiB, WS_SG = 3073 * MiB, WS_OG = 3201 * MiB;
constexpr size_t WS_FLOG = 3329 * MiB, WS_CUM = 3331 * MiB;
constexpr size_t WS_X3B = 3333 * MiB, WS_PART3 = 3461 * MiB;
constexpr size_t WS_MOE1 = 3465 * MiB, MOE_LAYER_STRIDE = WS_MOE1 - WS_ASG;
constexpr size_t WS_END = WS_MOE1 + 434 * MiB;
constexpr int CW_BAR = 4096;
constexpr int CW_GCNT = 8192;
constexpr int CW_NRM = 12288;
constexpr int CW_AQ = 13440;

constexpr int RING_BYTES = 131072;
constexpr int MISC_OFF = 139264;
constexpr int LDS_BYTES = 147456;
constexpr int MI_BAR = 0, MI_TSTART = 16, MI_CNT = 96;

__device__ __forceinline__ unsigned cvt_pk_bf16(float lo, float hi) { unsigned r; asm volatile("s_nop 0\n\tv_cvt_pk_bf16_f32 %0, %1, %2" : "=v"(r) : "v"(lo), "v"(hi)); return r; }
__device__ __forceinline__ float bflo(unsigned w) { return __uint_as_float(w << 16); }
__device__ __forceinline__ float bfhi(unsigned w) { return __uint_as_float(w & 0xffff0000u); }
__device__ __forceinline__ float bf2f(bf16_t h) { return __uint_as_float(((unsigned)h) << 16); }
__device__ __forceinline__ float fast_exp(float x) { return __builtin_amdgcn_exp2f(x * 1.4426950408889634f); }
__device__ __forceinline__ float fast_sigmoid(float x) { return __builtin_amdgcn_rcpf(1.0f + fast_exp(-x)); }
__device__ __forceinline__ float wave_sum(float v) {
#pragma unroll
    for (int o = 1; o < 64; o <<= 1) v += __shfl_xor(v, o);
    return v;
}
#define LDS_WAIT() asm volatile("s_waitcnt lgkmcnt(0)" ::: "memory")
#define VM_WAIT() asm volatile("s_waitcnt vmcnt(0)" ::: "memory")

#define XB_TMO      128
#define XB_XCNT(j)  (256  + 64 * (j))
#define XB_XSUB(j)  (1280 + 64 * (j))
#define XB_XGEN(j)  (2304 + 64 * (j))
#define XB_TOP      3328
#define XB_TOPGEN   3392
#define XCD_BAR_WORDS 3456
#define XB_SPIN_CAP (1u << 18)

__device__ __forceinline__ unsigned xb_ld(unsigned* p)              { return __hip_atomic_load(p, __ATOMIC_RELAXED, __HIP_MEMORY_SCOPE_AGENT); }
__device__ __forceinline__ unsigned xb_add(unsigned* p, unsigned v) { return __hip_atomic_fetch_add(p, v, __ATOMIC_RELAXED, __HIP_MEMORY_SCOPE_AGENT); }
__device__ __forceinline__ unsigned xb_xcc_id() { return (unsigned)__builtin_amdgcn_s_getreg((3 << 11) | 20) & 0xFu; }
#define XB_SPIN(cond, bar) do { unsigned _sp = 0; while (cond) { __builtin_amdgcn_s_sleep(1); \
    if ((++_sp & 255u) == 0u) { if (xb_ld(&(bar)[XB_TMO])) break; if (_sp > XB_SPIN_CAP) { atomicAdd(&(bar)[XB_TMO], 1u); break; } } } } while (0)

struct XcdBarrier { unsigned* bar; unsigned x; volatile LAS unsigned* st; };

__device__ __forceinline__ XcdBarrier xcd_barrier_post(unsigned* bar, volatile LAS unsigned* st) {
    XcdBarrier b; b.bar = bar; b.x = xb_xcc_id(); b.st = st;
    if (threadIdx.x == 0) (void)xb_add(&bar[XB_XCNT(b.x)], 1u);
    return b;
}
__device__ __forceinline__ void xcd_barrier_complete(unsigned* bar, unsigned x, unsigned& nloc, unsigned& nx) {
    const unsigned G = gridDim.x * gridDim.y * gridDim.z;
    unsigned sum, cnt, mine, sp = 0u;
    for (;;) {
        sum = 0u; cnt = 0u; mine = 0u;
#pragma unroll
        for (unsigned j = 0; j < 16; ++j) { const unsigned c = xb_ld(&bar[XB_XCNT(j)]); sum += c; cnt += (c > 0u) ? 1u : 0u; mine = (j == x) ? c : mine; }
        if (sum == G) break;
        __builtin_amdgcn_s_sleep(1);
        if ((++sp & 255u) == 0u) { if (xb_ld(&bar[XB_TMO])) break; if (sp > XB_SPIN_CAP) { atomicAdd(&bar[XB_TMO], 1u); break; } }
    }
    nloc = mine > 0u ? mine : 1u; nx = cnt > 0u ? cnt : 1u;
}
__device__ __forceinline__ void xcd_barrier(const XcdBarrier& b) {
    asm volatile("s_waitcnt vmcnt(0)" ::: "memory");
    __syncthreads();
    if (threadIdx.x == 0) {
        unsigned* bar = b.bar;
        __builtin_amdgcn_s_waitcnt(0);
        unsigned nloc = b.st[0], nx = b.st[1];
        if (nloc == 0u) { xcd_barrier_complete(bar, b.x, nloc, nx); b.st[0] = nloc; b.st[1] = nx; }
        const unsigned old = xb_add(&bar[XB_XSUB(b.x)], 1u);
        const unsigned gen = old / nloc;
        if (old + 1u == (gen + 1u) * nloc) {
            __builtin_amdgcn_fence(__ATOMIC_RELEASE, "agent");
            asm volatile("s_waitcnt vmcnt(0)" ::: "memory");
            const unsigned og = xb_add(&bar[XB_TOP], 1u);
            const unsigned tg = og / nx;
            if (og + 1u == (tg + 1u) * nx) xb_add(&bar[XB_TOPGEN], 1u);
            else XB_SPIN(xb_ld(&bar[XB_TOPGEN]) == tg, bar);
            __builtin_amdgcn_fence(__ATOMIC_ACQUIRE, "agent");
            xb_add(&bar[XB_XGEN(b.x)], 1u);
            asm volatile("s_waitcnt vmcnt(0)" ::: "memory");
        } else {
            XB_SPIN(xb_ld(&bar[XB_XGEN(b.x)]) == gen, bar);
            __builtin_amdgcn_fence(__ATOMIC_ACQUIRE, "agent");
            asm volatile("s_waitcnt vmcnt(0)" ::: "memory");
        }
    }
    __syncthreads();
}

namespace pg8 {
constexpr int BM = 256, BK = 64, HALF = 128, HTB = HALF * BK * 2, STAGE_BYTES = 8 * HTB, NXCD = 8, WGM = 8;
__host__ __device__ __forceinline__ int lds_byte(int r, int c) { const int st = (r >> 4) * 2 + (c >> 5), rr = r & 15, cc = c & 31, ob = rr * 64 + cc * 2; return st * 1024 + (ob ^ (((ob >> 9) & 1) << 5)); }
__host__ __device__ __forceinline__ void stage_rc(int b, int& R, int& C) { const int st = b / 1024, sb = b % 1024, swz = sb ^ (((sb >> 9) & 1) << 5); R = (st >> 1) * 16 + swz / 64; C = (st & 1) * 32 + (swz % 64) / 2; }
__host__ __device__ __forceinline__ int perm32(int rho) { const int n = rho >> 4, i = rho & 15; return 8 * (i >> 2) + 4 * n + (i & 3); }

struct Unit { int a0, acol, b0, pm, pn, e, nv, prow0; };
struct Gemm { const bf16_t* A; const bf16_t* Bt; int lda, ldb, K; const int* glist; const bf16_t* R; const bf16_t* I; };

__device__ __forceinline__ int xcd_remap(int L, int nwg) { const int q = nwg / NXCD, r = nwg % NXCD, xcd = L % NXCD, off = L / NXCD; return (xcd < r ? xcd * (q + 1) : r * (q + 1) + (xcd - r) * q) + off; }
struct GridOrder {
    int nM, nN, nwg, G, c;
    __device__ __forceinline__ void init(int nM_, int nN_, int G_, int c_) { nM = nM_; nN = nN_; nwg = nM * nN; G = G_; c = c_; }
    __device__ __forceinline__ bool tile(int i, int& pm, int& pn) const {
        const long L = (long)i * G + c; if (L >= nwg) return false;
        const int wgid = xcd_remap((int)L, nwg);
        const int nig = WGM * nN, gid = wgid / nig, fm = gid * WGM, gsz = (nM - fm) < WGM ? (nM - fm) : WGM;
        pm = fm + ((wgid % nig) % gsz); pn = (wgid % nig) / gsz; return true;
    }
};
struct DenseSched { GridOrder o;
    __device__ __forceinline__ bool next(int i, Unit& u) const { int pm, pn; if (!o.tile(i, pm, pn)) return false; u.pm = pm; u.pn = pn; u.a0 = pm * BM; u.acol = 0; u.b0 = pn * BM; u.e = 0; u.nv = BM; u.prow0 = pm * BM; return true; } };
struct GateSched { GridOrder o;
    __device__ __forceinline__ bool next(int i, Unit& u) const { int pm, pn; if (!o.tile(i, pm, pn)) return false; u.pm = pm; u.pn = pn; u.a0 = pm * BM; u.acol = (pn >> 1) * 256; u.b0 = pn * BM; u.e = 0; u.nv = BM; u.prow0 = pm * BM; return true; } };
template <bool GATHER> struct MoeSched {
    const LAS int* tstart; const LAS int* cnt; int NTN, G, c, nunits, brows;
    __device__ __forceinline__ bool next(int i, Unit& u) const {
        const long L = (long)i * G + c; if (L >= nunits) return false;
        const int wgid = xcd_remap((int)L, nunits);
        int lane = threadIdx.x & 63; asm volatile("" : "+v"(lane));
        const int uend = tstart[lane + 1] * NTN;
        const int e = __builtin_popcountll(__ballot(uend <= wgid));
        const int ts = tstart[e], nte = tstart[e + 1] - ts, idx = wgid - ts * NTN;
        const int mt = idx % nte, nt = idx / nte;
        const int ce = cnt[e];
        u.e = e; u.pm = mt; u.pn = nt; u.prow0 = (ts + mt) * BM; u.nv = (ce - mt * BM) < BM ? (ce - mt * BM) : BM;
        u.a0 = GATHER ? (e * LCAP + mt * BM) : u.prow0; u.acol = 0; u.b0 = e * brows + nt * BM;
        return true;
    }
};

template <class Epi, class Sched, bool GATHER, bool ALIGN_EPI>
__device__ __forceinline__ void gemm_phase(LAS unsigned char* lds, const Gemm g, const Sched& S, const Epi& E) {
    int tid = threadIdx.x; asm volatile("" : "+v"(tid));
    const int wid = __builtin_amdgcn_readfirstlane(tid >> 6), lane = tid & 63, wr = wid >> 2, wc = wid & 3, fr = lane & 15, fq = lane >> 4;
    const int K = g.K, nt = K / BK, ntot = nt + (Epi::RESK ? BM / BK : 0);
    int Rr[2], Cc[2];
    unsigned voffB[2];
#pragma unroll
    for (int i = 0; i < 2; ++i) { int R, C; stage_rc(tid * 16 + i * 8192, R, C); Rr[i] = R; Cc[i] = C; const int Rb = Epi::PERM ? ((Epi::WIDE ? (R >> 5) * 64 : (R & ~31)) + perm32(R & 31)) : R;
        voffB[i] = (unsigned)(Rb * g.ldb + C) * 2u; }
    const size_t kstep = (size_t)(BK * 2);
    const size_t hstepB = (size_t)(Epi::WIDE ? 32 : HALF) * g.ldb * 2;
    const unsigned ldsw = (unsigned)wid * 1024u;
    const int aoff = lds_byte(wr * 64 + fr, fq * 8), boff = lds_byte(wc * 32 + fr, fq * 8);
#define PG8_SA(b, h) (((b) * 2 + (h)) * HTB)
#define PG8_SB(b, h) ((4 + (b) * 2 + (h)) * HTB)
#define PG8_STAGE_B(bufoff, gbase) do { _Pragma("unroll") for (int _i = 0; _i < 2; ++_i) \
        __builtin_amdgcn_global_load_lds((const unsigned*)((const char*)(gbase) + voffB[_i]), (LAS unsigned*)(lds + (bufoff) + ldsw + _i * 8192), 16, 0, 0); } while (0)
#define PG8_STAGE_A(bufoff, gbase, vo, h) do { _Pragma("unroll") for (int _i = 0; _i < 2; ++_i) \
        __builtin_amdgcn_global_load_lds((const unsigned*)((const char*)(gbase) + (vo)[h][_i]), (LAS unsigned*)(lds + (bufoff) + ldsw + _i * 8192), 16, 0, 0); } while (0)
#define PG8_LDA(dst, b, h) do { _Pragma("unroll") for (int m = 0; m < 4; ++m) _Pragma("unroll") for (int k = 0; k < 2; ++k) dst[m][k] = *(const LAS bf16x8*)(lds + PG8_SA(b, h) + aoff + m * 2048 + k * 1024); } while (0)
#define PG8_LDB(dst, b, h) do { _Pragma("unroll") for (int n = 0; n < 2; ++n) _Pragma("unroll") for (int k = 0; k < 2; ++k) dst[n][k] = *(const LAS bf16x8*)(lds + PG8_SB(b, h) + boff + n * 2048 + k * 1024); } while (0)
#define PG8_MMA(ai, bj, At, Bt) do { __builtin_amdgcn_s_setprio(1); _Pragma("unroll") for (int m = 0; m < 4; ++m) _Pragma("unroll") for (int n = 0; n < 2; ++n) _Pragma("unroll") for (int k = 0; k < 2; ++k) \
        acc[ai][bj][m][n] = __builtin_amdgcn_mfma_f32_16x16x32_bf16(Bt[n][k], At[m][k], acc[ai][bj][m][n], 0, 0, 0); __builtin_amdgcn_s_setprio(0); } while (0)
#define PG8_WAIT_V(n) asm volatile("s_waitcnt vmcnt(" #n ")" ::: "memory")
#define PG8_WAIT_L(n) asm volatile("s_waitcnt lgkmcnt(" #n ")" ::: "memory")
#define PG8_BAR __builtin_amdgcn_s_barrier()
#define PG8_SCHED __builtin_amdgcn_sched_barrier(0)
#define PG8_AOFFS(vo, u) do { _Pragma("unroll") for (int _h = 0; _h < 2; ++_h) _Pragma("unroll") for (int _i = 0; _i < 2; ++_i) { const int _r = _h * HALF + Rr[_i]; \
        if (GATHER) { int _t = g.glist[(u).a0 + _r]; _t = (_r < (u).nv) ? _t : 0; (vo)[_h][_i] = (unsigned)(_t * g.lda + Cc[_i]) * 2u; } \
        else (vo)[_h][_i] = (unsigned)(_r * g.lda + Cc[_i]) * 2u; } } while (0)
#define PG8_ABASE(u) ((const char*)g.A + (GATHER ? (size_t)(u).acol * 2 : ((size_t)(u).a0 * g.lda + (u).acol) * 2))
    Unit cur, nxt; int ui = 0;
    if (!S.next(0, cur)) return;
    f32x4 acc[2][2][4][2];
#pragma unroll
    for (int a = 0; a < 2; ++a)
#pragma unroll
        for (int b = 0; b < 2; ++b)
#pragma unroll
            for (int m = 0; m < 4; ++m)
#pragma unroll
                for (int n = 0; n < 2; ++n) acc[a][b][m][n] = (f32x4){0.f, 0.f, 0.f, 0.f};
    bf16x8 At[4][2], B0[2][2], B1[2][2];
    unsigned vA[2][2], vN[2][2];
    PG8_AOFFS(vA, cur);
    const char* cA = PG8_ABASE(cur); const char* cB = (const char*)g.Bt + (size_t)cur.b0 * g.ldb * 2;
    PG8_STAGE_B(PG8_SB(0, 0), cB); PG8_STAGE_B(PG8_SB(0, 1), cB + hstepB); PG8_STAGE_A(PG8_SA(0, 0), cA, vA, 0); PG8_STAGE_A(PG8_SA(0, 1), cA, vA, 1);
    if (wr == 1) PG8_BAR;
    PG8_WAIT_V(2); PG8_BAR;
    PG8_STAGE_B(PG8_SB(1, 0), cB + kstep); PG8_STAGE_A(PG8_SA(1, 0), cA + kstep, vA, 0); PG8_STAGE_B(PG8_SB(1, 1), cB + hstepB + kstep);
    PG8_WAIT_V(6); PG8_BAR;
    for (;;) {
        const bool has_next = S.next(ui + 1, nxt);
        const char* nA = cA; const char* nB = cB;
        if (has_next) { nA = PG8_ABASE(nxt); nB = (const char*)g.Bt + (size_t)nxt.b0 * g.ldb * 2; }
        if (GATHER) { if (has_next) { PG8_AOFFS(vN, nxt); } else {
#pragma unroll
            for (int _h = 0; _h < 2; ++_h)
#pragma unroll
                for (int _i = 0; _i < 2; ++_i) vN[_h][_i] = vA[_h][_i]; } }
#pragma nounroll
        for (int t = 0; t < ntot; t += 2) {
            const bool last = (t == ntot - 2);
            const char* a1; const char* a2; const char* b2;
            if constexpr (Epi::RESK) {
                const char* rA = (const char*)g.R + ((size_t)cur.prow0 * g.lda + (size_t)cur.pn * BM) * 2;
                a1 = (t < nt ? cA + (size_t)t * kstep : rA + (size_t)(t - nt) * kstep) + kstep;
                a2 = last ? nA : (t + 2 < nt ? cA + (size_t)(t + 2) * kstep : rA + (size_t)(t + 2 - nt) * kstep);
                b2 = last ? nB : (t + 2 < nt ? cB + (size_t)(t + 2) * kstep : (const char*)g.I + (size_t)(t + 2 - nt) * kstep);
            } else {
                a1 = cA + (size_t)(t + 1) * kstep;
                a2 = last ? nA : cA + (size_t)(t + 2) * kstep; b2 = last ? nB : cB + (size_t)(t + 2) * kstep; }
            const char* a3 = a2 + kstep; const char* b3 = b2 + kstep;
            unsigned v2[2][2];
#pragma unroll
            for (int _h = 0; _h < 2; ++_h)
#pragma unroll
                for (int _i = 0; _i < 2; ++_i) v2[_h][_i] = (GATHER && last) ? vN[_h][_i] : vA[_h][_i];
            PG8_LDB(B0, 0, 0); PG8_LDB(B1, 0, 1); PG8_SCHED; PG8_LDA(At, 0, 0); PG8_STAGE_A(PG8_SA(1, 1), a1, vA, 1);
            PG8_WAIT_V(8); PG8_WAIT_L(0); PG8_BAR; PG8_MMA(0, 0, At, B0); PG8_MMA(0, 1, At, B1); PG8_BAR; PG8_SCHED;
            PG8_LDA(At, 0, 1); PG8_STAGE_B(PG8_SB(0, 0), b2); PG8_STAGE_B(PG8_SB(0, 1), b2 + hstepB); PG8_STAGE_A(PG8_SA(0, 0), a2, v2, 0);
            PG8_WAIT_V(8); PG8_WAIT_L(0); PG8_BAR; PG8_MMA(1, 0, At, B0); PG8_MMA(1, 1, At, B1); PG8_BAR; PG8_SCHED;
            PG8_LDB(B0, 1, 0); PG8_LDB(B1, 1, 1); PG8_SCHED; PG8_LDA(At, 1, 0); PG8_STAGE_A(PG8_SA(0, 1), a2, v2, 1);
            PG8_WAIT_V(8); PG8_WAIT_L(0); PG8_BAR; PG8_MMA(0, 0, At, B0); PG8_MMA(0, 1, At, B1); PG8_BAR; PG8_SCHED;
            PG8_LDA(At, 1, 1); PG8_STAGE_B(PG8_SB(1, 0), b3); PG8_STAGE_B(PG8_SB(1, 1), b3 + hstepB); PG8_STAGE_A(PG8_SA(1, 0), a3, v2, 0);
            PG8_WAIT_V(8); PG8_WAIT_L(0); PG8_BAR; PG8_MMA(1, 0, At, B0); PG8_MMA(1, 1, At, B1); PG8_BAR; PG8_SCHED;
        }
        if constexpr (ALIGN_EPI) { if (wr == 0) PG8_BAR; }
        if constexpr (!Epi::AFTER_DRAIN) { E(acc, cur, wr, wc, fr, fq); }
        if (!has_next) break;
#pragma unroll
        for (int a = 0; a < 2; ++a)
#pragma unroll
            for (int b = 0; b < 2; ++b)
#pragma unroll
                for (int m = 0; m < 4; ++m)
#pragma unroll
                    for (int n = 0; n < 2; ++n) acc[a][b][m][n] = (f32x4){0.f, 0.f, 0.f, 0.f};
        cur = nxt; cA = nA; cB = nB; ++ui;
        if (GATHER) {
#pragma unroll
            for (int _h = 0; _h < 2; ++_h)
#pragma unroll
                for (int _i = 0; _i < 2; ++_i) vA[_h][_i] = vN[_h][_i]; }
        if constexpr (ALIGN_EPI) { if (wr == 1) PG8_BAR; }
    }
    PG8_WAIT_V(0);
    if constexpr (!ALIGN_EPI) { if (wr == 0) PG8_BAR; }
    PG8_BAR;
    if constexpr (Epi::AFTER_DRAIN) { E.fused(acc, cur, wr, wc, fr, fq, lds, wid, lane); }
#undef PG8_SA
#undef PG8_SB
#undef PG8_STAGE_A
#undef PG8_STAGE_B
#undef PG8_LDA
#undef PG8_LDB
#undef PG8_MMA
#undef PG8_WAIT_V
#undef PG8_WAIT_L
#undef PG8_BAR
#undef PG8_SCHED
#undef PG8_AOFFS
#undef PG8_ABASE
}

__device__ __forceinline__ u32x4 pack8(const f32x4& a, const f32x4& b) { u32x4 w; w.x = cvt_pk_bf16(a[0], a[1]); w.y = cvt_pk_bf16(a[2], a[3]); w.z = cvt_pk_bf16(b[0], b[1]); w.w = cvt_pk_bf16(b[2], b[3]); return w; }
__device__ __forceinline__ float gelu_tanh(float y) {
    const float t = y * (1.0f + 0.044715f * y * y);
    return y * __builtin_amdgcn_rcpf(1.0f + __builtin_amdgcn_exp2f(t * (-2.0f * 0.7978845608028654f * 1.4426950408889634f)));
}

struct EpiInProj {
    static constexpr bool PERM = true, AFTER_DRAIN = false, RESK = false, WIDE = false;
    bf16_t* U; bf16_t* GY; const float* RS;
    __device__ __forceinline__ void operator()(const f32x4 (&acc)[2][2][4][2], const Unit& u, int wr, int wc, int fr, int fq) const {
        const bool isy = u.pn >= 8; bf16_t* base = isy ? GY : U; const int colt = (isy ? u.pn - 8 : u.pn) * BM + wc * 32 + 8 * fq;
        float rs[2][4];
#pragma unroll
        for (int ai = 0; ai < 2; ++ai)
#pragma unroll
            for (int m = 0; m < 4; ++m) rs[ai][m] = RS[u.pm * BM + ai * HALF + wr * 64 + m * 16 + fr];
#pragma unroll
        for (int ai = 0; ai < 2; ++ai)
#pragma unroll
            for (int m = 0; m < 4; ++m) { bf16_t* rowp = base + (size_t)(u.pm * BM + ai * HALF + wr * 64 + m * 16 + fr) * DM + colt;
#pragma unroll
                for (int bj = 0; bj < 2; ++bj) { f32x4 v0 = acc[ai][bj][m][0] * rs[ai][m], v1 = acc[ai][bj][m][1] * rs[ai][m];
                    if (isy) {
#pragma unroll
                        for (int j = 0; j < 4; ++j) { v0[j] = gelu_tanh(v0[j]); v1[j] = gelu_tanh(v1[j]); } }
                    *(u32x4*)(rowp + bj * HALF) = pack8(v0, v1); } }
    }
};
struct EpiGates {
    static constexpr bool PERM = true, AFTER_DRAIN = false, RESK = false, WIDE = false;
    const bf16_t* UC; bf16_t* LA; bf16_t* BB; const float* Lv; const float* brec; const float* binp;
    __device__ __forceinline__ void operator()(const f32x4 (&acc)[2][2][4][2], const Unit& u, int wr, int wc, int fr, int fq) const {
        const int cb = (u.pn >> 1) * 256 + (u.pn & 1) * 128 + wc * 32 + 8 * fq;
        u32x4 uw[2][4];
#pragma unroll
        for (int ai = 0; ai < 2; ++ai)
#pragma unroll
            for (int m = 0; m < 4; ++m) uw[ai][m] = *(const u32x4*)(UC + (size_t)(u.pm * BM + ai * HALF + wr * 64 + m * 16 + fr) * DM + cb);
#pragma unroll
        for (int ai = 0; ai < 2; ++ai)
#pragma unroll
            for (int m = 0; m < 4; ++m) { const size_t off = (size_t)(u.pm * BM + ai * HALF + wr * 64 + m * 16 + fr) * DM + cb;
                u32x4 lw, bw;
#pragma unroll
                for (int n = 0; n < 2; ++n) {
                    const f32x4 Lc = *(const f32x4*)(Lv + cb + 4 * n), rb = *(const f32x4*)(brec + cb + 4 * n), ib = *(const f32x4*)(binp + cb + 4 * n);
                    const unsigned ux = n ? uw[ai][m].z : uw[ai][m].x, uy = n ? uw[ai][m].w : uw[ai][m].y;
                    const float uu[4] = {bflo(ux), bfhi(ux), bflo(uy), bfhi(uy)};
                    float la[4], bb[4];
#pragma unroll
                    for (int j = 0; j < 4; ++j) {
                        const float r = fast_sigmoid(acc[ai][0][m][n][j] + rb[j]), ig = fast_sigmoid(acc[ai][1][m][n][j] + ib[j]);
                        const float l = r * Lc[j];
                        const float a2 = fast_exp(2.0f * l);
                        la[j] = l; bb[j] = __builtin_amdgcn_sqrtf(fmaxf(1.0f - a2, 0.0f)) * ig * uu[j]; }
                    if (n == 0) { lw.x = cvt_pk_bf16(la[0], la[1]); lw.y = cvt_pk_bf16(la[2], la[3]); bw.x = cvt_pk_bf16(bb[0], bb[1]); bw.y = cvt_pk_bf16(bb[2], bb[3]); }
                    else        { lw.z = cvt_pk_bf16(la[0], la[1]); lw.w = cvt_pk_bf16(la[2], la[3]); bw.z = cvt_pk_bf16(bb[0], bb[1]); bw.w = cvt_pk_bf16(bb[2], bb[3]); } }
                *(u32x4*)(LA + off) = lw; *(u32x4*)(BB + off) = bw; }
    }
};
struct EpiResid {
    static constexpr bool PERM = true, AFTER_DRAIN = false, RESK = false, WIDE = false;
    const float* base; bf16_t* XB;
    __device__ __forceinline__ void operator()(const f32x4 (&acc)[2][2][4][2], const Unit& u, int wr, int wc, int fr, int fq) const {
        const int col0 = u.pn * BM + wc * 32 + 8 * fq;
#pragma unroll
        for (int ai = 0; ai < 2; ++ai)
#pragma unroll
            for (int m = 0; m < 4; ++m) { const int row = u.pm * BM + ai * HALF + wr * 64 + m * 16 + fr; const size_t off = (size_t)row * DM + col0;
#pragma unroll
                for (int bj = 0; bj < 2; ++bj) { const f32x4 b0 = *(const f32x4*)(base + off + bj * HALF), b1 = *(const f32x4*)(base + off + bj * HALF + 4);
                    *(u32x4*)(XB + off + bj * HALF) = pack8(acc[ai][bj][m][0] + b0, acc[ai][bj][m][1] + b1); } }
    }
};
struct EpiResidB {
    static constexpr bool PERM = true, AFTER_DRAIN = false, RESK = false, WIDE = false;
    const bf16_t* base; bf16_t* XB;
    __device__ __forceinline__ void operator()(const f32x4 (&acc)[2][2][4][2], const Unit& u, int wr, int wc, int fr, int fq) const {
        const int col0 = u.pn * BM + wc * 32 + 8 * fq;
        u32x4 bw[2][4][2];
#pragma unroll
        for (int ai = 0; ai < 2; ++ai)
#pragma unroll
            for (int m = 0; m < 4; ++m)
#pragma unroll
                for (int bj = 0; bj < 2; ++bj) bw[ai][m][bj] = *(const u32x4*)(base + (size_t)(u.pm * BM + ai * HALF + wr * 64 + m * 16 + fr) * DM + col0 + bj * HALF);
#pragma unroll
        for (int ai = 0; ai < 2; ++ai)
#pragma unroll
            for (int m = 0; m < 4; ++m) { const int row = u.pm * BM + ai * HALF + wr * 64 + m * 16 + fr; const size_t off = (size_t)row * DM + col0;
#pragma unroll
                for (int bj = 0; bj < 2; ++bj) { const u32x4 b = bw[ai][m][bj];
                    const f32x4 b0 = {bflo(b.x), bfhi(b.x), bflo(b.y), bfhi(b.y)}, b1 = {bflo(b.z), bfhi(b.z), bflo(b.w), bfhi(b.w)};
                    *(u32x4*)(XB + off + bj * HALF) = pack8(acc[ai][bj][m][0] + b0, acc[ai][bj][m][1] + b1); } }
    }
};
struct EpiStoreRes {
    static constexpr bool PERM = true, AFTER_DRAIN = false, RESK = true, WIDE = false;
    bf16_t* XB; float* part;
    __device__ __forceinline__ void operator()(const f32x4 (&acc)[2][2][4][2], const Unit& u, int wr, int wc, int fr, int fq) const {
        const int col0 = u.pn * BM + wc * 32 + 8 * fq;
#pragma unroll
        for (int ai = 0; ai < 2; ++ai)
#pragma unroll
            for (int m = 0; m < 4; ++m) { const int row = u.pm * BM + ai * HALF + wr * 64 + m * 16 + fr; bf16_t* rowp = XB + (size_t)row * DM + col0; float ss = 0.f;
#pragma unroll
                for (int bj = 0; bj < 2; ++bj) { const f32x4 v0 = acc[ai][bj][m][0], v1 = acc[ai][bj][m][1];
                    *(u32x4*)(rowp + bj * HALF) = pack8(v0, v1);
                    ss += ((v0[0] * v0[0] + v0[1] * v0[1]) + (v0[2] * v0[2] + v0[3] * v0[3])) + ((v1[0] * v1[0] + v1[1] * v1[1]) + (v1[2] * v1[2] + v1[3] * v1[3])); }
                ss += __shfl_xor(ss, 16); ss += __shfl_xor(ss, 32);
                if (fq == 0) part[(size_t)row * 32 + u.pn * 4 + wc] = ss; }
    }
};
struct EpiMoe1 {
    static constexpr bool PERM = true, AFTER_DRAIN = false, RESK = false, WIDE = false;
    const float* RS; bf16_t* ACT;
    __device__ __forceinline__ void operator()(const f32x4 (&acc)[2][2][4][2], const Unit& u, int wr, int wc, int fr, int fq) const {
        const int col0 = u.pn * 128 + wc * 32 + 8 * fq;
#pragma unroll
        for (int ai = 0; ai < 2; ++ai) {
            float sv[4];
#pragma unroll
            for (int m = 0; m < 4; ++m) sv[m] = RS[u.a0 + ai * HALF + wr * 64 + m * 16 + fr];
#pragma unroll
            for (int m = 0; m < 4; ++m) { const int r = ai * HALF + wr * 64 + m * 16 + fr; const float s = sv[m]; f32x4 o[2];
#pragma unroll
                for (int n = 0; n < 2; ++n)
#pragma unroll
                    for (int j = 0; j < 4; ++j) { const float gg = acc[ai][0][m][n][j] * s, up = acc[ai][1][m][n][j] * s; o[n][j] = gg * fast_sigmoid(gg) * up; }
                *(u32x4*)(ACT + (size_t)(u.prow0 + r) * DEXP + col0) = pack8(o[0], o[1]); } }
    }
};
struct EpiMoe2 {
    static constexpr bool PERM = true, AFTER_DRAIN = false, RESK = false, WIDE = true;
    bf16_t* Y;
    __device__ __forceinline__ void operator()(const f32x4 (&acc)[2][2][4][2], const Unit& u, int wr, int wc, int fr, int fq) const {
        const int col0 = u.pn * BM + wc * 64 + 8 * fq;
#pragma unroll
        for (int ai = 0; ai < 2; ++ai)
#pragma unroll
            for (int m = 0; m < 4; ++m) { const int r = ai * HALF + wr * 64 + m * 16 + fr; bf16_t* rowp = Y + (size_t)(u.prow0 + r) * DM + col0;
#pragma unroll
                for (int bj = 0; bj < 2; ++bj) *(u32x4*)(rowp + bj * 32) = pack8(acc[ai][bj][m][0], acc[ai][bj][m][1]); }
    }
};
struct EpiKVQG {
    static constexpr bool PERM = true, AFTER_DRAIN = false, RESK = false, WIDE = false;
    bf16_t* Kb; bf16_t* Vb; bf16_t* Qb; bf16_t* SG; float* FLOG; const float* fbias; const float* RS;
    __device__ __forceinline__ void operator()(const f32x4 (&acc)[2][2][4][2], const Unit& u, int wr, int wc, int fr, int fq) const {
        const int pn = u.pn;
        float rs[2][4];
#pragma unroll
        for (int ai = 0; ai < 2; ++ai)
#pragma unroll
            for (int m = 0; m < 4; ++m) rs[ai][m] = RS[u.pm * BM + ai * HALF + wr * 64 + m * 16 + fr];
        if (pn == 16) {
            if (wc == 0 && fq < 2) { const f32x4 fb0 = *(const f32x4*)(fbias + 8 * fq), fb1 = *(const f32x4*)(fbias + 8 * fq + 4);
#pragma unroll
                for (int ai = 0; ai < 2; ++ai)
#pragma unroll
                    for (int m = 0; m < 4; ++m) { const int row = u.pm * BM + ai * HALF + wr * 64 + m * 16 + fr; f32x4 o[2];
#pragma unroll
                        for (int n = 0; n < 2; ++n)
#pragma unroll
                            for (int j = 0; j < 4; ++j) { const float z = acc[ai][0][m][n][j] * rs[ai][m] + (n ? fb1[j] : fb0[j]); o[n][j] = fminf(z, 0.f) - 0.6931471805599453f * __builtin_amdgcn_logf(1.0f + __builtin_amdgcn_exp2f(-1.4426950408889634f * fabsf(z))); }
                        *(f32x4*)(FLOG + (size_t)row * 16 + 8 * fq) = o[0]; *(f32x4*)(FLOG + (size_t)row * 16 + 8 * fq + 4) = o[1]; } }
            return; }
        if (pn >= 25) {
            const int col0 = (pn - 25) * BM + wc * 32 + 8 * fq;
#pragma unroll
            for (int ai = 0; ai < 2; ++ai)
#pragma unroll
                for (int m = 0; m < 4; ++m) { bf16_t* rowp = SG + (size_t)(u.pm * BM + ai * HALF + wr * 64 + m * 16 + fr) * DM + col0;
#pragma unroll
                    for (int bj = 0; bj < 2; ++bj) { f32x4 v0 = acc[ai][bj][m][0], v1 = acc[ai][bj][m][1];
#pragma unroll
                        for (int j = 0; j < 4; ++j) { v0[j] = fast_sigmoid(v0[j] * rs[ai][m]); v1[j] = fast_sigmoid(v1[j] * rs[ai][m]); }
                        *(u32x4*)(rowp + bj * HALF) = pack8(v0, v1); } }
            return; }
        bf16_t* base; int ct; float sc = 1.f;
        if (pn < 8) { base = Kb; ct = pn; } else if (pn < 16) { base = Vb; ct = pn - 8; } else { base = Qb; ct = pn - 17; sc = 0.08838834764831845f; }
        const int bidx = (u.pm * BM) / SEQ, s0 = (u.pm * BM) % SEQ;
#pragma unroll
        for (int ai = 0; ai < 2; ++ai)
#pragma unroll
            for (int m = 0; m < 4; ++m) { const int s = s0 + ai * HALF + wr * 64 + m * 16 + fr;
#pragma unroll
                for (int bj = 0; bj < 2; ++bj) { const int h = ct * 2 + bj;
                    *(u32x4*)(base + ((size_t)(bidx * NHEAD + h) * SEQ + s) * HDIM + wc * 32 + 8 * fq) = pack8(acc[ai][bj][m][0] * (sc * rs[ai][m]), acc[ai][bj][m][1] * (sc * rs[ai][m])); } }
    }
};
struct EpiRouter {
    static constexpr bool PERM = false, AFTER_DRAIN = true, RESK = false, WIDE = false;
    const float* PR; const float* bgroup; const float* brouter; int* TH;
    int* asg_e; int* asg_r; float* asg_w; float* rstd_tok;
    __device__ __forceinline__ void fused(const f32x4 (&acc)[2][2][4][2], const Unit& u, int wr, int wc, int fr, int fq, LAS unsigned char* lds, int wid, int lane) const {
        LAS float* Lg = (LAS float*)lds;
        LAS int* cntw = (LAS int*)(lds + 256 * 73 * 4);
        LAS int* offw = cntw + 512;
        const int tid = wid * 64 + lane;
        if (wc < 3) {
#pragma unroll
            for (int ai = 0; ai < 2; ++ai)
#pragma unroll
                for (int m = 0; m < 4; ++m) { const int row = ai * HALF + wr * 64 + m * 16 + fr;
#pragma unroll
                    for (int n = 0; n < 2; ++n) { const int col = wc * 32 + 16 * n + 4 * fq;
                        if (col < 72) {
#pragma unroll
                            for (int j = 0; j < 4; ++j) Lg[row * 73 + col + j] = acc[ai][0][m][n][j]; } } } }
        LDS_WAIT(); __builtin_amdgcn_s_barrier(); asm volatile("" ::: "memory");
        int e0 = 0, e1 = 0, l0 = 0, l1 = 0; float w0 = 0.f, w1 = 0.f, rstd = 0.f; const int t = u.pm * BM + tid;
        if (wid < 4) {
            LAS float* ssq = (LAS float*)(offw + 512);
            const f32x4* pp = (const f32x4*)(PR + (size_t)(u.pm * BM + tid) * 32); float s = 0.f;
#pragma unroll
            for (int i = 0; i < 8; ++i) { const f32x4 w = pp[i]; s += (w[0] + w[1]) + (w[2] + w[3]); }
            ssq[tid] = s;
        }
        LDS_WAIT(); __builtin_amdgcn_s_barrier(); asm volatile("" ::: "memory");
        if (wid < 4) {
            rstd = 1.0f / sqrtf(((LAS float*)(offw + 512))[tid] * (1.0f / DM) + RMS_EPS);
            float gm = -3.0e38f; int g = 0; float gl[8];
#pragma unroll
            for (int j = 0; j < 8; ++j) { gl[j] = Lg[tid * 73 + j] * rstd + bgroup[j]; if (gl[j] > gm) { gm = gl[j]; g = j; } }
            float gs = 0.f;
#pragma unroll
            for (int j = 0; j < 8; ++j) gs += expf(gl[j] - gm);
            const float gp = 1.0f / gs;
            float m1 = -3.0e38f, m2 = -3.0e38f; int i1 = 0, i2 = 0;
#pragma unroll
            for (int j = 0; j < 8; ++j) { const float v = Lg[tid * 73 + 8 + g * 8 + j] * rstd + brouter[g * 8 + j];
                if (v > m1) { m2 = m1; i2 = i1; m1 = v; i1 = j; } else if (v > m2) { m2 = v; i2 = j; } }
            const float ex = expf(m2 - m1); w0 = gp / (1.0f + ex); w1 = gp * ex / (1.0f + ex);
            e0 = g * 8 + i1; e1 = g * 8 + i2;
            const unsigned long long ltm = (1ull << lane) - 1ull; int c0 = 0, c1 = 0;
            for (int e = 0; e < 64; ++e) {
                const unsigned long long m0 = __ballot(e0 == e), mm1 = __ballot(e1 == e);
                if (e0 == e) l0 = __builtin_popcountll(m0 & ltm);
                if (e1 == e) l1 = __builtin_popcountll(mm1 & ltm);
                if (lane == e) { c0 = __builtin_popcountll(m0); c1 = __builtin_popcountll(mm1); } }
            cntw[(0 * 4 + wid) * 64 + lane] = c0; cntw[(1 * 4 + wid) * 64 + lane] = c1;
        }
        LDS_WAIT(); __builtin_amdgcn_s_barrier(); asm volatile("" ::: "memory");
        if (tid < 64) { int run = 0;
#pragma unroll
            for (int kw = 0; kw < 8; ++kw) { offw[kw * 64 + tid] = run; run += cntw[kw * 64 + tid]; }
            TH[u.pm * 64 + tid] = run; }
        LDS_WAIT(); __builtin_amdgcn_s_barrier(); asm volatile("" ::: "memory");
        if (wid < 4) {
            const int r0 = offw[(0 * 4 + wid) * 64 + e0] + l0, r1 = offw[(1 * 4 + wid) * 64 + e1] + l1;
            asg_e[2 * t] = e0; asg_e[2 * t + 1] = e1; asg_r[2 * t] = r0; asg_r[2 * t + 1] = r1; asg_w[2 * t] = w0; asg_w[2 * t + 1] = w1; rstd_tok[t] = rstd;
        }
    }
};
}

namespace att {
constexpr int NW = 8, QBLK = 32, KVBLK = 64, QB = NW * QBLK, D = 128;
constexpr int SHM_V = KVBLK * D * 2, SHM_K = KVBLK * D * 2;
constexpr int CK_OFF = 2 * SHM_V + 2 * SHM_K + NW * 64 * 4;
constexpr int LDS_ATT = CK_OFF + 512;
constexpr int TBL_OFF = LDS_ATT + 64, TBL_BYTES = 272 * 4, TBLM_OFF = TBL_OFF + 2 * TBL_BYTES, ORD_OFF = TBLM_OFF + 64, CAP_OFF = ORD_OFF + 2048 * 2;
constexpr int OT_RS = 288, OT_WAVE = 32 * OT_RS, OT_OFF = (CAP_OFF + 128 + 127) & ~127;
static_assert(OT_OFF + (NW - 1) * OT_WAVE <= 139264, "attention LDS: waves 0..6 below the kernel's MISC words (barrier state), wave 7 in K buffer 1");
static_assert(OT_WAVE <= SHM_K, "attention LDS");
constexpr float THR = 8.f;
constexpr int OROW = DM;
enum { ORDER_PAIRED = 2, ORDER_XCD = 4 };

#define KSWZ(row, colB) ((row) * 256 + ((colB) ^ (((row) & 7) << 4)))
#define SBAR() __builtin_amdgcn_sched_barrier(0)
__device__ __forceinline__ int v_st(int k, int c) { const int kk = (k & ~0xC) | ((k & 4) << 1) | ((k & 8) >> 1); return ((kk >> 3) * 4 + (c >> 5)) * 512 + ((kk & 7) * 32 + (c & 31)) * 2; }
__device__ __forceinline__ int v_rd_base(int lane) { return ((lane & 3) << 3) | (((lane >> 2) & 3) << 6) | (((lane >> 4) & 1) << 5) | (((lane >> 5) & 1) << 8); }
constexpr int v_rd_off(int d0, int ks, int half) { return d0 * 512 + ks * 4096 + half * 2048; }
__device__ __forceinline__ int crow(int r, int hi) { return (r & 3) + 8 * (r >> 2) + 4 * hi; }
__device__ __forceinline__ bf16x8 load8(const bf16_t* p) { return *reinterpret_cast<const bf16x8*>(p); }

__device__ __forceinline__ void mask_tile(f32x16& p0, f32x16& p1, int dq, unsigned W) {
    const float NEG = -__builtin_inff();
#pragma unroll
    for (int r = 0; r < 16; ++r) {
        const int c = (r & 3) + 8 * (r >> 2);
        if ((unsigned)(dq - c) >= W) p0[r] = NEG;
        if ((unsigned)(dq - c - 32) >= W) p1[r] = NEG;
    }
}
__device__ __forceinline__ void partialSM(f32x16& p0, f32x16& p1, float& m_reg, float& mn, float& alpha, float thr = THR) {
    float pmax = p0[0];
#pragma unroll
    for (int r = 1; r < 16; ++r) pmax = fmaxf(pmax, p0[r]);
#pragma unroll
    for (int r = 0; r < 16; ++r) pmax = fmaxf(pmax, p1[r]);
    { auto rr = __builtin_amdgcn_permlane32_swap(__float_as_uint(pmax), __float_as_uint(pmax), false, false);
      pmax = fmaxf(__uint_as_float(rr[0]), __uint_as_float(rr[1])); }
    constexpr float C2 = 1.4426950408889634f;
    if (__builtin_expect(__all((pmax - m_reg) <= thr), 1)) { mn = m_reg; alpha = 1.f; }
    else { mn = fmaxf(m_reg, pmax); alpha = __builtin_amdgcn_exp2f((m_reg - mn) * C2); m_reg = mn; }
    const float mnL = -mn * C2;
#pragma unroll
    for (int r = 0; r < 16; ++r) p0[r] = fmaf(p0[r], C2, mnL);
#pragma unroll
    for (int r = 0; r < 16; ++r) p1[r] = fmaf(p1[r], C2, mnL);
#pragma unroll
    for (int r = 0; r < 16; ++r) p0[r] = __builtin_amdgcn_exp2f(p0[r]);
}
__device__ __forceinline__ void finishSM(f32x16& p0, f32x16& p1, float alpha, float& l_reg, bf16x8& pa0, bf16x8& pa1, bf16x8& pa2, bf16x8& pa3) {
#pragma unroll
    for (int r = 0; r < 16; ++r) p1[r] = __builtin_amdgcn_exp2f(p1[r]);
    float ps = 0;
#pragma unroll
    for (int r = 0; r < 16; ++r) ps += p0[r];
#pragma unroll
    for (int r = 0; r < 16; ++r) ps += p1[r];
    { auto rr = __builtin_amdgcn_permlane32_swap(__float_as_uint(ps), __float_as_uint(ps), false, false);
      ps = __uint_as_float(rr[0]) + __uint_as_float(rr[1]); }
    l_reg = l_reg * alpha + ps;
#define PK4(P, B_, OUT) do { unsigned a0 = cvt_pk_bf16(P[B_+0], P[B_+1]), a1 = cvt_pk_bf16(P[B_+2], P[B_+3]);                          \
        unsigned b0 = cvt_pk_bf16(P[B_+4], P[B_+5]), b1 = cvt_pk_bf16(P[B_+6], P[B_+7]);                                             \
        auto r0 = __builtin_amdgcn_permlane32_swap(a0, b0, false, false); auto r1 = __builtin_amdgcn_permlane32_swap(a1, b1, false, false); \
        u32x4 w = {r0[0], r1[0], r0[1], r1[1]}; OUT = *reinterpret_cast<bf16x8*>(&w); } while (0)
    PK4(p0, 0, pa0); PK4(p0, 8, pa1); PK4(p1, 0, pa2); PK4(p1, 8, pa3);
#undef PK4
}
template <int KB>
__device__ __forceinline__ void qkt(f32x16& p0, f32x16& p1, const char* K_lds, const char* ck_lds, int r32, int hi, const bf16x8* qr) {
    const float* ckb = (const float*)(ck_lds + KB * 256) + 4 * hi;
#pragma unroll
    for (int g = 0; g < 4; ++g) { const f32x4 c0 = *(const f32x4*)(ckb + 8 * g), c1 = *(const f32x4*)(ckb + 32 + 8 * g);
#pragma unroll
        for (int j = 0; j < 4; ++j) { p0[4 * g + j] = c0[j]; p1[4 * g + j] = c1[j]; } }
    const char* kb[4];
#pragma unroll
    for (int dd = 0; dd < 4; ++dd) kb[dd] = K_lds + KB * SHM_K + KSWZ(r32, (dd * 16 + hi * 8) * 2);
#pragma unroll
    for (int d0 = 0; d0 < 8; ++d0) { const char* a = kb[d0 & 3] + (d0 >> 2) * 128;
        bf16x8 b0 = *reinterpret_cast<const bf16x8*>(a);
        bf16x8 b1 = *reinterpret_cast<const bf16x8*>(a + 32 * 256);
        p0 = __builtin_amdgcn_mfma_f32_32x32x16_bf16(b0, qr[d0], p0, 0, 0, 0);
        p1 = __builtin_amdgcn_mfma_f32_32x32x16_bf16(b1, qr[d0], p1, 0, 0, 0); }
}
template <int VB>
__device__ __forceinline__ void pv_tile(f32x16* o, int vb0, bf16x8 pa0, bf16x8 pa1, bf16x8 pa2, bf16x8 pa3) {
#define TRRD(dst, off) asm volatile("ds_read_b64_tr_b16 %0, %1 offset:%2" : "=&v"(dst) : "v"(vb0), "i"(off) : "memory")
#define PV_D0(d0) do { s16x4 l0, l1, l2, l3, h0, h1, h2, h3; constexpr int b_ = VB * SHM_V + v_rd_off(d0, 0, 0); \
        TRRD(l0, b_); TRRD(h0, b_ + 2048); TRRD(l1, b_ + 4096); TRRD(h1, b_ + 6144); TRRD(l2, b_ + 8192); TRRD(h2, b_ + 10240); TRRD(l3, b_ + 12288); TRRD(h3, b_ + 14336); \
        asm volatile("s_waitcnt lgkmcnt(0)" ::: "memory"); SBAR();   \
        o[d0] = __builtin_amdgcn_mfma_f32_32x32x16_bf16(pa0, (bf16x8){l0[0], l0[1], l0[2], l0[3], h0[0], h0[1], h0[2], h0[3]}, o[d0], 0, 0, 0);   \
        o[d0] = __builtin_amdgcn_mfma_f32_32x32x16_bf16(pa1, (bf16x8){l1[0], l1[1], l1[2], l1[3], h1[0], h1[1], h1[2], h1[3]}, o[d0], 0, 0, 0);   \
        o[d0] = __builtin_amdgcn_mfma_f32_32x32x16_bf16(pa2, (bf16x8){l2[0], l2[1], l2[2], l2[3], h2[0], h2[1], h2[2], h2[3]}, o[d0], 0, 0, 0);   \
        o[d0] = __builtin_amdgcn_mfma_f32_32x32x16_bf16(pa3, (bf16x8){l3[0], l3[1], l3[2], l3[3], h3[0], h3[1], h3[2], h3[3]}, o[d0], 0, 0, 0); } while (0)
    PV_D0(0); PV_D0(1); PV_D0(2); PV_D0(3);
#undef PV_D0
#undef TRRD
}

struct Tensors { const bf16_t* Q; const bf16_t* K; const bf16_t* V; const float* C; const bf16_t* G; bf16_t* O; const float* nrm; unsigned* queue; };
constexpr float SKIP_EPS = 0.99f * 5.9604645e-8f / 64.f;
struct Blk { int L; int jlo; int tb; };
constexpr int NBH = NB * NHEAD, NQB = SEQ / (NW * QBLK);
__device__ __forceinline__ int blk_bh(int L) { return L >> 6; }
__device__ __forceinline__ int blk_qb(int L) { return L & 63; }
struct Seam { bf16x8 qr[8]; bf16x8 st_v0, st_v1, st_k0, st_k1; float st_c; };
#define VMW() asm volatile("s_waitcnt vmcnt(0)" ::: "memory")
#define VMWN(n) asm volatile("s_waitcnt vmcnt(%0)" :: "i"(n) : "memory")
#define LD16(base, off) (*(const bf16x8*)((const char*)(base) + (off)))
#define SLOAD_H(Kp, Vp, Cp, k0, cbf) do { const bf16_t* kt_ = (Kp) + (size_t)(k0) * D; const bf16_t* vt_ = (Vp) + (size_t)(k0) * D;              \
                         S.st_v0 = LD16(vt_, so0); S.st_v1 = LD16(vt_, so1); S.st_k0 = LD16(kt_, so0); S.st_k1 = LD16(kt_, so1);            \
                         S.st_c = *(const float*)((const char*)((Cp) + (k0)) + co); } while (0)
#define SWRITE_HK(bf) do { *(bf16x8*)(K_lds + (bf) * SHM_K + kws) = S.st_k0; *(bf16x8*)(K_lds + (bf) * SHM_K + kws + 32 * 256) = S.st_k1; \
                         if (wid == 0) *(float*)(ck_lds + (bf) * 256 + co) = -S.st_c; } while (0)
#define SWRITE_HV(bf) do { *(bf16x8*)(V_lds + (bf) * SHM_V + vst0) = S.st_v0; *(bf16x8*)(V_lds + (bf) * SHM_V + vst1) = S.st_v1; } while (0)
#define SWRITE_H(bf) do { SWRITE_HV(bf); SWRITE_HK(bf); } while (0)
__device__ __forceinline__ void attn_prime(const Tensors& T, const Blk cb, char* lds, Seam& S) {
    const int tid = threadIdx.x, wid = __builtin_amdgcn_readfirstlane(tid >> 6), lane = tid & 63, r32 = lane & 31, hi = lane >> 5;
    const int sr = tid >> 4, sc = (tid & 15) * 8, kws = KSWZ(sr, sc * 2); char* K_lds = lds + 2 * SHM_V; char* ck_lds = lds + CK_OFF;
    const unsigned so0 = (unsigned)((sr * D + sc) * 2), so1 = so0 + 32 * D * 2, co = (unsigned)(lane * 4), qo = (unsigned)((r32 * D + hi * 8) * 2);
    const int bh = blk_bh(cb.L), P0 = blk_qb(cb.L) * QB;
    const bf16_t* Kh = T.K + (size_t)bh * SEQ * D; const bf16_t* Vh = T.V + (size_t)bh * SEQ * D; const float* Ch = T.C + (size_t)bh * SEQ;
    { const bf16_t* qb_ = T.Q + ((size_t)bh * SEQ + P0 + wid * QBLK) * D;
#pragma unroll
      for (int d0 = 0; d0 < 8; ++d0) S.qr[d0] = LD16(qb_, qo + d0 * 32);
    }
    SLOAD_H(Kh, Vh, Ch, ((P0 + QB - 1) / KVBLK) * KVBLK, 0); VMW(); SWRITE_HK(0);
    __syncthreads();
}
__device__ __forceinline__ void attn_block(const Tensors& T, const Blk cb, const Blk nb, char* lds, Seam& S) {
    const int tid = threadIdx.x, wid = __builtin_amdgcn_readfirstlane(tid >> 6), lane = tid & 63, r32 = lane & 31, hi = lane >> 5;
    constexpr int W = SEQ;
    const int cbh = blk_bh(cb.L), cP0 = blk_qb(cb.L) * QB;
    const int jhi = (cP0 + QB - 1) / KVBLK; int NT = jhi + 1 - cb.jlo;
    const int qlo = cP0 + wid * QBLK;
    char* V_lds = lds; char* K_lds = lds + 2 * SHM_V; char* ck_lds = lds + CK_OFF;
    float* ws = (float*)(lds + 2 * SHM_V + 2 * SHM_K) + wid * 64; float* li_l = ws, * al_l = ws + 32;
    float m_reg = -1e30f, l_reg = 0; f32x16 o[4] = {};
    const int sr = tid >> 4, sc = (tid & 15) * 8, vst0 = v_st(sr, sc), vst1 = v_st(32 + sr, sc), kws = KSWZ(sr, sc * 2);
    const unsigned so0 = (unsigned)((sr * D + sc) * 2), so1 = so0 + 32 * D * 2, co = (unsigned)(lane * 4), qo = (unsigned)((r32 * D + hi * 8) * 2);
    const int vb0 = (int)(uintptr_t)V_lds + v_rd_base(lane);
    const bf16_t* Kh = T.K + (size_t)cbh * SEQ * D; const bf16_t* Vh = T.V + (size_t)cbh * SEQ * D; const float* Ch = T.C + (size_t)cbh * SEQ;
#define RESC(a) do { if (__any((a) < 1.f)) { if (hi == 0) al_l[r32] = (a); asm volatile("s_waitcnt lgkmcnt(0)" ::: "memory");              \
                     for (int d_ = 0; d_ < 4; ++d_) for (int r = 0; r < 16; ++r) o[d_][r] *= al_l[crow(r, hi)]; } } while (0)
#define KBASE(t) ((jhi - (t)) * KVBLK)
#define MASKT(P0_, P1_, t) do { const int kb_ = KBASE(t); if (kb_ + KVBLK - 1 > qlo) { int l_ = threadIdx.x; asm volatile("" : "+v"(l_)); const int lq_ = (l_ & 31) - 4 * ((l_ >> 5) & 1); mask_tile(P0_, P1_, (qlo - kb_) + lq_, (unsigned)W); } } while (0)
    constexpr int NQL = 8;
#define SEAM_K0() do { VMWN(NQL); SWRITE_HK(0); SBAR(); } while (0)
    f32x16 pA0, pA1, pB0, pB1; float mnA, mnB, alA, alB; bf16x8 pa0, pa1, pa2, pa3;
    SWRITE_HV(0); SBAR();
    if (NT > 1) { SLOAD_H(Kh, Vh, Ch, KBASE(1), 1); }
    SBAR(); qkt<0>(pA0, pA1, K_lds, ck_lds, r32, hi, S.qr);
    MASKT(pA0, pA1, 0); partialSM(pA0, pA1, m_reg, mnA, alA, 0.f);
    if (NT > 1) { VMW(); SWRITE_H(1); }
    __syncthreads();
#define HALF_STEP(PX0, PX1, mnX, alX, PY0, PY1, alY, t, KB, VB, SB) do {                                                      \
        SBAR(); qkt<KB>(PX0, PX1, K_lds, ck_lds, r32, hi, S.qr);                                                          \
        finishSM(PY0, PY1, alY, l_reg, pa0, pa1, pa2, pa3); SBAR();                                                           \
        if ((t) + 1 < NT) { SLOAD_H(Kh, Vh, Ch, KBASE((t) + 1), SB); SBAR(); }                                                    \
        pv_tile<VB>(o, vb0, pa0, pa1, pa2, pa3); MASKT(PX0, PX1, (t)); partialSM(PX0, PX1, m_reg, mnX, alX, (t) <= 4 ? 0.f : THR);     \
        __syncthreads();                                                                                                      \
        if ((t) + 1 < NT) { VMW(); SWRITE_H(SB); }                                                                            \
        RESC(alX); __syncthreads(); } while (0)
    for (int t = 1; t + 1 < NT; t += 2) {
        HALF_STEP(pB0, pB1, mnB, alB, pA0, pA1, alA, t, 1, 0, 0);
        HALF_STEP(pA0, pA1, mnA, alA, pB0, pB1, alB, t + 1, 0, 1, 1);
        if (t == 3 && NT > 6) {
            const float* tab = (const float*)(lds + TBL_OFF + cb.tb * TBL_BYTES); float* tbm = (float*)(lds + TBLM_OFF);
            int mb = (int)__float_as_uint(m_reg);
#define DPP_MIN(ctrl, rmask) mb = (int)__float_as_uint(fminf(__uint_as_float((unsigned)mb), __uint_as_float((unsigned)__builtin_amdgcn_update_dpp(mb, mb, ctrl, rmask, 0xf, false))))
            DPP_MIN(0x111, 0xf); DPP_MIN(0x112, 0xf); DPP_MIN(0x114, 0xf); DPP_MIN(0x118, 0xf); DPP_MIN(0x142, 0xa); DPP_MIN(0x143, 0xc);
#undef DPP_MIN
            const float mwave = __uint_as_float((unsigned)__builtin_amdgcn_readlane(mb, 63));
            if (lane == 0) tbm[wid] = mwave;
            asm volatile("s_waitcnt lgkmcnt(0)" ::: "memory"); __syncthreads();
            const f32x4 t0 = *(const f32x4*)tbm, t1 = *(const f32x4*)(tbm + 4);
            const float mm = fminf(fminf(fminf(t0[0], t0[1]), fminf(t0[2], t0[3])), fminf(fminf(t1[0], t1[1]), fminf(t1[2], t1[3])));
            const float thr = SKIP_EPS * __builtin_amdgcn_exp2f((mm + tab[256] - 0.05f) * 1.4426950408889634f);
            int lane_ = lane; asm volatile("" : "+v"(lane_));
            int jl = jhi - 5;
#pragma unroll
            for (int g = 3; g >= 0; --g) { const int j = g * 64 + lane_; const bool skip = (j <= jhi - 6) && (tab[j] <= thr) && (thr < 1e30f);
                const unsigned long long keep = ~__ballot(skip);
                if (keep) jl = g * 64 + (int)__builtin_ctzll(keep); }
            const int NTr = jhi + 1 - jl;
            NT = NTr < NT ? NTr : NT;
            __syncthreads();
        }
    }
    const bool even = (NT & 1) == 0;
    if (even) { SBAR(); qkt<1>(pB0, pB1, K_lds, ck_lds, r32, hi, S.qr); SBAR(); }
    { const int nbh_ = blk_bh(nb.L), nP0 = blk_qb(nb.L) * QB; const float* nC = T.C + (size_t)nbh_ * SEQ;
      SLOAD_H(T.K + (size_t)nbh_ * SEQ * D, T.V + (size_t)nbh_ * SEQ * D, nC, ((nP0 + QB - 1) / KVBLK) * KVBLK, 0); SBAR();
      const bf16_t* qb_ = T.Q + ((size_t)nbh_ * SEQ + nP0 + wid * QBLK) * D;
#pragma unroll
      for (int d0 = 0; d0 < 8; ++d0) S.qr[d0] = LD16(qb_, qo + d0 * 32);
    }
    SBAR();
    finishSM(pA0, pA1, alA, l_reg, pa0, pa1, pa2, pa3); SBAR();
    pv_tile<0>(o, vb0, pa0, pa1, pa2, pa3);
    if (even) { MASKT(pB0, pB1, NT - 1); partialSM(pB0, pB1, m_reg, mnB, alB); __syncthreads(); RESC(alB);
        finishSM(pB0, pB1, alB, l_reg, pa0, pa1, pa2, pa3); SBAR(); pv_tile<1>(o, vb0, pa0, pa1, pa2, pa3); }
    SBAR(); SEAM_K0();
    if (hi == 0) li_l[r32] = l_reg; asm volatile("s_waitcnt lgkmcnt(0)" ::: "memory");
    float rli[16];
#pragma unroll
    for (int r = 0; r < 16; ++r) rli[r] = __builtin_amdgcn_rcpf(li_l[crow(r, hi)]);
    int el = threadIdx.x; asm volatile("" : "+v"(el));
    const int elane = el & 63, er32 = elane & 31, ehi = elane >> 5, odd = er32 & 1;
    char* ot = lds + (wid < NW - 1 ? OT_OFF + wid * OT_WAVE : 2 * SHM_V + SHM_K);
    const size_t go = ((size_t)(cbh / NHEAD) * SEQ + cP0 + wid * QBLK) * OROW + (size_t)(cbh % NHEAD) * D;
    char* Ob = (char*)(T.O + go); const char* Gb = (const char*)(T.G + go);
    const unsigned rdo = (unsigned)((elane >> 4) * OROW * 2 + (elane & 15) * 16);
    u32x4 gv[8];
#pragma unroll
    for (int it = 0; it < 8; ++it) gv[it] = *(const u32x4*)(Gb + (size_t)it * 4 * OROW * 2 + rdo);
    const unsigned wbase = (unsigned)((4 * ehi + 2 * odd) * OT_RS + (er32 & ~1) * 2);
#pragma unroll
    for (int d0 = 0; d0 < 4; ++d0)
#pragma unroll
        for (int q = 0; q < 8; ++q) { const int r = (q >> 1) * 4 + (q & 1);
            const float X = o[d0][r] * rli[r], Y = o[d0][r + 2] * rli[r + 2];
            const float snd = odd ? X : Y;
            const float rcv = __uint_as_float((unsigned)__builtin_amdgcn_update_dpp((int)__float_as_uint(snd), (int)__float_as_uint(snd), 0xB1, 0xf, 0xf, false));
            const unsigned pk = cvt_pk_bf16(odd ? rcv : X, odd ? Y : rcv);
            *(unsigned*)(ot + wbase + ((r & 3) + 8 * (r >> 2)) * OT_RS + d0 * 64) = pk; }
    asm volatile("s_waitcnt lgkmcnt(0)" ::: "memory");
    const unsigned rbase = (unsigned)((elane >> 4) * OT_RS + (elane & 15) * 16);
#pragma unroll
    for (int it = 0; it < 8; ++it) { const u32x4 ov = *(const u32x4*)(ot + rbase + it * 4 * OT_RS), g = gv[it]; u32x4 w;
        w.x = cvt_pk_bf16(bflo(ov.x) * bflo(g.x), bfhi(ov.x) * bfhi(g.x)); w.y = cvt_pk_bf16(bflo(ov.y) * bflo(g.y), bfhi(ov.y) * bfhi(g.y));
        w.z = cvt_pk_bf16(bflo(ov.z) * bflo(g.z), bfhi(ov.z) * bfhi(g.z)); w.w = cvt_pk_bf16(bflo(ov.w) * bflo(g.w), bfhi(ov.w) * bfhi(g.w));
        *(u32x4*)(Ob + (size_t)it * 4 * OROW * 2 + rdo) = w; }
    __syncthreads();
#undef RESC
#undef KBASE
#undef MASKT
#undef SEAM_K0
#undef HALF_STEP
}
#undef LD16
#undef VMW
#undef VMWN
#undef SLOAD_H
#undef SWRITE_HK
#undef SWRITE_HV
#undef SWRITE_H

__device__ __forceinline__ int find_jlo(const float* Ch, const float* kn2, int P0, float rho, float bnd, float* tab) {
    int lane = threadIdx.x & 63; asm volatile("" : "+v"(lane));
    const int nd = P0 / KVBLK; const float c0 = Ch[P0];
    const float thr0 = SKIP_EPS * __builtin_amdgcn_exp2f(-bnd * 1.4426950408889634f);
    float e[4];
#pragma unroll
    for (int g = 0; g < 4; ++g) { const int j = g * 64 + lane; e[g] = 0.f;
        if (j < nd) e[g] = __builtin_amdgcn_exp2f((fmaf(rho, __builtin_sqrtf(kn2[j]), c0) - Ch[j * KVBLK + KVBLK - 1]) * 1.4426950408889634f); }
    int jlo = 4 * 64; float carry = 0.f;
#pragma unroll
    for (int g = 0; g < 4; ++g) { float p = e[g];
#define DPP_ADD(ctrl, rmask) p += __uint_as_float((unsigned)__builtin_amdgcn_update_dpp(0, (int)__float_as_uint(p), ctrl, rmask, 0xf, true))
        DPP_ADD(0x111, 0xf); DPP_ADD(0x112, 0xf); DPP_ADD(0x114, 0xf); DPP_ADD(0x118, 0xf);
        DPP_ADD(0x142, 0xa); DPP_ADD(0x143, 0xc);
#undef DPP_ADD
        p += carry;
        if (tab && threadIdx.x < 64) tab[g * 64 + lane] = p;
        const bool skip = (g * 64 + lane < nd) && (p <= thr0);
        const unsigned long long keep = ~__ballot(skip);
        if (keep && jlo == 4 * 64) jlo = g * 64 + (int)__builtin_ctzll(keep);
        carry = __uint_as_float((unsigned)__builtin_amdgcn_readlane((int)__float_as_uint(p), 63)); }
    if (tab && threadIdx.x == 0) tab[256] = c0;
    return jlo;
}
__device__ __forceinline__ Blk mkblk(int L, const Tensors& T, char* lds, int tb) {
    const int bh = blk_bh(L), P0 = blk_qb(L) * QB;
    const float qn2 = T.nrm[bh * 64 + blk_qb(L)], dneg = T.nrm[NBH * 64 + bh * 64 + blk_qb(L)];
    const float rho = 1.001f * __builtin_sqrtf(qn2), bnd = 1.001f * dneg + 0.05f;
    Blk r; r.L = L; r.tb = tb; r.jlo = __builtin_amdgcn_readfirstlane(find_jlo(T.C + (size_t)bh * SEQ, T.nrm + 2 * NBH * 64 + bh * 256, P0, rho, bnd, (float*)(lds + TBL_OFF + tb * TBL_BYTES)));
    return r;
}
__device__ __forceinline__ void attn_order(char* lds, const Tensors& T) {
    unsigned short* ord = (unsigned short*)(lds + ORD_OFF); int* cap = (int*)(lds + CAP_OFF);
    int tid = threadIdx.x; asm volatile("" : "+v"(tid));
    const int wid = __builtin_amdgcn_readfirstlane(tid >> 6);
#pragma unroll
    for (int k = 0; k < 4; ++k) { const int bh = wid * 4 + k;
        const float qn2 = T.nrm[bh * 64 + 63], dneg = T.nrm[NBH * 64 + bh * 64 + 63];
        const int jl = find_jlo(T.C + (size_t)bh * SEQ, T.nrm + 2 * NBH * 64 + bh * 256, 63 * QB, 1.001f * __builtin_sqrtf(qn2), 1.001f * dneg + 0.05f, nullptr);
        int c = (63 * 4 - jl + 3) >> 2; c = c > 63 ? 63 : c;
        if ((tid & 63) == 0) cap[bh] = c; }
    asm volatile("s_waitcnt lgkmcnt(0)" ::: "memory"); __syncthreads();
    for (int i = tid; i < NBH * NQB; i += NW * 64) { const int bh = i >> 6, qb = i & 63, capb = cap[bh], lev = qb < capb ? qb : capb;
        int pos = lev == capb ? qb - capb : 0;
        for (int h = 0; h < NBH; ++h) { const int c = cap[h];
            if (lev + 1 <= c) pos += 63 - lev;
            if (h < bh) pos += lev < c ? 1 : (lev == c ? 64 - c : 0); }
        ord[pos] = (unsigned short)i; }
    asm volatile("s_waitcnt lgkmcnt(0)" ::: "memory"); __syncthreads();
}
__device__ __forceinline__ void attn_phase(char* lds, const Tensors& T) {
    constexpr int total = NBH * NQB;
    attn_order(lds, T);
    const unsigned short* ord = (const unsigned short*)(lds + ORD_OFF);
    volatile int* qslot = (volatile int*)(lds + LDS_ATT);
    if (threadIdx.x == 0) *qslot = (int)atomicAdd(T.queue, 1u);
    __syncthreads();
    const int L0 = __builtin_amdgcn_readfirstlane(*qslot);
    __syncthreads();
    if (L0 >= total) return;
    Blk cur = mkblk(__builtin_amdgcn_readfirstlane((int)ord[L0]), T, lds, 0);
    Seam S;
    attn_prime(T, cur, lds, S);
    for (;;) {
        if (threadIdx.x == 0) *qslot = (int)atomicAdd(T.queue, 1u);
        __syncthreads();
        const int Ln = __builtin_amdgcn_readfirstlane(*qslot);
        const bool last = Ln >= total;
        Blk nxt = cur; if (!last) nxt = mkblk(__builtin_amdgcn_readfirstlane((int)ord[Ln]), T, lds, cur.tb ^ 1);
        attn_block(T, cur, nxt, lds, S);
        if (last) break;
        cur = nxt;
    }
}
}

struct Args {
    const float* in[25]; float* out; unsigned char* ws; int ph_lo, ph_hi; int alt, pad;
};
enum { I_X = 0, I_ANORM, I_AWIN, I_ACONVW, I_ACONVB, I_AWREC, I_ABREC, I_AWINP, I_ABINP, I_ALAMBDA, I_AWOUT, I_KVNORM, I_KVW, I_KVBF, I_BNORM, I_BWQG, I_BWO,
       I_MNORM, I_MWGROUP, I_MBGROUP, I_MWROUTER, I_MBROUTER, I_MWIN, I_MWOUT, I_FNORM };
constexpr int NPHASES = 21;

__device__ __forceinline__ void cvt_item(const float* src, int ld, const float* gain, bf16_t* dst, int ldd, LAS float* scr, int lane) {
    const int q = lane & 15, kr = lane >> 4;
#pragma unroll
    for (int hb = 0; hb < 2; ++hb) {
        f32x4 v[8];
#pragma unroll
        for (int it = 0; it < 8; ++it) { const int kk = (hb * 8 + it) * 4 + kr; v[it] = *(const f32x4*)(src + (size_t)kk * ld + q * 4); }
#pragma unroll
        for (int it = 0; it < 8; ++it) { const int kk = (hb * 8 + it) * 4 + kr; const float gk = gain ? gain[kk] : 1.0f;
            *(LAS f32x4*)(scr + kk * 64 + ((4 * q) ^ (4 * (kk >> 3)))) = v[it] * gk; }
    }
    LDS_WAIT(); asm volatile("" ::: "memory");
    const int c = lane & 7;
#pragma unroll
    for (int j = 0; j < 8; ++j) { const int n = (lane >> 3) + 8 * j; const LAS float* s = scr + (8 * c) * 64 + (n ^ (4 * c));
        u32x4 o; o.x = cvt_pk_bf16(s[0 * 64], s[1 * 64]); o.y = cvt_pk_bf16(s[2 * 64], s[3 * 64]); o.z = cvt_pk_bf16(s[4 * 64], s[5 * 64]); o.w = cvt_pk_bf16(s[6 * 64], s[7 * 64]);
        *(u32x4*)(dst + (size_t)n * ldd + 8 * c) = o; }
    LDS_WAIT(); asm volatile("" ::: "memory");
}

constexpr int DEFER_ITEMS = 64 * 256, DEFER_ROUTER = 7168, DEFER_SCATTER = 1024;
static_assert(2 * (DEFER_ROUTER + DEFER_SCATTER) == DEFER_ITEMS, "deferred weight items");
__device__ __forceinline__ void cvt_wout_deferred(const float* mwout, bf16_t* WmoT, int first, int count, int w, int nw, LAS float* scr, int wave, int lane) {
    for (int d = first + w * NWAVES + wave; d < first + count; d += nw * NWAVES) {
        const int le = 64 + (d >> 8), rr = d & 255, kb = rr >> 5, nb = rr & 31;
        cvt_item(mwout + (size_t)le * 512 * DM + (size_t)kb * 64 * DM + nb * 64, DM, nullptr, WmoT + (size_t)le * DM * 512 + (size_t)nb * 64 * 512 + kb * 64, 512, scr, lane); }
}
struct MoeCtx {
    LAS unsigned char* lds; volatile LAS unsigned* MISC; unsigned char* ws; int G, bx, vcu, wave, lo, hi;
    const float* bgroup; const float* brouter; const float* fnorm; float* out; const float* mwout;
};
#ifndef PHASE_MASK
#define PHASE_MASK 0x1fffff
#endif
#define PH_ON(k) (((PHASE_MASK) >> (k)) & 1)
#define IN(k) (PH_ON(k) && lo <= (k) && (k) < hi)
#if !MK_PER_PHASE
#define GRID_BAR() xcd_barrier(bar)
#else
#define GRID_BAR() do { } while (0)
#endif
#define SEAM(k) do { if (IN(k) && IN((k) + 1)) GRID_BAR(); } while (0)
template <int layer>
__device__ __forceinline__ void moe_block(const MoeCtx& C, const XcdBarrier& bar) {
    LAS unsigned char* lds = C.lds; volatile LAS unsigned* MISC = C.MISC; const int G = C.G, bx = C.bx, vcu = C.vcu, wave = C.wave, lo = C.lo, hi = C.hi;
    int tid = threadIdx.x; asm volatile("" : "+v"(tid));
    const int lane = tid & 63;
    constexpr int pb = 7 + 9 * layer;
    unsigned char* ws = C.ws; unsigned* ctl = (unsigned*)(ws + WS_CTL);
    const bf16_t* XRB = (const bf16_t*)(ws + (layer ? WS_X3B : WS_X1B));
    unsigned* gcnt = ctl + CW_GCNT + 64 * layer;
    unsigned char* mb = ws + WS_ASG + (size_t)layer * MOE_LAYER_STRIDE;
    int* asg_e = (int*)mb; int* asg_r = asg_e + 2 * NTOK; float* asg_w = (float*)(asg_r + 2 * NTOK); float* rstd_tok = asg_w + 2 * NTOK; int* TH = (int*)(rstd_tok + NTOK); int* asg_g = TH + 128 * 64;
    int* tokl = (int*)(mb + (WS_TOKL - WS_ASG)); float* rsl = (float*)(mb + (WS_RSL - WS_ASG)); bf16_t* ACT = (bf16_t*)(mb + (WS_ACT - WS_ASG)); bf16_t* YB = (bf16_t*)(mb + (WS_YB - WS_ASG));
    float* X2 = (float*)(ws + WS_X2); bf16_t* XN2 = (bf16_t*)(ws + WS_XN2);
    const bf16_t* WrT = (const bf16_t*)(ws + WS_WR); const bf16_t* WmiT = (const bf16_t*)(ws + WS_WMI); const bf16_t* WmoT = (const bf16_t*)(ws + WS_WMO);
    if (IN(pb)) {
        pg8::Gemm g{XRB, WrT + (size_t)layer * 256 * DM, DM, DM, DM, nullptr, nullptr, nullptr}; pg8::DenseSched S; S.o.init(NTOK / 256, 1, G, bx);
        pg8::EpiRouter E{(const float*)(ws + (layer ? WS_PART3 : WS_PART)), C.bgroup + 8 * layer, C.brouter + 64 * layer, TH, asg_e, asg_r, asg_w, rstd_tok};
        pg8::gemm_phase<pg8::EpiRouter, pg8::DenseSched, false, false>(lds, g, S, E);
        if (G >= 256 && bx >= NTOK / 256) {
            int dl = threadIdx.x; asm volatile("" : "+v"(dl));
            cvt_wout_deferred(C.mwout, (bf16_t*)(ws + WS_WMO), layer * (DEFER_ROUTER + DEFER_SCATTER), DEFER_ROUTER, bx - NTOK / 256, G - NTOK / 256, (LAS float*)(lds + wave * 16384), wave, dl & 63); }
    }
    SEAM(pb);
    if (IN(pb + 1)) {
        LAS int* bs = (LAS int*)lds;
        for (int tile = vcu; tile < NTOK / 256; tile += G) {
            if (tid < 64) { int base = 0;
#pragma unroll 16
                for (int tt = 0; tt < tile; ++tt) base += TH[tt * 64 + tid];
                bs[tid] = base; if (tile == NTOK / 256 - 1) gcnt[tid] = (unsigned)(base + TH[tile * 64 + tid]); }
            LDS_WAIT(); __syncthreads();
            if (tid < 256) { const int t = tile * 256 + tid; const float rs = rstd_tok[t];
#pragma unroll
                for (int k = 0; k < 2; ++k) { const int e = asg_e[2 * t + k], r = bs[e] + asg_r[2 * t + k]; asg_g[2 * t + k] = r; __hip_atomic_store(tokl + (size_t)e * LCAP + r, t, __ATOMIC_RELAXED, __HIP_MEMORY_SCOPE_AGENT); __hip_atomic_store(rsl + (size_t)e * LCAP + r, rs, __ATOMIC_RELAXED, __HIP_MEMORY_SCOPE_AGENT); } }
            __syncthreads();
        }
        if (G >= 256 && vcu >= NTOK / 256) {
            int dl = threadIdx.x; asm volatile("" : "+v"(dl));
            cvt_wout_deferred(C.mwout, (bf16_t*)(ws + WS_WMO), layer * (DEFER_ROUTER + DEFER_SCATTER) + DEFER_ROUTER, DEFER_SCATTER, vcu - NTOK / 256, G - NTOK / 256, (LAS float*)(lds + wave * 16384), wave, dl & 63); }
    }
    SEAM(pb + 1);
    if (IN(pb + 2) || IN(pb + 3) || IN(pb + 4)) {
        __syncthreads();
        if (tid < 64) { const int c = (int)__hip_atomic_load(gcnt + tid, __ATOMIC_RELAXED, __HIP_MEMORY_SCOPE_AGENT); const int ntile = (c + 255) >> 8; int incl = ntile;
#pragma unroll
            for (int o = 1; o < 64; o <<= 1) { const int nb = __shfl_up(incl, o); if (lane >= o) incl += nb; }
            MISC[MI_CNT + tid] = (unsigned)c; MISC[MI_TSTART + tid + 1] = (unsigned)incl; if (tid == 0) MISC[MI_TSTART] = 0u; }
        LDS_WAIT(); __syncthreads();
    }
    const LAS int* tstart = (const LAS int*)(lds + MISC_OFF) + MI_TSTART; const LAS int* ecnt = (const LAS int*)(lds + MISC_OFF) + MI_CNT;
    if (IN(pb + 2)) {
        pg8::Gemm g{XRB, WmiT + (size_t)layer * 64 * 1024 * DM, DM, DM, DM, tokl, nullptr, nullptr};
        pg8::MoeSched<true> S{tstart, ecnt, 4, G, bx, tstart[64] * 4, 1024};
        pg8::EpiMoe1 E{rsl, ACT};
        pg8::gemm_phase<pg8::EpiMoe1, pg8::MoeSched<true>, true, true>(lds, g, S, E);
    }
    SEAM(pb + 2);
    if (IN(pb + 3)) {
        pg8::Gemm g{ACT, WmoT + (size_t)layer * 64 * DM * 512, DEXP, DEXP, DEXP, nullptr, nullptr, nullptr};
        pg8::MoeSched<false> S{tstart, ecnt, 8, G, bx, tstart[64] * 8, 2048};
        pg8::EpiMoe2 E{YB};
        pg8::gemm_phase<pg8::EpiMoe2, pg8::MoeSched<false>, false, true>(lds, g, S, E);
    }
    SEAM(pb + 3);
    if (IN(pb + 4)) {
        const int gw = vcu * NWAVES + wave, NGW = G * NWAVES;
        const float* fn = C.fnorm;
        struct Asg { int e0, e1, r0, r1; float w0, w1; };
#define CB_LD_ASG(A_, t_) do { (A_).e0 = asg_e[2 * (t_)]; (A_).e1 = asg_e[2 * (t_) + 1]; (A_).r0 = asg_g[2 * (t_)]; (A_).r1 = asg_g[2 * (t_) + 1]; (A_).w0 = asg_w[2 * (t_)]; (A_).w1 = asg_w[2 * (t_) + 1]; } while (0)
#define CB_LD_ROW(X_, A0_, B0_, A_, t_) do { const size_t p0_ = (size_t)(tstart[(A_).e0] * 256 + (A_).r0), p1_ = (size_t)(tstart[(A_).e1] * 256 + (A_).r1);               \
            const u32x2* xr_ = (const u32x2*)(XRB + (size_t)(t_) * DM) + lane; const u32x2* y0_ = (const u32x2*)(YB + p0_ * DM) + lane; const u32x2* y1_ = (const u32x2*)(YB + p1_ * DM) + lane; \
            _Pragma("unroll") for (int j = 0; j < 8; ++j) { (X_)[j] = __builtin_nontemporal_load(xr_ + 64 * j); (A0_)[j] = __builtin_nontemporal_load(y0_ + 64 * j); (B0_)[j] = __builtin_nontemporal_load(y1_ + 64 * j); } } while (0)
        Asg ac, an; u32x2 xw[8], aw[8], bw[8];
        { const int t0 = gw; ac.e0 = ac.e1 = ac.r0 = ac.r1 = 0; ac.w0 = ac.w1 = 0.f; an = ac;
          if (t0 < NTOK) { CB_LD_ASG(ac, t0); CB_LD_ROW(xw, aw, bw, ac, t0); }
          if (t0 + NGW < NTOK) CB_LD_ASG(an, t0 + NGW); }
        for (int t = gw; t < NTOK; t += NGW) {
            const int tn = t + NGW;
            Asg a2 = an; if (tn + NGW < NTOK) CB_LD_ASG(a2, tn + NGW);
            u32x2 xn[8], yn0[8], yn1[8];
            if (tn < NTOK) CB_LD_ROW(xn, yn0, yn1, an, tn);
            else {
#pragma unroll
                for (int j = 0; j < 8; ++j) { xn[j] = xw[j]; yn0[j] = aw[j]; yn1[j] = bw[j]; } }
            float w0 = ac.w0, w1 = ac.w1;
#ifdef DBG_ZERO_MOE1
                if (layer == 1) { w0 = 0.f; w1 = 0.f; }
#endif
            f32x4 v[8]; float s = 0.f;
#pragma unroll
            for (int j = 0; j < 8; ++j) { const u32x2 xv = xw[j]; v[j] = (f32x4){bflo(xv.x), bfhi(xv.x), bflo(xv.y), bfhi(xv.y)}; const u32x2 a = aw[j], b = bw[j];
                v[j][0] += w0 * bflo(a.x) + w1 * bflo(b.x); v[j][1] += w0 * bfhi(a.x) + w1 * bfhi(b.x); v[j][2] += w0 * bflo(a.y) + w1 * bflo(b.y); v[j][3] += w0 * bfhi(a.y) + w1 * bfhi(b.y);
                s += (v[j][0] * v[j][0] + v[j][1] * v[j][1]) + (v[j][2] * v[j][2] + v[j][3] * v[j][3]); }
            const float rstd = 1.0f / sqrtf(wave_sum(s) * (1.0f / DM) + RMS_EPS);
            if (layer == 0) {
                u32x2* o8 = (u32x2*)(XN2 + (size_t)t * DM) + lane;
#pragma unroll
                for (int j = 0; j < 8; ++j) { u32x2 w; w.x = cvt_pk_bf16(v[j][0], v[j][1]); w.y = cvt_pk_bf16(v[j][2], v[j][3]); __builtin_nontemporal_store(w, o8 + 64 * j); }
                if (lane == 0) X2[t] = rstd;
            } else {
                f32x4* oo = (f32x4*)(C.out + (size_t)t * DM) + lane; const f32x4* fg = (const f32x4*)fn + lane;
#pragma unroll
                for (int j = 0; j < 8; ++j) __builtin_nontemporal_store(v[j] * rstd * fg[64 * j], oo + 64 * j);
            }
            ac = an; an = a2;
#pragma unroll
            for (int j = 0; j < 8; ++j) { xw[j] = xn[j]; aw[j] = yn0[j]; bw[j] = yn1[j]; }
        }
#undef CB_LD_ASG
#undef CB_LD_ROW
    }
    if (layer == 0) SEAM(pb + 4);
}

__global__ void __launch_bounds__(NTHREADS, 2) fwd_kernel(Args args) {
    extern __shared__ __attribute__((aligned(16))) unsigned char lds_raw[];
    LAS unsigned char* lds = (LAS unsigned char*)lds_raw;
    volatile LAS unsigned* MISC = (volatile LAS unsigned*)(lds + MISC_OFF);
    const int tid = threadIdx.x, lane = tid & 63, wave = __builtin_amdgcn_readfirstlane(tid >> 6);
    const int G = gridDim.x; const int bx = blockIdx.x; const int vcu = (G % 8 == 0) ? (bx % 8) * (G / 8) + bx / 8 : bx;
    unsigned char* ws = args.ws;
    unsigned* ctl = (unsigned*)(ws + WS_CTL);
    for (int u = tid; u < (LDS_BYTES - MISC_OFF) / 4; u += NTHREADS) MISC[u] = 0u;
    __syncthreads();
#if !MK_PER_PHASE
    XcdBarrier bar = xcd_barrier_post(ctl + CW_BAR, MISC + MI_BAR);
#else
    XcdBarrier bar; bar.bar = nullptr; bar.x = 0; bar.st = nullptr;
#endif
    const int lo = args.ph_lo, hi = args.ph_hi;

    bf16_t* WinT = (bf16_t*)(ws + WS_WIN); bf16_t* WgT = (bf16_t*)(ws + WS_WG); bf16_t* WoutT = (bf16_t*)(ws + WS_WOUT); bf16_t* WkvqgT = (bf16_t*)(ws + WS_WKVQG);
    bf16_t* WoT = (bf16_t*)(ws + WS_WO); bf16_t* WrT = (bf16_t*)(ws + WS_WR); bf16_t* WmiT = (bf16_t*)(ws + WS_WMI); bf16_t* WmoT = (bf16_t*)(ws + WS_WMO);
    float* Lvec = (float*)(ws + WS_LVEC);
    bf16_t* H0 = (bf16_t*)(ws + WS_H0); bf16_t* Ub = (bf16_t*)(ws + WS_U); bf16_t* GY = (bf16_t*)(ws + WS_GY); bf16_t* UC = (bf16_t*)(ws + WS_UC);
    bf16_t* LAb = (bf16_t*)(ws + WS_LA); bf16_t* BBb = (bf16_t*)(ws + WS_BB); bf16_t* HS = (bf16_t*)(ws + WS_HS);
    bf16_t* X1B = (bf16_t*)(ws + WS_X1B); float* PART = (float*)(ws + WS_PART);
    bf16_t* IDN = (bf16_t*)(ws + WS_X2 + 4 * MiB);
    float* cLA = (float*)(ws + WS_CARRY); float* cH = cLA + 256 * DM;
    int* asg_e = (int*)(ws + WS_ASG); int* asg_r = asg_e + 2 * NTOK; float* asg_w = (float*)(asg_r + 2 * NTOK); float* rstd_tok = asg_w + 2 * NTOK; int* TH = (int*)(rstd_tok + NTOK);
    int* tokl = (int*)(ws + WS_TOKL); float* rsl = (float*)(ws + WS_RSL);
    bf16_t* ACT = (bf16_t*)(ws + (args.alt ? (size_t)3400 * MiB : WS_ACT)); bf16_t* YB = (bf16_t*)(ws + WS_YB);
    float* X2 = (float*)(ws + WS_X2); bf16_t* XN2 = (bf16_t*)(ws + WS_XN2);
    bf16_t* Kb = (bf16_t*)(ws + WS_KB); bf16_t* Vb = (bf16_t*)(ws + WS_VB); bf16_t* Qb = (bf16_t*)(ws + WS_QB); bf16_t* SG = (bf16_t*)(ws + WS_SG);
    float* FLOG = (float*)(ws + WS_FLOG); float* CUM = (float*)(ws + WS_CUM); bf16_t* OG = (bf16_t*)(ws + WS_OG);
    float* RS0 = (float*)(ws + WS_X2 + 2 * MiB);
    float* NRMF = (float*)(ws + WS_X2 + 1 * MiB);
    bf16_t* X3B = (bf16_t*)(ws + WS_X3B); float* PART3 = (float*)(ws + WS_PART3);
    const float* x_in = args.in[I_X];

    if (IN(0)) {
        LAS float* scr = (LAS float*)(lds + wave * 16384);
        const int gw = vcu * NWAVES + wave, NGW = G * NWAVES;
        constexpr int I1 = 32 * 64, I2 = 256, I3 = 32 * 32, I4 = 32 * 64, I5 = 32 * 64, I6 = 32 * 32, I8 = 2 * 64 * 512, I9 = 2 * 64 * 256;
        const int NITEMS = I1 + I2 + I3 + I4 + I5 + I6 + I8 + (G >= 256 ? I9 - DEFER_ITEMS : I9);
        for (int it = gw; it < NITEMS; it += NGW) {
            int r = it; const float* src; const float* gain = nullptr; bf16_t* dst; int ld, ldd;
            if (r < I1) { const int kb = r >> 6, nb = r & 63;
                src = args.in[I_AWIN] + (size_t)kb * 64 * 4096 + nb * 64; ld = 4096; gain = args.in[I_ANORM] + kb * 64; dst = WinT + (size_t)nb * 64 * DM + kb * 64; ldd = DM; }
            else if ((r -= I1) < I2) { const int which = r & 1, kb = (r >> 1) & 3, nh = (r >> 3) & 1, q = (r >> 4) & 1, nblk = r >> 5;
                src = args.in[which ? I_AWINP : I_AWREC] + (size_t)nblk * 65536 + (size_t)kb * 64 * 256 + q * 128 + nh * 64; ld = 256;
                dst = WgT + (size_t)(nblk * 512 + q * 256 + which * 128 + nh * 64) * 256 + kb * 64; ldd = 256; }
            else if ((r -= I2) < I3) { const int kb = r >> 5, nb = r & 31;
                src = args.in[I_AWOUT] + (size_t)kb * 64 * DM + nb * 64; ld = DM; dst = WoutT + (size_t)nb * 64 * DM + kb * 64; ldd = DM; }
            else if ((r -= I3) < I4) { const int kb = r >> 6, nb = r & 63;
                src = args.in[I_KVW] + (size_t)kb * 64 * 4112 + nb * 64; ld = 4112; gain = args.in[I_KVNORM] + kb * 64; dst = WkvqgT + (size_t)nb * 64 * DM + kb * 64; ldd = DM; }
            else if ((r -= I4) < I5) { const int kb = r >> 6, nb = r & 63;
                src = args.in[I_BWQG] + (size_t)kb * 64 * 4096 + nb * 64; ld = 4096; gain = args.in[I_BNORM] + kb * 64; dst = WkvqgT + (size_t)(4352 + nb * 64) * DM + kb * 64; ldd = DM; }
            else if ((r -= I5) < I6) { const int kb = r >> 5, nb = r & 31;
                src = args.in[I_BWO] + (size_t)kb * 64 * DM + nb * 64; ld = DM; dst = WoT + (size_t)nb * 64 * DM + kb * 64; ldd = DM; }
            else if ((r -= I6) < I8) { const int le = r >> 9, rr = r & 511, kb = rr >> 4, nb = rr & 15;
                const int pn = nb >> 2, half = (nb >> 1) & 1, sub = nb & 1; const int scol = half * 512 + pn * 128 + sub * 64, layer = le >> 6;
                src = args.in[I_MWIN] + (size_t)le * 2048 * 1024 + (size_t)kb * 64 * 1024 + scol; ld = 1024; gain = args.in[I_MNORM] + layer * DM + kb * 64;
                dst = WmiT + (size_t)le * 1024 * DM + (size_t)nb * 64 * DM + kb * 64; ldd = DM; }
            else { r -= I8; const int le = r >> 8, rr = r & 255, kb = rr >> 5, nb = rr & 31;
                src = args.in[I_MWOUT] + (size_t)le * 512 * DM + (size_t)kb * 64 * DM + nb * 64; ld = DM; dst = WmoT + (size_t)le * DM * 512 + (size_t)nb * 64 * 512 + kb * 64; ldd = 512; }
            cvt_item(src, ld, gain, dst, ldd, scr, lane);
        }
        const int gt = vcu * NTHREADS + tid, NGT = G * NTHREADS;
        for (int i = gt; i < 256 * DM; i += NGT) {
            const int n = i / DM, k = i % DM; float v = 0.f; if (n < 16) v = args.in[I_KVW][(size_t)k * 4112 + 4096 + n] * args.in[I_KVNORM][k];
            WkvqgT[(size_t)(4096 + n) * DM + k] = (bf16_t)(cvt_pk_bf16(v, 0.f) & 0xffffu); }
        for (int i = gt; i < 2 * 256 * DM; i += NGT) {
            const int layer = i / (256 * DM), n = (i / DM) % 256, k = i % DM; float v = 0.f;
            if (n < 8) v = args.in[I_MWGROUP][(size_t)layer * DM * 8 + (size_t)k * 8 + n]; else if (n < 72) v = args.in[I_MWROUTER][(size_t)layer * DM * 64 + (size_t)k * 64 + (n - 8)];
            v *= args.in[I_MNORM][layer * DM + k];
            WrT[i] = (bf16_t)(cvt_pk_bf16(v, 0.f) & 0xffffu); }
        for (int i = gt; i < 256 * 256; i += NGT) IDN[(size_t)(i >> 8) * DM + (i & 255)] = (bf16_t)((i >> 8) == (i & 255) ? 0x3F80 : 0);
        for (int i = gt; i < DM; i += NGT) { const float lam = args.in[I_ALAMBDA][i]; const float sp = fmaxf(-lam, 0.f) + log1pf(expf(-fabsf(lam))); Lvec[i] = -8.0f * sp; }
        for (int m = gw; m < NTOK; m += NGW) {
            const f32x4* xr = (const f32x4*)(x_in + (size_t)m * DM) + lane; f32x4 v[8]; float s = 0.f;
#pragma unroll
            for (int j = 0; j < 8; ++j) { v[j] = xr[64 * j]; s += (v[j][0] * v[j][0] + v[j][1] * v[j][1]) + (v[j][2] * v[j][2] + v[j][3] * v[j][3]); }
            const float rstd = 1.0f / sqrtf(wave_sum(s) * (1.0f / DM) + RMS_EPS);
            u32x2* o8 = (u32x2*)(H0 + (size_t)m * DM) + lane;
#pragma unroll
            for (int j = 0; j < 8; ++j) { u32x2 w; w.x = cvt_pk_bf16(v[j][0], v[j][1]); w.y = cvt_pk_bf16(v[j][2], v[j][3]); o8[64 * j] = w; }
            if (lane == 0) RS0[m] = rstd;
        }
    }
    SEAM(0);

    if (IN(1)) {
        pg8::Gemm g{H0, WinT, DM, DM, DM, nullptr, nullptr, nullptr}; pg8::DenseSched S; S.o.init(NTOK / 256, 4096 / 256, G, bx);
        pg8::EpiInProj E{Ub, GY, RS0};
        pg8::gemm_phase<pg8::EpiInProj, pg8::DenseSched, false, true>(lds, g, S, E);
    }
    SEAM(1);

    if (IN(2)) {
        const int tc = tid & 255, c0 = tc * 8; const float* cw = args.in[I_ACONVW]; const float* cbp = args.in[I_ACONVB];
        float w[4][8], cb[8];
#pragma unroll
        for (int j = 0; j < 4; ++j) { const f32x4 a = *(const f32x4*)(cw + j * DM + c0), b = *(const f32x4*)(cw + j * DM + c0 + 4);
#pragma unroll
            for (int e = 0; e < 4; ++e) { w[j][e] = a[e]; w[j][4 + e] = b[e]; } }
        { const f32x4 a = *(const f32x4*)(cbp + c0), b = *(const f32x4*)(cbp + c0 + 4);
#pragma unroll
          for (int e = 0; e < 4; ++e) { cb[e] = a[e]; cb[4 + e] = b[e]; } }
        for (int grp = vcu * 2 + (tid >> 8); grp < NTOK / 64; grp += G * 2) {
            const int row0 = grp * 64; float p1[8], p2[8], p3[8];
#pragma unroll
            for (int e = 0; e < 8; ++e) { p1[e] = 0.f; p2[e] = 0.f; p3[e] = 0.f; }
            if ((row0 % SEQ) != 0) {
                const u32x4 a = *(const u32x4*)(Ub + (size_t)(row0 - 1) * DM + c0), b = *(const u32x4*)(Ub + (size_t)(row0 - 2) * DM + c0), c = *(const u32x4*)(Ub + (size_t)(row0 - 3) * DM + c0);
                p1[0] = bflo(a.x); p1[1] = bfhi(a.x); p1[2] = bflo(a.y); p1[3] = bfhi(a.y); p1[4] = bflo(a.z); p1[5] = bfhi(a.z); p1[6] = bflo(a.w); p1[7] = bfhi(a.w);
                p2[0] = bflo(b.x); p2[1] = bfhi(b.x); p2[2] = bflo(b.y); p2[3] = bfhi(b.y); p2[4] = bflo(b.z); p2[5] = bfhi(b.z); p2[6] = bflo(b.w); p2[7] = bfhi(b.w);
                p3[0] = bflo(c.x); p3[1] = bfhi(c.x); p3[2] = bflo(c.y); p3[3] = bfhi(c.y); p3[4] = bflo(c.z); p3[5] = bfhi(c.z); p3[6] = bflo(c.w); p3[7] = bfhi(c.w);
            }
#pragma unroll 4
            for (int i = 0; i < 64; ++i) {
                const u32x4 a = __builtin_nontemporal_load((const u32x4*)(Ub + (size_t)(row0 + i) * DM + c0));
                const float cu[8] = {bflo(a.x), bfhi(a.x), bflo(a.y), bfhi(a.y), bflo(a.z), bfhi(a.z), bflo(a.w), bfhi(a.w)};
                float o[8];
#pragma unroll
                for (int e = 0; e < 8; ++e) { o[e] = cb[e] + w[3][e] * cu[e] + w[2][e] * p1[e] + w[1][e] * p2[e] + w[0][e] * p3[e]; p3[e] = p2[e]; p2[e] = p1[e]; p1[e] = cu[e]; }
                u32x4 ow; ow.x = cvt_pk_bf16(o[0], o[1]); ow.y = cvt_pk_bf16(o[2], o[3]); ow.z = cvt_pk_bf16(o[4], o[5]); ow.w = cvt_pk_bf16(o[6], o[7]);
                __builtin_nontemporal_store(ow, (u32x4*)(UC + (size_t)(row0 + i) * DM + c0));
            }
        }
    }
    SEAM(2);

    if (IN(3)) {
        pg8::Gemm g{UC, WgT, DM, 256, 256, nullptr, nullptr, nullptr}; pg8::GateSched S; S.o.init(NTOK / 256, 16, G, bx);
        pg8::EpiGates E{UC, LAb, BBb, Lvec, args.in[I_ABREC], args.in[I_ABINP]};
        pg8::gemm_phase<pg8::EpiGates, pg8::GateSched, false, true>(lds, g, S, E);
    }
    SEAM(3);

    if (IN(4)) {
        for (int it = vcu; it < 256; it += G) {
            const size_t base = (size_t)it * 128 * DM + 4 * tid;
            float h[4] = {0.f, 0.f, 0.f, 0.f}, sl[4] = {0.f, 0.f, 0.f, 0.f};
#pragma unroll 8
            for (int i = 0; i < 128; ++i) { const u32x2 lw = *(const u32x2*)(LAb + base + (size_t)i * DM), bw = *(const u32x2*)(BBb + base + (size_t)i * DM);
                const float l[4] = {bflo(lw.x), bfhi(lw.x), bflo(lw.y), bfhi(lw.y)}, b[4] = {bflo(bw.x), bfhi(bw.x), bflo(bw.y), bfhi(bw.y)};
#pragma unroll
                for (int e = 0; e < 4; ++e) { h[e] = fast_exp(l[e]) * h[e] + b[e]; sl[e] += l[e]; } }
            *(f32x4*)(cLA + (size_t)it * DM + 4 * tid) = (f32x4){sl[0], sl[1], sl[2], sl[3]}; *(f32x4*)(cH + (size_t)it * DM + 4 * tid) = (f32x4){h[0], h[1], h[2], h[3]};
        }
    }
    SEAM(4);

    if (IN(5)) {
        for (int it = vcu; it < 256; it += G) {
            const int chunk = it & 127, it0 = it - chunk;
            float h[4] = {0.f, 0.f, 0.f, 0.f};
#pragma unroll 4
            for (int j = 0; j < chunk; ++j) { const f32x4 a = *(const f32x4*)(cLA + (size_t)(it0 + j) * DM + 4 * tid), hh = *(const f32x4*)(cH + (size_t)(it0 + j) * DM + 4 * tid);
#pragma unroll
                for (int e = 0; e < 4; ++e) h[e] = fast_exp(a[e]) * h[e] + hh[e]; }
            const size_t base = (size_t)it * 128 * DM + 4 * tid;
#pragma unroll 8
            for (int i = 0; i < 128; ++i) { const u32x2 lw = __builtin_nontemporal_load((const u32x2*)(LAb + base + (size_t)i * DM)), bw = __builtin_nontemporal_load((const u32x2*)(BBb + base + (size_t)i * DM)), gw2 = __builtin_nontemporal_load((const u32x2*)(GY + base + (size_t)i * DM));
                const float l[4] = {bflo(lw.x), bfhi(lw.x), bflo(lw.y), bfhi(lw.y)}, b[4] = {bflo(bw.x), bfhi(bw.x), bflo(bw.y), bfhi(bw.y)}, gy[4] = {bflo(gw2.x), bfhi(gw2.x), bflo(gw2.y), bfhi(gw2.y)};
                float o[4];
#pragma unroll
                for (int e = 0; e < 4; ++e) { h[e] = fast_exp(l[e]) * h[e] + b[e]; o[e] = h[e] * gy[e]; }
                u32x2 ow; ow.x = cvt_pk_bf16(o[0], o[1]); ow.y = cvt_pk_bf16(o[2], o[3]); __builtin_nontemporal_store(ow, (u32x2*)(HS + base + (size_t)i * DM)); }
        }
    }
    SEAM(5);

    if (IN(6)) {
        pg8::Gemm g{HS, WoutT, DM, DM, DM, nullptr, H0, IDN}; pg8::DenseSched S; S.o.init(NTOK / 256, DM / 256, G, bx);
        pg8::EpiStoreRes E{X1B, PART};
        pg8::gemm_phase<pg8::EpiStoreRes, pg8::DenseSched, false, true>(lds, g, S, E);
    }
    SEAM(6);

    { MoeCtx MC{lds, MISC, ws, G, bx, vcu, wave, lo, hi, args.in[I_MBGROUP], args.in[I_MBROUTER], args.in[I_FNORM], args.out, args.in[I_MWOUT]};
      moe_block<0>(MC, bar); }

    if (IN(12)) {
        pg8::Gemm g{XN2, WkvqgT, DM, DM, DM, nullptr, nullptr, nullptr}; pg8::DenseSched S; S.o.init(NTOK / 256, NKVQG / 256, G, bx);
        pg8::EpiKVQG E{Kb, Vb, Qb, SG, FLOG, args.in[I_KVBF], X2};
        pg8::gemm_phase<pg8::EpiKVQG, pg8::DenseSched, false, true>(lds, g, S, E);
    }
    SEAM(12);
    if (IN(13)) {
        LAS float* wt = (LAS float*)lds;
        for (int it = vcu; it < NB * NHEAD; it += G) {
            const int b = it / NHEAD, h = it % NHEAD; float v[32]; float tot = 0.f;
#pragma unroll
            for (int i = 0; i < 32; ++i) { v[i] = FLOG[((size_t)b * SEQ + 32 * tid + i) * 16 + h]; tot += v[i]; v[i] = tot; }
            float incl = tot;
#pragma unroll
            for (int o = 1; o < 64; o <<= 1) { const float nb = __shfl_up(incl, o); if (lane >= o) incl += nb; }
            if (lane == 63) wt[wave] = incl;
            LDS_WAIT(); __syncthreads();
            float off = incl - tot;
            for (int w = 0; w < wave; ++w) off += wt[w];
            float* dst = CUM + (size_t)it * SEQ + 32 * tid;
#pragma unroll
            for (int i = 0; i < 8; ++i) *(f32x4*)(dst + 4 * i) = (f32x4){v[4 * i] + off, v[4 * i + 1] + off, v[4 * i + 2] + off, v[4 * i + 3] + off};
            __syncthreads();
        }
        const int nW = G > 64 ? G - 32 : G, w0 = G > 64 ? vcu - 32 : vcu;
        if (w0 >= 0) {
            LAS float* red = (LAS float*)(lds + 1024);
            float* QN2 = NRMF; float* DNG = NRMF + NB * NHEAD * 64; float* KN2 = NRMF + 2 * NB * NHEAD * 64;
            for (int u = w0; u < NB * NHEAD * 32; u += nW) {
                const int bh = u >> 5, ch = u & 31;
                const size_t base = (((size_t)bh * SEQ + ch * 512 + wave * 64 + (lane >> 4)) * HDIM + (lane & 15) * 8) * 2;
                const char* qp = (const char*)Qb + base; const char* kp = (const char*)Kb + base;
                float mq = 0.f, mk = 0.f, md = 0.f;
#pragma unroll 4
                for (int st = 0; st < 16; ++st) {
                    const u32x4 q = *(const u32x4*)(qp + st * 1024), k = *(const u32x4*)(kp + st * 1024);
                    float qq = 0.f, kk = 0.f, qk = 0.f;
#pragma unroll
                    for (int c = 0; c < 4; ++c) { const float ql = __uint_as_float(q[c] << 16), qh = __uint_as_float(q[c] & 0xffff0000u), kl = __uint_as_float(k[c] << 16), kh = __uint_as_float(k[c] & 0xffff0000u);
                        qq = fmaf(ql, ql, fmaf(qh, qh, qq)); kk = fmaf(kl, kl, fmaf(kh, kh, kk)); qk = fmaf(ql, kl, fmaf(qh, kh, qk)); }
#pragma unroll
                    for (int o = 1; o < 16; o <<= 1) { qq += __shfl_xor(qq, o); kk += __shfl_xor(kk, o); qk += __shfl_xor(qk, o); }
                    mq = fmaxf(mq, qq); mk = fmaxf(mk, kk); md = fmaxf(md, -qk);
                }
#pragma unroll
                for (int o = 16; o < 64; o <<= 1) { mq = fmaxf(mq, __shfl_xor(mq, o)); mk = fmaxf(mk, __shfl_xor(mk, o)); md = fmaxf(md, __shfl_xor(md, o)); }
                if (lane == 0) { KN2[bh * 256 + ch * 8 + wave] = mk; red[wave * 2 + 0] = mq; red[wave * 2 + 1] = md; }
                LDS_WAIT(); __syncthreads();
                if (tid < 4) { const int bq = tid >> 1, wq = tid & 1;
                    const float m = fmaxf(fmaxf(red[(bq * 4 + 0) * 2 + wq], red[(bq * 4 + 1) * 2 + wq]), fmaxf(red[(bq * 4 + 2) * 2 + wq], red[(bq * 4 + 3) * 2 + wq]));
                    (wq ? DNG : QN2)[bh * 64 + ch * 2 + bq] = m; }
                __syncthreads();
            }
        }
    }
    SEAM(13);
    if (IN(14)) {
        att::Tensors T{Qb, Kb, Vb, CUM, SG, OG, NRMF, ctl + CW_AQ};
        att::attn_phase((char*)lds_raw, T);
    }
    SEAM(14);
    if (IN(15)) {
        pg8::Gemm g{OG, WoT, DM, DM, DM, nullptr, XN2, IDN}; pg8::DenseSched S; S.o.init(NTOK / 256, DM / 256, G, bx);
        pg8::EpiStoreRes E{X3B, PART3};
        pg8::gemm_phase<pg8::EpiStoreRes, pg8::DenseSched, false, true>(lds, g, S, E);
    }
    SEAM(15);

    { MoeCtx MC{lds, MISC, ws, G, bx, vcu, wave, lo, hi, args.in[I_MBGROUP], args.in[I_MBROUTER], args.in[I_FNORM], args.out, args.in[I_MWOUT]};
      moe_block<1>(MC, bar); }

#ifdef DBG_CHECK_ATTN
    GRID_BAR();
    if (bx == 0 && threadIdx.x == 0) args.out[0] = 0.f;
    GRID_BAR();
    if (bx < 64) {
        int ctid = threadIdx.x; asm volatile("" : "+v"(ctid));
        LAS float* red = (LAS float*)lds; LAS float* qv = red + 512; LAS float* sc = qv + 128;
        const int smp = bx; const int bh = (smp * 7) % 32;
        const int tlist[16] = {0, 1, 31, 32, 63, 64, 255, 256, 257, 511, 4095, 4096, 8191, 12345, 15000, 16383};
        const int t = tlist[smp % 16]; const int b = bh / 16, h = bh % 16;
        if (ctid < 128) qv[ctid] = bf2f(Qb[((size_t)bh * SEQ + t) * 128 + ctid]);
        LDS_WAIT(); __syncthreads();
        const float ct = CUM[(size_t)bh * SEQ + t];
        float mx = -1e30f;
        for (int s0 = ctid; s0 <= t; s0 += NTHREADS) { float d = 0.f; for (int k = 0; k < 128; ++k) d += qv[k] * bf2f(Kb[((size_t)bh * SEQ + s0) * 128 + k]); d += ct - CUM[(size_t)bh * SEQ + s0]; sc[s0] = d; mx = fmaxf(mx, d); }
        red[ctid] = mx; LDS_WAIT(); __syncthreads(); for (int o = 256; o > 0; o >>= 1) { if (ctid < o) red[ctid] = fmaxf(red[ctid], red[ctid + o]); LDS_WAIT(); __syncthreads(); }
        const float m = red[0]; __syncthreads();
        float ls = 0.f;
        for (int s0 = ctid; s0 <= t; s0 += NTHREADS) { const float p = expf(sc[s0] - m); sc[s0] = p; ls += p; }
        red[ctid] = ls; LDS_WAIT(); __syncthreads(); for (int o = 256; o > 0; o >>= 1) { if (ctid < o) red[ctid] += red[ctid + o]; LDS_WAIT(); __syncthreads(); }
        const float l = red[0]; __syncthreads();
        float err = 0.f;
        if (ctid < 128) { float o = 0.f; for (int s0 = 0; s0 <= t; ++s0) o += sc[s0] * bf2f(Vb[((size_t)bh * SEQ + s0) * 128 + ctid]);
            const size_t gi = ((size_t)b * SEQ + t) * DM + h * 128 + ctid; const float ref = o / l * bf2f(SG[gi]); err = fabsf(ref - bf2f(OG[gi])); }
        red[ctid] = err; LDS_WAIT(); __syncthreads(); for (int o = 256; o > 0; o >>= 1) { if (ctid < o) red[ctid] = fmaxf(red[ctid], red[ctid + o]); LDS_WAIT(); __syncthreads(); }
        if (ctid == 0) atomicMax((int*)args.out, __float_as_int(red[0] * 1000.f));
    }
#endif

#ifdef DBG_CHECK_RGLRU
    GRID_BAR();
    if (bx == 0 && threadIdx.x == 0) args.out[0] = 0.f;
    GRID_BAR();
    if (bx < 16) {
        int ctid = threadIdx.x; asm volatile("" : "+v"(ctid));
        LAS float* lav = (LAS float*)lds; LAS float* bbv = lav + 16384;
        const int clist[8] = {0, 5, 255, 256, 1000, 1029, 1800, 2047};
        const int b = bx >> 3, c = clist[bx & 7], nb = c >> 8, cc = c & 255;
        const float* wr_ = args.in[I_AWREC] + (size_t)nb * 65536 + cc; const float* wi_ = args.in[I_AWINP] + (size_t)nb * 65536 + cc;
        const float brc = args.in[I_ABREC][c], bic = args.in[I_ABINP][c], lam = args.in[I_ALAMBDA][c];
        const float sp = fmaxf(-lam, 0.f) + log1pf(expf(-fabsf(lam)));
        for (int s0 = ctid; s0 < SEQ; s0 += NTHREADS) { const bf16_t* ur = UC + ((size_t)b * SEQ + s0) * DM + nb * 256; float rl = brc, il = bic;
            for (int k = 0; k < 256; ++k) { const float uk = bf2f(ur[k]); rl += uk * wr_[(size_t)k * 256]; il += uk * wi_[(size_t)k * 256]; }
            const float r = 1.f / (1.f + expf(-rl)), ig = 1.f / (1.f + expf(-il)); const float la = -8.f * r * sp; const float a2 = expf(2.f * la);
            lav[s0] = la; bbv[s0] = sqrtf(fmaxf(1.f - a2, 0.f)) * ig * bf2f(ur[cc]); }
        LDS_WAIT(); __syncthreads();
        if (ctid == 0) { float h = 0.f, err = 0.f;
            for (int s0 = 0; s0 < SEQ; ++s0) { h = expf(lav[s0]) * h + bbv[s0];
                if ((s0 & 127) == 127 || (s0 & 127) == 0 || s0 < 8) { const size_t gi = ((size_t)b * SEQ + s0) * DM + c; err = fmaxf(err, fabsf(h * bf2f(GY[gi]) - bf2f(HS[gi]))); } }
            atomicMax((int*)args.out, __float_as_int(err * 1000.f)); }
    }
#endif
#undef IN
#undef SEAM
}


#ifdef DBG_CMP
__global__ void dbg_cmp_kernel(const unsigned* a, const unsigned* b, const unsigned* gcnt, float* out, size_t nout) {
    unsigned long long bad = 0; size_t rows = 0;
    for (int e = 0; e < 64; ++e) rows += ((gcnt[e] + 255u) >> 8) << 8;
    const size_t n = rows * 512 / 2;
    for (size_t i = (size_t)blockIdx.x * blockDim.x + threadIdx.x; i < n; i += (size_t)gridDim.x * blockDim.x) if (a[i] != b[i]) ++bad;
    for (size_t i = (size_t)blockIdx.x * blockDim.x + threadIdx.x; i < nout; i += (size_t)gridDim.x * blockDim.x) out[i] = 0.f;
    if (bad) atomicAdd(out, (float)bad);
}
#endif

#ifdef DBG_VALID
__global__ void dbg_valid_kernel(const unsigned* buf, int nwords, const unsigned* gcnt, unsigned* out, size_t nout) {
    __shared__ int ts[65]; __shared__ int cn[64];
    if (threadIdx.x == 0) { int t = 0; for (int e = 0; e < 64; ++e) { ts[e] = t; cn[e] = (int)gcnt[e]; t += ((int)gcnt[e] + 255) >> 8; } ts[64] = t; }
    __syncthreads();
    for (size_t i = (size_t)blockIdx.x * blockDim.x + threadIdx.x; i < nout; i += (size_t)gridDim.x * blockDim.x) {
        const size_t row = i / nwords; unsigned v = 0u;
        if (row < (size_t)ts[64] * 256) { const int tile = (int)(row >> 8); int e = 0; while (e < 63 && ts[e + 1] <= tile) ++e;
            const int r = (int)(row - (size_t)ts[e] * 256); if (r < cn[e]) v = buf[i]; }
        out[i] = v; }
}
#endif

extern "C" void kernel_launch(void* const* d_in, const int* in_sizes, int n_in, void* d_out, int out_size, void* d_ws, size_t ws_size, hipStream_t stream) {
    static int grid = 0;
    if (grid == 0) {
        if (n_in != 25 || in_sizes[0] != NTOK * DM || out_size != NTOK * DM || ws_size < WS_END) {
            fprintf(stderr, "kernel_launch: unexpected shapes (n_in %d, in0 %d, out %d, ws %zu < %zu); nothing launched\n", n_in, n_in > 0 ? in_sizes[0] : -1, out_size, ws_size, (size_t)WS_END); grid = -1; return; }
        int dev = 0, cus = 0, per_cu = 0;
        if (hipGetDevice(&dev) != hipSuccess || hipDeviceGetAttribute(&cus, hipDeviceAttributeMultiprocessorCount, dev) != hipSuccess) { fprintf(stderr, "kernel_launch: device query failed\n"); grid = -1; return; }
        if (hipFuncSetAttribute((const void*)fwd_kernel, hipFuncAttributeMaxDynamicSharedMemorySize, LDS_BYTES) != hipSuccess) { fprintf(stderr, "kernel_launch: hipFuncSetAttribute failed\n"); grid = -1; return; }
        if (hipOccupancyMaxActiveBlocksPerMultiprocessor(&per_cu, (const void*)fwd_kernel, NTHREADS, LDS_BYTES) != hipSuccess || per_cu < 1)
            fprintf(stderr, "kernel_launch: note: occupancy query reports %d workgroups per CU\n", per_cu);
        (void)hipGetLastError();
        grid = cus;
    }
    if (grid < 0) return;
    if (hipMemsetAsync((char*)d_ws + WS_CTL, 0, CTL_ZERO_BYTES, stream) != hipSuccess) { fprintf(stderr, "kernel_launch: memset failed\n"); return; }
    Args a{};
    for (int i = 0; i < 25; ++i) a.in[i] = (const float*)d_in[i];
    a.out = (float*)d_out; a.ws = (unsigned char*)d_ws;
#if MK_PER_PHASE
#ifndef DBG_LAST
#define DBG_LAST (NPHASES - 1)
#endif
    for (int p = 0; p <= DBG_LAST; ++p) { a.ph_lo = p; a.ph_hi = p + 1; hipLaunchKernelGGL(fwd_kernel, dim3(grid), dim3(NTHREADS), LDS_BYTES, stream, a); }
#ifdef DBG_OUT
    hipMemcpyAsync(d_out, (char*)d_ws + DBG_OUT, (size_t)NTOK * DM * 4, hipMemcpyDeviceToDevice, stream);
#endif
#ifdef DBG_VALID
    hipLaunchKernelGGL(dbg_valid_kernel, dim3(2048), dim3(256), 0, stream, (const unsigned*)((char*)d_ws + DBG_VALID), DBG_VALID_WORDS, (const unsigned*)d_ws + CW_GCNT + 64 * DBG_VALID_LAYER, (unsigned*)d_out, (size_t)NTOK * DM);
#endif
#ifdef DBG_CMP
    a.alt = 1; a.ph_lo = DBG_LAST; a.ph_hi = DBG_LAST + 1; hipLaunchKernelGGL(fwd_kernel, dim3(grid), dim3(NTHREADS), LDS_BYTES, stream, a); a.alt = 0;
    hipLaunchKernelGGL(dbg_cmp_kernel, dim3(1024), dim3(256), 0, stream, (const unsigned*)((char*)d_ws + WS_ACT), (const unsigned*)((char*)d_ws + (size_t)3400 * MiB), (const unsigned*)d_ws + CW_GCNT + 64, (float*)d_out, (size_t)NTOK * DM);
#endif
#else
    a.ph_lo = 0; a.ph_hi = NPHASES;
    hipLaunchKernelGGL(fwd_kernel, dim3(grid), dim3(NTHREADS), LDS_BYTES, stream, a);
#ifdef PROBE_EXTRA
    { const int plist[] = {PROBE_EXTRA}; for (int r = 0; r < PROBE_REPS; ++r) for (int p : plist) { if (p == 14) hipMemsetAsync((char*)d_ws + WS_CTL + CW_AQ * 4, 0, 4, stream); a.ph_lo = p; a.ph_hi = p + 1; hipLaunchKernelGGL(fwd_kernel, dim3(grid), dim3(NTHREADS), LDS_BYTES, stream, a); } }
#endif
#endif
    const hipError_t le = hipPeekAtLastError();
    if (le != hipSuccess) fprintf(stderr, "kernel_launch: launch failed: %s\n", hipGetErrorName(le));
}
```

```cpp
#include <hip/hip_runtime.h>
#include <cstdio>
#include <cstdint>


#ifndef MK_PER_PHASE
#define MK_PER_PHASE 0
#endif

#define LAS __attribute__((address_space(3)))
#define GAS __attribute__((address_space(1)))
typedef unsigned short bf16_t;
typedef short bf16x8 __attribute__((ext_vector_type(8)));
typedef short s16x4 __attribute__((ext_vector_type(4)));
typedef float f32x4 __attribute__((ext_vector_type(4)));
typedef float f32x2 __attribute__((ext_vector_type(2)));
typedef float f32x16 __attribute__((ext_vector_type(16)));
typedef unsigned u32x4 __attribute__((ext_vector_type(4)));
typedef unsigned u32x2 __attribute__((ext_vector_type(2)));

constexpr int NB = 2, SEQ = 16384, DM = 2048, NTOK = NB * SEQ;
constexpr int NHEAD = 16, HDIM = 128;
constexpr int NEXP = 64, DEXP = 512, LCAP = 65536;
constexpr int NKVQG = 8448;
constexpr float RMS_EPS = 1e-6f;
constexpr int NWAVES = 8, NTHREADS = 512;

constexpr size_t MiB = (size_t)1 << 20;
constexpr size_t WS_CTL = 0, CTL_ZERO_BYTES = 1 * MiB;
constexpr size_t WS_WIN = 1 * MiB, WS_WG = 17 * MiB, WS_WOUT = 19 * MiB, WS_WKVQG = 27 * MiB, WS_WO = 60 * MiB, WS_WR = 68 * MiB;
constexpr size_t WS_WMI = 70 * MiB, WS_WMO = 582 * MiB, WS_LVEC = 838 * MiB;
constexpr size_t WS_H0 = 839 * MiB, WS_U = 967 * MiB, WS_GY = 1095 * MiB, WS_UC = 1223 * MiB, WS_LA = 1351 * MiB, WS_BB = 1479 * MiB, WS_HS = 1607 * MiB;
constexpr size_t WS_X1B = 1735 * MiB, WS_PART = 1863 * MiB, WS_CARRY = 1867 * MiB;
constexpr size_t WS_ASG = 1871 * MiB, WS_TOKL = 1873 * MiB, WS_RSL = 1889 * MiB, WS_ACT = 1905 * MiB, WS_YB = 1985 * MiB;
constexpr size_t WS_X2 = 2305 * MiB, WS_XN2 = 2561 * MiB;
constexpr size_t WS_KB = 2689 * MiB, WS_VB = 2817 * MiB, WS_QB = 2945 * MiB, WS_SG = 3073 * MiB, WS_OG = 3201 * MiB;
constexpr size_t WS_FLOG = 3329 * MiB, WS_CUM = 3331 * MiB;
constexpr size_t WS_X3B = 3333 * MiB, WS_PART3 = 3461 * MiB;
constexpr size_t WS_MOE1 = 3465 * MiB, MOE_LAYER_STRIDE = WS_MOE1 - WS_ASG;
constexpr size_t WS_END = WS_MOE1 + 434 * MiB;
constexpr int CW_BAR = 4096;
constexpr int CW_GCNT = 8192;
constexpr int CW_NRM = 12288;
constexpr int CW_AQ = 13440;

constexpr int RING_BYTES = 131072;
constexpr int MISC_OFF = 139264;
constexpr int LDS_BYTES = 147456;
constexpr int MI_BAR = 0, MI_TSTART = 16, MI_CNT = 96;

__device__ __forceinline__ unsigned cvt_pk_bf16(float lo, float hi) { unsigned r; asm volatile("s_nop 0\n\tv_cvt_pk_bf16_f32 %0, %1, %2" : "=v"(r) : "v"(lo), "v"(hi)); return r; }
__device__ __forceinline__ float bflo(unsigned w) { return __uint_as_float(w << 16); }
__device__ __forceinline__ float bfhi(unsigned w) { return __uint_as_float(w & 0xffff0000u); }
__device__ __forceinline__ float bf2f(bf16_t h) { return __uint_as_float(((unsigned)h) << 16); }
__device__ __forceinline__ float fast_exp(float x) { return __builtin_amdgcn_exp2f(x * 1.4426950408889634f); }
__device__ __forceinline__ float fast_sigmoid(float x) { return __builtin_amdgcn_rcpf(1.0f + fast_exp(-x)); }
__device__ __forceinline__ float wave_sum(float v) {
#pragma unroll
    for (int o = 1; o < 64; o <<= 1) v += __shfl_xor(v, o);
    return v;
}
#define LDS_WAIT() asm volatile("s_waitcnt lgkmcnt(0)" ::: "memory")
#define VM_WAIT() asm volatile("s_waitcnt vmcnt(0)" ::: "memory")

#define XB_TMO      128
#define XB_XCNT(j)  (256  + 64 * (j))
#define XB_XSUB(j)  (1280 + 64 * (j))
#define XB_XGEN(j)  (2304 + 64 * (j))
#define XB_TOP      3328
#define XB_TOPGEN   3392
#define XCD_BAR_WORDS 3456
#define XB_SPIN_CAP (1u << 18)

__device__ __forceinline__ unsigned xb_ld(unsigned* p)              { return __hip_atomic_load(p, __ATOMIC_RELAXED, __HIP_MEMORY_SCOPE_AGENT); }
__device__ __forceinline__ unsigned xb_add(unsigned* p, unsigned v) { return __hip_atomic_fetch_add(p, v, __ATOMIC_RELAXED, __HIP_MEMORY_SCOPE_AGENT); }
__device__ __forceinline__ unsigned xb_xcc_id() { return (unsigned)__builtin_amdgcn_s_getreg((3 << 11) | 20) & 0xFu; }
#define XB_SPIN(cond, bar) do { unsigned _sp = 0; while (cond) { __builtin_amdgcn_s_sleep(1); \
    if ((++_sp & 255u) == 0u) { if (xb_ld(&(bar)[XB_TMO])) break; if (_sp > XB_SPIN_CAP) { atomicAdd(&(bar)[XB_TMO], 1u); break; } } } } while (0)

struct XcdBarrier { unsigned* bar; unsigned x; volatile LAS unsigned* st; };

__device__ __forceinline__ XcdBarrier xcd_barrier_post(unsigned* bar, volatile LAS unsigned* st) {
    XcdBarrier b; b.bar = bar; b.x = xb_xcc_id(); b.st = st;
    if (threadIdx.x == 0) (void)xb_add(&bar[XB_XCNT(b.x)], 1u);
    return b;
}
__device__ __forceinline__ void xcd_barrier_complete(unsigned* bar, unsigned x, unsigned& nloc, unsigned& nx) {
    const unsigned G = gridDim.x * gridDim.y * gridDim.z;
    unsigned sum, cnt, mine, sp = 0u;
    for (;;) {
        sum = 0u; cnt = 0u; mine = 0u;
#pragma unroll
        for (unsigned j = 0; j < 16; ++j) { const unsigned c = xb_ld(&bar[XB_XCNT(j)]); sum += c; cnt += (c > 0u) ? 1u : 0u; mine = (j == x) ? c : mine; }
        if (sum == G) break;
        __builtin_amdgcn_s_sleep(1);
        if ((++sp & 255u) == 0u) { if (xb_ld(&bar[XB_TMO])) break; if (sp > XB_SPIN_CAP) { atomicAdd(&bar[XB_TMO], 1u); break; } }
    }
    nloc = mine > 0u ? mine : 1u; nx = cnt > 0u ? cnt : 1u;
}
__device__ __forceinline__ void xcd_barrier(const XcdBarrier& b) {
    asm volatile("s_waitcnt vmcnt(0)" ::: "memory");
    __syncthreads();
    if (threadIdx.x == 0) {
        unsigned* bar = b.bar;
        __builtin_amdgcn_s_waitcnt(0);
        unsigned nloc = b.st[0], nx = b.st[1];
        if (nloc == 0u) { xcd_barrier_complete(bar, b.x, nloc, nx); b.st[0] = nloc; b.st[1] = nx; }
        const unsigned old = xb_add(&bar[XB_XSUB(b.x)], 1u);
        const unsigned gen = old / nloc;
        if (old + 1u == (gen + 1u) * nloc) {
            __builtin_amdgcn_fence(__ATOMIC_RELEASE, "agent");
            asm volatile("s_waitcnt vmcnt(0)" ::: "memory");
            const unsigned og = xb_add(&bar[XB_TOP], 1u);
            const unsigned tg = og / nx;
            if (og + 1u == (tg + 1u) * nx) xb_add(&bar[XB_TOPGEN], 1u);
            else XB_SPIN(xb_ld(&bar[XB_TOPGEN]) == tg, bar);
            __builtin_amdgcn_fence(__ATOMIC_ACQUIRE, "agent");
            xb_add(&bar[XB_XGEN(b.x)], 1u);
            asm volatile("s_waitcnt vmcnt(0)" ::: "memory");
        } else {
            XB_SPIN(xb_ld(&bar[XB_XGEN(b.x)]) == gen, bar);
            __builtin_amdgcn_fence(__ATOMIC_ACQUIRE, "agent");
            asm volatile("s_waitcnt vmcnt(0)" ::: "memory");
        }
    }
    __syncthreads();
}

namespace pg8 {
constexpr int BM = 256, BK = 64, HALF = 128, HTB = HALF * BK * 2, STAGE_BYTES = 8 * HTB, NXCD = 8, WGM = 8;
__host__ __device__ __forceinline__ int lds_byte(int r, int c) { const int st = (r >> 4) * 2 + (c >> 5), rr = r & 15, cc = c & 31, ob = rr * 64 + cc * 2; return st * 1024 + (ob ^ (((ob >> 9) & 1) << 5)); }
__host__ __device__ __forceinline__ void stage_rc(int b, int& R, int& C) { const int st = b / 1024, sb = b % 1024, swz = sb ^ (((sb >> 9) & 1) << 5); R = (st >> 1) * 16 + swz / 64; C = (st & 1) * 32 + (swz % 64) / 2; }
__host__ __device__ __forceinline__ int perm32(int rho) { const int n = rho >> 4, i = rho & 15; return 8 * (i >> 2) + 4 * n + (i & 3); }

struct Unit { int a0, acol, b0, pm, pn, e, nv, prow0; };
struct Gemm { const bf16_t* A; const bf16_t* Bt; int lda, ldb, K; const int* glist; const bf16_t* R; const bf16_t* I; };

__device__ __forceinline__ int xcd_remap(int L, int nwg) { const int q = nwg / NXCD, r = nwg % NXCD, xcd = L % NXCD, off = L / NXCD; return (xcd < r ? xcd * (q + 1) : r * (q + 1) + (xcd - r) * q) + off; }
struct GridOrder {
    int nM, nN, nwg, G, c;
    __device__ __forceinline__ void init(int nM_, int nN_, int G_, int c_) { nM = nM_; nN = nN_; nwg = nM * nN; G = G_; c = c_; }
    __device__ __forceinline__ bool tile(int i, int& pm, int& pn) const {
        const long L = (long)i * G + c; if (L >= nwg) return false;
        const int wgid = xcd_remap((int)L, nwg);
        const int nig = WGM * nN, gid = wgid / nig, fm = gid * WGM, gsz = (nM - fm) < WGM ? (nM - fm) : WGM;
        pm = fm + ((wgid % nig) % gsz); pn = (wgid % nig) / gsz; return true;
    }
};
struct DenseSched { GridOrder o;
    __device__ __forceinline__ bool next(int i, Unit& u) const { int pm, pn; if (!o.tile(i, pm, pn)) return false; u.pm = pm; u.pn = pn; u.a0 = pm * BM; u.acol = 0; u.b0 = pn * BM; u.e = 0; u.nv = BM; u.prow0 = pm * BM; return true; } };
struct GateSched { GridOrder o;
    __device__ __forceinline__ bool next(int i, Unit& u) const { int pm, pn; if (!o.tile(i, pm, pn)) return false; u.pm = pm; u.pn = pn; u.a0 = pm * BM; u.acol = (pn >> 1) * 256; u.b0 = pn * BM; u.e = 0; u.nv = BM; u.prow0 = pm * BM; return true; } };
template <bool GATHER> struct MoeSched {
    const LAS int* tstart; const LAS int* cnt; int NTN, G, c, nunits, brows;
    __device__ __forceinline__ bool next(int i, Unit& u) const {
        const long L = (long)i * G + c; if (L >= nunits) return false;
        const int wgid = xcd_remap((int)L, nunits);
        int lane = threadIdx.x & 63; asm volatile("" : "+v"(lane));
        const int uend = tstart[lane + 1] * NTN;
        const int e = __builtin_popcountll(__ballot(uend <= wgid));
        const int ts = tstart[e], nte = tstart[e + 1] - ts, idx = wgid - ts * NTN;
        const int mt = idx % nte, nt = idx / nte;
        const int ce = cnt[e];
        u.e = e; u.pm = mt; u.pn = nt; u.prow0 = (ts + mt) * BM; u.nv = (ce - mt * BM) < BM ? (ce - mt * BM) : BM;
        u.a0 = GATHER ? (e * LCAP + mt * BM) : u.prow0; u.acol = 0; u.b0 = e * brows + nt * BM;
        return true;
    }
};

template <class Epi, class Sched, bool GATHER, bool ALIGN_EPI>
__device__ __forceinline__ void gemm_phase(LAS unsigned char* lds, const Gemm g, const Sched& S, const Epi& E) {
    int tid = threadIdx.x; asm volatile("" : "+v"(tid));
    const int wid = __builtin_amdgcn_readfirstlane(tid >> 6), lane = tid & 63, wr = wid >> 2, wc = wid & 3, fr = lane & 15, fq = lane >> 4;
    const int K = g.K, nt = K / BK, ntot = nt + (Epi::RESK ? BM / BK : 0);
    int Rr[2], Cc[2];
    unsigned voffB[2];
#pragma unroll
    for (int i = 0; i < 2; ++i) { int R, C; stage_rc(tid * 16 + i * 8192, R, C); Rr[i] = R; Cc[i] = C; const int Rb = Epi::PERM ? ((R & ~31) + perm32(R & 31)) : R;
        voffB[i] = (unsigned)(Rb * g.ldb + C) * 2u; }
    const size_t kstep = (size_t)(BK * 2);
    const size_t hstepB = (size_t)HALF * g.ldb * 2;
    const unsigned ldsw = (unsigned)wid * 1024u;
    const int aoff = lds_byte(wr * 64 + fr, fq * 8), boff = lds_byte(wc * 32 + fr, fq * 8);
#define PG8_SA(b, h) (((b) * 2 + (h)) * HTB)
#define PG8_SB(b, h) ((4 + (b) * 2 + (h)) * HTB)
#define PG8_STAGE_B(bufoff, gbase) do { _Pragma("unroll") for (int _i = 0; _i < 2; ++_i) \
        __builtin_amdgcn_global_load_lds((const unsigned*)((const char*)(gbase) + voffB[_i]), (LAS unsigned*)(lds + (bufoff) + ldsw + _i * 8192), 16, 0, 0); } while (0)
#define PG8_STAGE_A(bufoff, gbase, vo, h) do { _Pragma("unroll") for (int _i = 0; _i < 2; ++_i) \
        __builtin_amdgcn_global_load_lds((const unsigned*)((const char*)(gbase) + (vo)[h][_i]), (LAS unsigned*)(lds + (bufoff) + ldsw + _i * 8192), 16, 0, 0); } while (0)
#define PG8_LDA(dst, b, h) do { _Pragma("unroll") for (int m = 0; m < 4; ++m) _Pragma("unroll") for (int k = 0; k < 2; ++k) dst[m][k] = *(const LAS bf16x8*)(lds + PG8_SA(b, h) + aoff + m * 2048 + k * 1024); } while (0)
#define PG8_LDB(dst, b, h) do { _Pragma("unroll") for (int n = 0; n < 2; ++n) _Pragma("unroll") for (int k = 0; k < 2; ++k) dst[n][k] = *(const LAS bf16x8*)(lds + PG8_SB(b, h) + boff + n * 2048 + k * 1024); } while (0)
#define PG8_MMA(ai, bj, At, Bt) do { __builtin_amdgcn_s_setprio(1); _Pragma("unroll") for (int m = 0; m < 4; ++m) _Pragma("unroll") for (int n = 0; n < 2; ++n) _Pragma("unroll") for (int k = 0; k < 2; ++k) \
        acc[ai][bj][m][n] = __builtin_amdgcn_mfma_f32_16x16x32_bf16(Bt[n][k], At[m][k], acc[ai][bj][m][n], 0, 0, 0); __builtin_amdgcn_s_setprio(0); } while (0)
#define PG8_WAIT_V(n) asm volatile("s_waitcnt vmcnt(" #n ")" ::: "memory")
#define PG8_WAIT_L(n) asm volatile("s_waitcnt lgkmcnt(" #n ")" ::: "memory")
#define PG8_BAR __builtin_amdgcn_s_barrier()
#define PG8_SCHED __builtin_amdgcn_sched_barrier(0)
#define PG8_AOFFS(vo, u) do { _Pragma("unroll") for (int _h = 0; _h < 2; ++_h) _Pragma("unroll") for (int _i = 0; _i < 2; ++_i) { const int _r = _h * HALF + Rr[_i]; \
        if (GATHER) { int _t = g.glist[(u).a0 + _r]; _t = (_r < (u).nv) ? _t : 0; (vo)[_h][_i] = (unsigned)(_t * g.lda + Cc[_i]) * 2u; } \
        else (vo)[_h][_i] = (unsigned)(_r * g.lda + Cc[_i]) * 2u; } } while (0)
#define PG8_ABASE(u) ((const char*)g.A + (GATHER ? (size_t)(u).acol * 2 : ((size_t)(u).a0 * g.lda + (u).acol) * 2))
    Unit cur, nxt; int ui = 0;
    if (!S.next(0, cur)) return;
    f32x4 acc[2][2][4][2];
#pragma unroll
    for (int a = 0; a < 2; ++a)
#pragma unroll
        for (int b = 0; b < 2; ++b)
#pragma unroll
            for (int m = 0; m < 4; ++m)
#pragma unroll
                for (int n = 0; n < 2; ++n) acc[a][b][m][n] = (f32x4){0.f, 0.f, 0.f, 0.f};
    bf16x8 At[4][2], B0[2][2], B1[2][2];
    unsigned vA[2][2], vN[2][2];
    PG8_AOFFS(vA, cur);
    const char* cA = PG8_ABASE(cur); const char* cB = (const char*)g.Bt + (size_t)cur.b0 * g.ldb * 2;
    PG8_STAGE_B(PG8_SB(0, 0), cB); PG8_STAGE_B(PG8_SB(0, 1), cB + hstepB); PG8_STAGE_A(PG8_SA(0, 0), cA, vA, 0); PG8_STAGE_A(PG8_SA(0, 1), cA, vA, 1);
    if (wr == 1) PG8_BAR;
    PG8_WAIT_V(2); PG8_BAR;
    PG8_STAGE_B(PG8_SB(1, 0), cB + kstep); PG8_STAGE_A(PG8_SA(1, 0), cA + kstep, vA, 0); PG8_STAGE_B(PG8_SB(1, 1), cB + hstepB + kstep);
    PG8_WAIT_V(6); PG8_BAR;
    for (;;) {
        const bool has_next = S.next(ui + 1, nxt);
        const char* nA = cA; const char* nB = cB;
        if (has_next) { nA = PG8_ABASE(nxt); nB = (const char*)g.Bt + (size_t)nxt.b0 * g.ldb * 2; }
        if (GATHER) { if (has_next) { PG8_AOFFS(vN, nxt); } else {
#pragma unroll
            for (int _h = 0; _h < 2; ++_h)
#pragma unroll
                for (int _i = 0; _i < 2; ++_i) vN[_h][_i] = vA[_h][_i]; } }
#pragma nounroll
        for (int t = 0; t < ntot; t += 2) {
            const bool last = (t == ntot - 2);
            const char* a1; const char* a2; const char* b2;
            if constexpr (Epi::RESK) {
                const char* rA = (const char*)g.R + ((size_t)cur.prow0 * g.lda + (size_t)cur.pn * BM) * 2;
                a1 = (t < nt ? cA + (size_t)t * kstep : rA + (size_t)(t - nt) * kstep) + kstep;
                a2 = last ? nA : (t + 2 < nt ? cA + (size_t)(t + 2) * kstep : rA + (size_t)(t + 2 - nt) * kstep);
                b2 = last ? nB : (t + 2 < nt ? cB + (size_t)(t + 2) * kstep : (const char*)g.I + (size_t)(t + 2 - nt) * kstep);
            } else {
                a1 = cA + (size_t)(t + 1) * kstep;
                a2 = last ? nA : cA + (size_t)(t + 2) * kstep; b2 = last ? nB : cB + (size_t)(t + 2) * kstep; }
            const char* a3 = a2 + kstep; const char* b3 = b2 + kstep;
            unsigned v2[2][2];
#pragma unroll
            for (int _h = 0; _h < 2; ++_h)
#pragma unroll
                for (int _i = 0; _i < 2; ++_i) v2[_h][_i] = (GATHER && last) ? vN[_h][_i] : vA[_h][_i];
            PG8_LDB(B0, 0, 0); PG8_LDB(B1, 0, 1); PG8_SCHED; PG8_LDA(At, 0, 0); PG8_STAGE_A(PG8_SA(1, 1), a1, vA, 1);
            PG8_WAIT_V(8); PG8_WAIT_L(0); PG8_BAR; PG8_MMA(0, 0, At, B0); PG8_MMA(0, 1, At, B1); PG8_BAR; PG8_SCHED;
            PG8_LDA(At, 0, 1); PG8_STAGE_B(PG8_SB(0, 0), b2); PG8_STAGE_B(PG8_SB(0, 1), b2 + hstepB); PG8_STAGE_A(PG8_SA(0, 0), a2, v2, 0);
            PG8_WAIT_V(8); PG8_WAIT_L(0); PG8_BAR; PG8_MMA(1, 0, At, B0); PG8_MMA(1, 1, At, B1); PG8_BAR; PG8_SCHED;
            PG8_LDB(B0, 1, 0); PG8_LDB(B1, 1, 1); PG8_SCHED; PG8_LDA(At, 1, 0); PG8_STAGE_A(PG8_SA(0, 1), a2, v2, 1);
            PG8_WAIT_V(8); PG8_WAIT_L(0); PG8_BAR; PG8_MMA(0, 0, At, B0); PG8_MMA(0, 1, At, B1); PG8_BAR; PG8_SCHED;
            PG8_LDA(At, 1, 1); PG8_STAGE_B(PG8_SB(1, 0), b3); PG8_STAGE_B(PG8_SB(1, 1), b3 + hstepB); PG8_STAGE_A(PG8_SA(1, 0), a3, v2, 0);
            PG8_WAIT_V(8); PG8_WAIT_L(0); PG8_BAR; PG8_MMA(1, 0, At, B0); PG8_MMA(1, 1, At, B1); PG8_BAR; PG8_SCHED;
        }
        if constexpr (ALIGN_EPI) { if (wr == 0) PG8_BAR; }
        if constexpr (!Epi::AFTER_DRAIN) { E(acc, cur, wr, wc, fr, fq); }
        if (!has_next) break;
#pragma unroll
        for (int a = 0; a < 2; ++a)
#pragma unroll
            for (int b = 0; b < 2; ++b)
#pragma unroll
                for (int m = 0; m < 4; ++m)
#pragma unroll
                    for (int n = 0; n < 2; ++n) acc[a][b][m][n] = (f32x4){0.f, 0.f, 0.f, 0.f};
        cur = nxt; cA = nA; cB = nB; ++ui;
        if (GATHER) {
#pragma unroll
            for (int _h = 0; _h < 2; ++_h)
#pragma unroll
                for (int _i = 0; _i < 2; ++_i) vA[_h][_i] = vN[_h][_i]; }
        if constexpr (ALIGN_EPI) { if (wr == 1) PG8_BAR; }
    }
    PG8_WAIT_V(0);
    if constexpr (!ALIGN_EPI) { if (wr == 0) PG8_BAR; }
    PG8_BAR;
    if constexpr (Epi::AFTER_DRAIN) { E.fused(acc, cur, wr, wc, fr, fq, lds, wid, lane); }
#undef PG8_SA
#undef PG8_SB
#undef PG8_STAGE_A
#undef PG8_STAGE_B
#undef PG8_LDA
#undef PG8_LDB
#undef PG8_MMA
#undef PG8_WAIT_V
#undef PG8_WAIT_L
#undef PG8_BAR
#undef PG8_SCHED
#undef PG8_AOFFS
#undef PG8_ABASE
}

__device__ __forceinline__ u32x4 pack8(const f32x4& a, const f32x4& b) { u32x4 w; w.x = cvt_pk_bf16(a[0], a[1]); w.y = cvt_pk_bf16(a[2], a[3]); w.z = cvt_pk_bf16(b[0], b[1]); w.w = cvt_pk_bf16(b[2], b[3]); return w; }
__device__ __forceinline__ float gelu_tanh(float y) {
    const float t = y * (1.0f + 0.044715f * y * y);
    return y * __builtin_amdgcn_rcpf(1.0f + __builtin_amdgcn_exp2f(t * (-2.0f * 0.7978845608028654f * 1.4426950408889634f)));
}

struct EpiInProj {
    static constexpr bool PERM = true, AFTER_DRAIN = false, RESK = false;
    bf16_t* U; bf16_t* GY; const float* RS;
    __device__ __forceinline__ void operator()(const f32x4 (&acc)[2][2][4][2], const Unit& u, int wr, int wc, int fr, int fq) const {
        const bool isy = u.pn >= 8; bf16_t* base = isy ? GY : U; const int colt = (isy ? u.pn - 8 : u.pn) * BM + wc * 32 + 8 * fq;
        float rs[2][4];
#pragma unroll
        for (int ai = 0; ai < 2; ++ai)
#pragma unroll
            for (int m = 0; m < 4; ++m) rs[ai][m] = RS[u.pm * BM + ai * HALF + wr * 64 + m * 16 + fr];
#pragma unroll
        for (int ai = 0; ai < 2; ++ai)
#pragma unroll
            for (int m = 0; m < 4; ++m) { bf16_t* rowp = base + (size_t)(u.pm * BM + ai * HALF + wr * 64 + m * 16 + fr) * DM + colt;
#pragma unroll
                for (int bj = 0; bj < 2; ++bj) { f32x4 v0 = acc[ai][bj][m][0] * rs[ai][m], v1 = acc[ai][bj][m][1] * rs[ai][m];
                    if (isy) {
#pragma unroll
                        for (int j = 0; j < 4; ++j) { v0[j] = gelu_tanh(v0[j]); v1[j] = gelu_tanh(v1[j]); } }
                    *(u32x4*)(rowp + bj * HALF) = pack8(v0, v1); } }
    }
};
struct EpiGates {
    static constexpr bool PERM = true, AFTER_DRAIN = false, RESK = false;
    const bf16_t* UC; bf16_t* LA; bf16_t* BB; const float* Lv; const float* brec; const float* binp;
    __device__ __forceinline__ void operator()(const f32x4 (&acc)[2][2][4][2], const Unit& u, int wr, int wc, int fr, int fq) const {
        const int cb = (u.pn >> 1) * 256 + (u.pn & 1) * 128 + wc * 32 + 8 * fq;
        u32x4 uw[2][4];
#pragma unroll
        for (int ai = 0; ai < 2; ++ai)
#pragma unroll
            for (int m = 0; m < 4; ++m) uw[ai][m] = *(const u32x4*)(UC + (size_t)(u.pm * BM + ai * HALF + wr * 64 + m * 16 + fr) * DM + cb);
#pragma unroll
        for (int ai = 0; ai < 2; ++ai)
#pragma unroll
            for (int m = 0; m < 4; ++m) { const size_t off = (size_t)(u.pm * BM + ai * HALF + wr * 64 + m * 16 + fr) * DM + cb;
                u32x4 lw, bw;
#pragma unroll
                for (int n = 0; n < 2; ++n) {
                    const f32x4 Lc = *(const f32x4*)(Lv + cb + 4 * n), rb = *(const f32x4*)(brec + cb + 4 * n), ib = *(const f32x4*)(binp + cb + 4 * n);
                    const unsigned ux = n ? uw[ai][m].z : uw[ai][m].x, uy = n ? uw[ai][m].w : uw[ai][m].y;
                    const float uu[4] = {bflo(ux), bfhi(ux), bflo(uy), bfhi(uy)};
                    float la[4], bb[4];
#pragma unroll
                    for (int j = 0; j < 4; ++j) {
                        const float r = fast_sigmoid(acc[ai][0][m][n][j] + rb[j]), ig = fast_sigmoid(acc[ai][1][m][n][j] + ib[j]);
                        const float l = r * Lc[j];
                        const float a2 = fast_exp(2.0f * l);
                        la[j] = l; bb[j] = __builtin_amdgcn_sqrtf(fmaxf(1.0f - a2, 0.0f)) * ig * uu[j]; }
                    if (n == 0) { lw.x = cvt_pk_bf16(la[0], la[1]); lw.y = cvt_pk_bf16(la[2], la[3]); bw.x = cvt_pk_bf16(bb[0], bb[1]); bw.y = cvt_pk_bf16(bb[2], bb[3]); }
                    else        { lw.z = cvt_pk_bf16(la[0], la[1]); lw.w = cvt_pk_bf16(la[2], la[3]); bw.z = cvt_pk_bf16(bb[0], bb[1]); bw.w = cvt_pk_bf16(bb[2], bb[3]); } }
                *(u32x4*)(LA + off) = lw; *(u32x4*)(BB + off) = bw; }
    }
};
struct EpiResid {
    static constexpr bool PERM = true, AFTER_DRAIN = false, RESK = false;
    const float* base; bf16_t* XB;
    __device__ __forceinline__ void operator()(const f32x4 (&acc)[2][2][4][2], const Unit& u, int wr, int wc, int fr, int fq) const {
        const int col0 = u.pn * BM + wc * 32 + 8 * fq;
#pragma unroll
        for (int ai = 0; ai < 2; ++ai)
#pragma unroll
            for (int m = 0; m < 4; ++m) { const int row = u.pm * BM + ai * HALF + wr * 64 + m * 16 + fr; const size_t off = (size_t)row * DM + col0;
#pragma unroll
                for (int bj = 0; bj < 2; ++bj) { const f32x4 b0 = *(const f32x4*)(base + off + bj * HALF), b1 = *(const f32x4*)(base + off + bj * HALF + 4);
                    *(u32x4*)(XB + off + bj * HALF) = pack8(acc[ai][bj][m][0] + b0, acc[ai][bj][m][1] + b1); } }
    }
};
struct EpiResidB {
    static constexpr bool PERM = true, AFTER_DRAIN = false, RESK = false;
    const bf16_t* base; bf16_t* XB;
    __device__ __forceinline__ void operator()(const f32x4 (&acc)[2][2][4][2], const Unit& u, int wr, int wc, int fr, int fq) const {
        const int col0 = u.pn * BM + wc * 32 + 8 * fq;
        u32x4 bw[2][4][2];
#pragma unroll
        for (int ai = 0; ai < 2; ++ai)
#pragma unroll
            for (int m = 0; m < 4; ++m)
#pragma unroll
                for (int bj = 0; bj < 2; ++bj) bw[ai][m][bj] = *(const u32x4*)(base + (size_t)(u.pm * BM + ai * HALF + wr * 64 + m * 16 + fr) * DM + col0 + bj * HALF);
#pragma unroll
        for (int ai = 0; ai < 2; ++ai)
#pragma unroll
            for (int m = 0; m < 4; ++m) { const int row = u.pm * BM + ai * HALF + wr * 64 + m * 16 + fr; const size_t off = (size_t)row * DM + col0;
#pragma unroll
                for (int bj = 0; bj < 2; ++bj) { const u32x4 b = bw[ai][m][bj];
                    const f32x4 b0 = {bflo(b.x), bfhi(b.x), bflo(b.y), bfhi(b.y)}, b1 = {bflo(b.z), bfhi(b.z), bflo(b.w), bfhi(b.w)};
                    *(u32x4*)(XB + off + bj * HALF) = pack8(acc[ai][bj][m][0] + b0, acc[ai][bj][m][1] + b1); } }
    }
};
struct EpiStoreRes {
    static constexpr bool PERM = true, AFTER_DRAIN = false, RESK = true;
    bf16_t* XB; float* part;
    __device__ __forceinline__ void operator()(const f32x4 (&acc)[2][2][4][2], const Unit& u, int wr, int wc, int fr, int fq) const {
        const int col0 = u.pn * BM + wc * 32 + 8 * fq;
#pragma unroll
        for (int ai = 0; ai < 2; ++ai)
#pragma unroll
            for (int m = 0; m < 4; ++m) { const int row = u.pm * BM + ai * HALF + wr * 64 + m * 16 + fr; bf16_t* rowp = XB + (size_t)row * DM + col0; float ss = 0.f;
#pragma unroll
                for (int bj = 0; bj < 2; ++bj) { const f32x4 v0 = acc[ai][bj][m][0], v1 = acc[ai][bj][m][1];
                    *(u32x4*)(rowp + bj * HALF) = pack8(v0, v1);
                    ss += ((v0[0] * v0[0] + v0[1] * v0[1]) + (v0[2] * v0[2] + v0[3] * v0[3])) + ((v1[0] * v1[0] + v1[1] * v1[1]) + (v1[2] * v1[2] + v1[3] * v1[3])); }
                ss += __shfl_xor(ss, 16); ss += __shfl_xor(ss, 32);
                if (fq == 0) part[(size_t)row * 32 + u.pn * 4 + wc] = ss; }
    }
};
struct EpiMoe1 {
    static constexpr bool PERM = true, AFTER_DRAIN = false, RESK = false;
    const float* RS; bf16_t* ACT;
    __device__ __forceinline__ void operator()(const f32x4 (&acc)[2][2][4][2], const Unit& u, int wr, int wc, int fr, int fq) const {
        const int col0 = u.pn * 128 + wc * 32 + 8 * fq;
#pragma unroll
        for (int ai = 0; ai < 2; ++ai) {
            float sv[4];
#pragma unroll
            for (int m = 0; m < 4; ++m) sv[m] = RS[u.a0 + ai * HALF + wr * 64 + m * 16 + fr];
#pragma unroll
            for (int m = 0; m < 4; ++m) { const int r = ai * HALF + wr * 64 + m * 16 + fr; const float s = sv[m]; f32x4 o[2];
#pragma unroll
                for (int n = 0; n < 2; ++n)
#pragma unroll
                    for (int j = 0; j < 4; ++j) { const float gg = acc[ai][0][m][n][j] * s, up = acc[ai][1][m][n][j] * s; o[n][j] = gg * fast_sigmoid(gg) * up; }
                *(u32x4*)(ACT + (size_t)(u.prow0 + r) * DEXP + col0) = pack8(o[0], o[1]); } }
    }
};
struct EpiMoe2 {
    static constexpr bool PERM = true, AFTER_DRAIN = false, RESK = false;
    bf16_t* Y;
    __device__ __forceinline__ void operator()(const f32x4 (&acc)[2][2][4][2], const Unit& u, int wr, int wc, int fr, int fq) const {
        const int col0 = u.pn * BM + wc * 32 + 8 * fq;
#pragma unroll
        for (int ai = 0; ai < 2; ++ai)
#pragma unroll
            for (int m = 0; m < 4; ++m) { const int r = ai * HALF + wr * 64 + m * 16 + fr; bf16_t* rowp = Y + (size_t)(u.prow0 + r) * DM + col0;
#pragma unroll
                for (int bj = 0; bj < 2; ++bj) *(u32x4*)(rowp + bj * HALF) = pack8(acc[ai][bj][m][0], acc[ai][bj][m][1]); }
    }
};
struct EpiKVQG {
    static constexpr bool PERM = true, AFTER_DRAIN = false, RESK = false;
    bf16_t* Kb; bf16_t* Vb; bf16_t* Qb; bf16_t* SG; float* FLOG; const float* fbias; const float* RS;
    __device__ __forceinline__ void operator()(const f32x4 (&acc)[2][2][4][2], const Unit& u, int wr, int wc, int fr, int fq) const {
        const int pn = u.pn;
        float rs[2][4];
#pragma unroll
        for (int ai = 0; ai < 2; ++ai)
#pragma unroll
            for (int m = 0; m < 4; ++m) rs[ai][m] = RS[u.pm * BM + ai * HALF + wr * 64 + m * 16 + fr];
        if (pn == 16) {
            if (wc == 0 && fq < 2) { const f32x4 fb0 = *(const f32x4*)(fbias + 8 * fq), fb1 = *(const f32x4*)(fbias + 8 * fq + 4);
#pragma unroll
                for (int ai = 0; ai < 2; ++ai)
#pragma unroll
                    for (int m = 0; m < 4; ++m) { const int row = u.pm * BM + ai * HALF + wr * 64 + m * 16 + fr; f32x4 o[2];
#pragma unroll
                        for (int n = 0; n < 2; ++n)
#pragma unroll
                            for (int j = 0; j < 4; ++j) { const float z = acc[ai][0][m][n][j] * rs[ai][m] + (n ? fb1[j] : fb0[j]); o[n][j] = fminf(z, 0.f) - 0.6931471805599453f * __builtin_amdgcn_logf(1.0f + __builtin_amdgcn_exp2f(-1.4426950408889634f * fabsf(z))); }
                        *(f32x4*)(FLOG + (size_t)row * 16 + 8 * fq) = o[0]; *(f32x4*)(FLOG + (size_t)row * 16 + 8 * fq + 4) = o[1]; } }
            return; }
        if (pn >= 25) {
            const int col0 = (pn - 25) * BM + wc * 32 + 8 * fq;
#pragma unroll
            for (int ai = 0; ai < 2; ++ai)
#pragma unroll
                for (int m = 0; m < 4; ++m) { bf16_t* rowp = SG + (size_t)(u.pm * BM + ai * HALF + wr * 64 + m * 16 + fr) * DM + col0;
#pragma unroll
                    for (int bj = 0; bj < 2; ++bj) { f32x4 v0 = acc[ai][bj][m][0], v1 = acc[ai][bj][m][1];
#pragma unroll
                        for (int j = 0; j < 4; ++j) { v0[j] = fast_sigmoid(v0[j] * rs[ai][m]); v1[j] = fast_sigmoid(v1[j] * rs[ai][m]); }
                        *(u32x4*)(rowp + bj * HALF) = pack8(v0, v1); } }
            return; }
        bf16_t* base; int ct; float sc = 1.f;
        if (pn < 8) { base = Kb; ct = pn; } else if (pn < 16) { base = Vb; ct = pn - 8; } else { base = Qb; ct = pn - 17; sc = 0.08838834764831845f; }
        const int bidx = (u.pm * BM) / SEQ, s0 = (u.pm * BM) % SEQ;
#pragma unroll
        for (int ai = 0; ai < 2; ++ai)
#pragma unroll
            for (int m = 0; m < 4; ++m) { const int s = s0 + ai * HALF + wr * 64 + m * 16 + fr;
#pragma unroll
                for (int bj = 0; bj < 2; ++bj) { const int h = ct * 2 + bj;
                    *(u32x4*)(base + ((size_t)(bidx * NHEAD + h) * SEQ + s) * HDIM + wc * 32 + 8 * fq) = pack8(acc[ai][bj][m][0] * (sc * rs[ai][m]), acc[ai][bj][m][1] * (sc * rs[ai][m])); } }
    }
};
struct EpiRouter {
    static constexpr bool PERM = false, AFTER_DRAIN = true, RESK = false;
    const float* PR; const float* bgroup; const float* brouter; int* TH;
    int* asg_e; int* asg_r; float* asg_w; float* rstd_tok;
    __device__ __forceinline__ void fused(const f32x4 (&acc)[2][2][4][2], const Unit& u, int wr, int wc, int fr, int fq, LAS unsigned char* lds, int wid, int lane) const {
        LAS float* Lg = (LAS float*)lds;
        LAS int* cntw = (LAS int*)(lds + 256 * 73 * 4);
        LAS int* offw = cntw + 512;
        const int tid = wid * 64 + lane;
        if (wc < 3) {
#pragma unroll
            for (int ai = 0; ai < 2; ++ai)
#pragma unroll
                for (int m = 0; m < 4; ++m) { const int row = ai * HALF + wr * 64 + m * 16 + fr;
#pragma unroll
                    for (int n = 0; n < 2; ++n) { const int col = wc * 32 + 16 * n + 4 * fq;
                        if (col < 72) {
#pragma unroll
                            for (int j = 0; j < 4; ++j) Lg[row * 73 + col + j] = acc[ai][0][m][n][j]; } } } }
        LDS_WAIT(); __builtin_amdgcn_s_barrier(); asm volatile("" ::: "memory");
        int e0 = 0, e1 = 0, l0 = 0, l1 = 0; float w0 = 0.f, w1 = 0.f, rstd = 0.f; const int t = u.pm * BM + tid;
        if (wid < 4) {
            LAS float* ssq = (LAS float*)(offw + 512);
            const f32x4* pp = (const f32x4*)(PR + (size_t)(u.pm * BM + tid) * 32); float s = 0.f;
#pragma unroll
            for (int i = 0; i < 8; ++i) { const f32x4 w = pp[i]; s += (w[0] + w[1]) + (w[2] + w[3]); }
            ssq[tid] = s;
        }
        LDS_WAIT(); __builtin_amdgcn_s_barrier(); asm volatile("" ::: "memory");
        if (wid < 4) {
            rstd = 1.0f / sqrtf(((LAS float*)(offw + 512))[tid] * (1.0f / DM) + RMS_EPS);
            float gm = -3.0e38f; int g = 0; float gl[8];
#pragma unroll
            for (int j = 0; j < 8; ++j) { gl[j] = Lg[tid * 73 + j] * rstd + bgroup[j]; if (gl[j] > gm) { gm = gl[j]; g = j; } }
            float gs = 0.f;
#pragma unroll
            for (int j = 0; j < 8; ++j) gs += expf(gl[j] - gm);
            const float gp = 1.0f / gs;
            float m1 = -3.0e38f, m2 = -3.0e38f; int i1 = 0, i2 = 0;
#pragma unroll
            for (int j = 0; j < 8; ++j) { const float v = Lg[tid * 73 + 8 + g * 8 + j] * rstd + brouter[g * 8 + j];
                if (v > m1) { m2 = m1; i2 = i1; m1 = v; i1 = j; } else if (v > m2) { m2 = v; i2 = j; } }
            const float ex = expf(m2 - m1); w0 = gp / (1.0f + ex); w1 = gp * ex / (1.0f + ex);
            e0 = g * 8 + i1; e1 = g * 8 + i2;
            const unsigned long long ltm = (1ull << lane) - 1ull; int c0 = 0, c1 = 0;
            for (int e = 0; e < 64; ++e) {
                const unsigned long long m0 = __ballot(e0 == e), mm1 = __ballot(e1 == e);
                if (e0 == e) l0 = __builtin_popcountll(m0 & ltm);
                if (e1 == e) l1 = __builtin_popcountll(mm1 & ltm);
                if (lane == e) { c0 = __builtin_popcountll(m0); c1 = __builtin_popcountll(mm1); } }
            cntw[(0 * 4 + wid) * 64 + lane] = c0; cntw[(1 * 4 + wid) * 64 + lane] = c1;
        }
        LDS_WAIT(); __builtin_amdgcn_s_barrier(); asm volatile("" ::: "memory");
        if (tid < 64) { int run = 0;
#pragma unroll
            for (int kw = 0; kw < 8; ++kw) { offw[kw * 64 + tid] = run; run += cntw[kw * 64 + tid]; }
            TH[u.pm * 64 + tid] = run; }
        LDS_WAIT(); __builtin_amdgcn_s_barrier(); asm volatile("" ::: "memory");
        if (wid < 4) {
            const int r0 = offw[(0 * 4 + wid) * 64 + e0] + l0, r1 = offw[(1 * 4 + wid) * 64 + e1] + l1;
            asg_e[2 * t] = e0; asg_e[2 * t + 1] = e1; asg_r[2 * t] = r0; asg_r[2 * t + 1] = r1; asg_w[2 * t] = w0; asg_w[2 * t + 1] = w1; rstd_tok[t] = rstd;
        }
    }
};
}

namespace att {
constexpr int NW = 8, QBLK = 32, KVBLK = 64, QB = NW * QBLK, D = 128;
constexpr int SHM_V = KVBLK * D * 2, SHM_K = KVBLK * D * 2;
constexpr int CK_OFF = 2 * SHM_V + 2 * SHM_K + NW * 64 * 4;
constexpr int LDS_ATT = CK_OFF + 512;
constexpr int TBL_OFF = LDS_ATT + 64, TBL_BYTES = 272 * 4, TBLM_OFF = TBL_OFF + 2 * TBL_BYTES, ORD_OFF = TBLM_OFF + 64, CAP_OFF = ORD_OFF + 2048 * 2;
constexpr int OT_RS = 288, OT_WAVE = 32 * OT_RS, OT_OFF = (CAP_OFF + 128 + 127) & ~127;
static_assert(OT_OFF + (NW - 1) * OT_WAVE <= 139264, "attention LDS: waves 0..6 below the kernel's MISC words (barrier state), wave 7 in K buffer 1");
static_assert(OT_WAVE <= SHM_K, "attention LDS");
constexpr float THR = 8.f;
constexpr int OROW = DM;
enum { ORDER_PAIRED = 2, ORDER_XCD = 4 };

#define KSWZ(row, colB) ((row) * 256 + ((colB) ^ (((row) & 7) << 4)))
#define SBAR() __builtin_amdgcn_sched_barrier(0)
__device__ __forceinline__ int v_st(int k, int c) { const int kk = (k & ~0xC) | ((k & 4) << 1) | ((k & 8) >> 1); return ((kk >> 3) * 4 + (c >> 5)) * 512 + ((kk & 7) * 32 + (c & 31)) * 2; }
__device__ __forceinline__ int v_rd_base(int lane) { return ((lane & 3) << 3) | (((lane >> 2) & 3) << 6) | (((lane >> 4) & 1) << 5) | (((lane >> 5) & 1) << 8); }
constexpr int v_rd_off(int d0, int ks, int half) { return d0 * 512 + ks * 4096 + half * 2048; }
__device__ __forceinline__ int crow(int r, int hi) { return (r & 3) + 8 * (r >> 2) + 4 * hi; }
__device__ __forceinline__ bf16x8 load8(const bf16_t* p) { return *reinterpret_cast<const bf16x8*>(p); }

__device__ __forceinline__ void mask_tile(f32x16& p0, f32x16& p1, int dq, unsigned W) {
    const float NEG = -__builtin_inff();
#pragma unroll
    for (int r = 0; r < 16; ++r) {
        const int c = (r & 3) + 8 * (r >> 2);
        if ((unsigned)(dq - c) >= W) p0[r] = NEG;
        if ((unsigned)(dq - c - 32) >= W) p1[r] = NEG;
    }
}
__device__ __forceinline__ void partialSM(f32x16& p0, f32x16& p1, float& m_reg, float& mn, float& alpha, float thr = THR) {
    float pmax = p0[0];
#pragma unroll
    for (int r = 1; r < 16; ++r) pmax = fmaxf(pmax, p0[r]);
#pragma unroll
    for (int r = 0; r < 16; ++r) pmax = fmaxf(pmax, p1[r]);
    { auto rr = __builtin_amdgcn_permlane32_swap(__float_as_uint(pmax), __float_as_uint(pmax), false, false);
      pmax = fmaxf(__uint_as_float(rr[0]), __uint_as_float(rr[1])); }
    constexpr float C2 = 1.4426950408889634f;
    if (__builtin_expect(__all((pmax - m_reg) <= thr), 1)) { mn = m_reg; alpha = 1.f; }
    else { mn = fmaxf(m_reg, pmax); alpha = __builtin_amdgcn_exp2f((m_reg - mn) * C2); m_reg = mn; }
    const float mnL = -mn * C2;
#pragma unroll
    for (int r = 0; r < 16; ++r) p0[r] = fmaf(p0[r], C2, mnL);
#pragma unroll
    for (int r = 0; r < 16; ++r) p1[r] = fmaf(p1[r], C2, mnL);
#pragma unroll
    for (int r = 0; r < 16; ++r) p0[r] = __builtin_amdgcn_exp2f(p0[r]);
}
__device__ __forceinline__ void finishSM(f32x16& p0, f32x16& p1, float alpha, float& l_reg, bf16x8& pa0, bf16x8& pa1, bf16x8& pa2, bf16x8& pa3) {
#pragma unroll
    for (int r = 0; r < 16; ++r) p1[r] = __builtin_amdgcn_exp2f(p1[r]);
    float ps = 0;
#pragma unroll
    for (int r = 0; r < 16; ++r) ps += p0[r];
#pragma unroll
    for (int r = 0; r < 16; ++r) ps += p1[r];
    { auto rr = __builtin_amdgcn_permlane32_swap(__float_as_uint(ps), __float_as_uint(ps), false, false);
      ps = __uint_as_float(rr[0]) + __uint_as_float(rr[1]); }
    l_reg = l_reg * alpha + ps;
#define PK4(P, B_, OUT) do { unsigned a0 = cvt_pk_bf16(P[B_+0], P[B_+1]), a1 = cvt_pk_bf16(P[B_+2], P[B_+3]);                          \
        unsigned b0 = cvt_pk_bf16(P[B_+4], P[B_+5]), b1 = cvt_pk_bf16(P[B_+6], P[B_+7]);                                             \
        auto r0 = __builtin_amdgcn_permlane32_swap(a0, b0, false, false); auto r1 = __builtin_amdgcn_permlane32_swap(a1, b1, false, false); \
        u32x4 w = {r0[0], r1[0], r0[1], r1[1]}; OUT = *reinterpret_cast<bf16x8*>(&w); } while (0)
    PK4(p0, 0, pa0); PK4(p0, 8, pa1); PK4(p1, 0, pa2); PK4(p1, 8, pa3);
#undef PK4
}
template <int KB>
__device__ __forceinline__ void qkt(f32x16& p0, f32x16& p1, const char* K_lds, const char* ck_lds, int r32, int hi, const bf16x8* qr) {
    const float* ckb = (const float*)(ck_lds + KB * 256) + 4 * hi;
#pragma unroll
    for (int g = 0; g < 4; ++g) { const f32x4 c0 = *(const f32x4*)(ckb + 8 * g), c1 = *(const f32x4*)(ckb + 32 + 8 * g);
#pragma unroll
        for (int j = 0; j < 4; ++j) { p0[4 * g + j] = c0[j]; p1[4 * g + j] = c1[j]; } }
    const char* kb[4];
#pragma unroll
    for (int dd = 0; dd < 4; ++dd) kb[dd] = K_lds + KB * SHM_K + KSWZ(r32, (dd * 16 + hi * 8) * 2);
#pragma unroll
    for (int d0 = 0; d0 < 8; ++d0) { const char* a = kb[d0 & 3] + (d0 >> 2) * 128;
        bf16x8 b0 = *reinterpret_cast<const bf16x8*>(a);
        bf16x8 b1 = *reinterpret_cast<const bf16x8*>(a + 32 * 256);
        p0 = __builtin_amdgcn_mfma_f32_32x32x16_bf16(b0, qr[d0], p0, 0, 0, 0);
        p1 = __builtin_amdgcn_mfma_f32_32x32x16_bf16(b1, qr[d0], p1, 0, 0, 0); }
}
template <int VB>
__device__ __forceinline__ void pv_tile(f32x16* o, int vb0, bf16x8 pa0, bf16x8 pa1, bf16x8 pa2, bf16x8 pa3) {
#define TRRD(dst, off) asm volatile("ds_read_b64_tr_b16 %0, %1 offset:%2" : "=&v"(dst) : "v"(vb0), "i"(off) : "memory")
#define PV_D0(d0) do { s16x4 l0, l1, l2, l3, h0, h1, h2, h3; constexpr int b_ = VB * SHM_V + v_rd_off(d0, 0, 0); \
        TRRD(l0, b_); TRRD(h0, b_ + 2048); TRRD(l1, b_ + 4096); TRRD(h1, b_ + 6144); TRRD(l2, b_ + 8192); TRRD(h2, b_ + 10240); TRRD(l3, b_ + 12288); TRRD(h3, b_ + 14336); \
        asm volatile("s_waitcnt lgkmcnt(0)" ::: "memory"); SBAR();   \
        o[d0] = __builtin_amdgcn_mfma_f32_32x32x16_bf16(pa0, (bf16x8){l0[0], l0[1], l0[2], l0[3], h0[0], h0[1], h0[2], h0[3]}, o[d0], 0, 0, 0);   \
        o[d0] = __builtin_amdgcn_mfma_f32_32x32x16_bf16(pa1, (bf16x8){l1[0], l1[1], l1[2], l1[3], h1[0], h1[1], h1[2], h1[3]}, o[d0], 0, 0, 0);   \
        o[d0] = __builtin_amdgcn_mfma_f32_32x32x16_bf16(pa2, (bf16x8){l2[0], l2[1], l2[2], l2[3], h2[0], h2[1], h2[2], h2[3]}, o[d0], 0, 0, 0);   \
        o[d0] = __builtin_amdgcn_mfma_f32_32x32x16_bf16(pa3, (bf16x8){l3[0], l3[1], l3[2], l3[3], h3[0], h3[1], h3[2], h3[3]}, o[d0], 0, 0, 0); } while (0)
    PV_D0(0); PV_D0(1); PV_D0(2); PV_D0(3);
#undef PV_D0
#undef TRRD
}

struct Tensors { const bf16_t* Q; const bf16_t* K; const bf16_t* V; const float* C; const bf16_t* G; bf16_t* O; const float* nrm; unsigned* queue; };
constexpr float SKIP_EPS = 0.99f * 5.9604645e-8f / 64.f;
struct Blk { int L; int jlo; int tb; };
constexpr int NBH = NB * NHEAD, NQB = SEQ / (NW * QBLK);
__device__ __forceinline__ int blk_bh(int L) { return L >> 6; }
__device__ __forceinline__ int blk_qb(int L) { return L & 63; }
struct Seam { bf16x8 qr[8]; bf16x8 st_v0, st_v1, st_k0, st_k1; float st_c; };
#define VMW() asm volatile("s_waitcnt vmcnt(0)" ::: "memory")
#define VMWN(n) asm volatile("s_waitcnt vmcnt(%0)" :: "i"(n) : "memory")
#define LD16(base, off) (*(const bf16x8*)((const char*)(base) + (off)))
#define SLOAD_H(Kp, Vp, Cp, k0, cbf) do { const bf16_t* kt_ = (Kp) + (size_t)(k0) * D; const bf16_t* vt_ = (Vp) + (size_t)(k0) * D;              \
                         S.st_v0 = LD16(vt_, so0); S.st_v1 = LD16(vt_, so1); S.st_k0 = LD16(kt_, so0); S.st_k1 = LD16(kt_, so1);            \
                         S.st_c = *(const float*)((const char*)((Cp) + (k0)) + co); } while (0)
#define SWRITE_HK(bf) do { *(bf16x8*)(K_lds + (bf) * SHM_K + kws) = S.st_k0; *(bf16x8*)(K_lds + (bf) * SHM_K + kws + 32 * 256) = S.st_k1; \
                         if (wid == 0) *(float*)(ck_lds + (bf) * 256 + co) = -S.st_c; } while (0)
#define SWRITE_HV(bf) do { *(bf16x8*)(V_lds + (bf) * SHM_V + vst0) = S.st_v0; *(bf16x8*)(V_lds + (bf) * SHM_V + vst1) = S.st_v1; } while (0)
#define SWRITE_H(bf) do { SWRITE_HV(bf); SWRITE_HK(bf); } while (0)
__device__ __forceinline__ void attn_prime(const Tensors& T, const Blk cb, char* lds, Seam& S) {
    const int tid = threadIdx.x, wid = __builtin_amdgcn_readfirstlane(tid >> 6), lane = tid & 63, r32 = lane & 31, hi = lane >> 5;
    const int sr = tid >> 4, sc = (tid & 15) * 8, kws = KSWZ(sr, sc * 2); char* K_lds = lds + 2 * SHM_V; char* ck_lds = lds + CK_OFF;
    const unsigned so0 = (unsigned)((sr * D + sc) * 2), so1 = so0 + 32 * D * 2, co = (unsigned)(lane * 4), qo = (unsigned)((r32 * D + hi * 8) * 2);
    const int bh = blk_bh(cb.L), P0 = blk_qb(cb.L) * QB;
    const bf16_t* Kh = T.K + (size_t)bh * SEQ * D; const bf16_t* Vh = T.V + (size_t)bh * SEQ * D; const float* Ch = T.C + (size_t)bh * SEQ;
    { const bf16_t* qb_ = T.Q + ((size_t)bh * SEQ + P0 + wid * QBLK) * D;
#pragma unroll
      for (int d0 = 0; d0 < 8; ++d0) S.qr[d0] = LD16(qb_, qo + d0 * 32);
    }
    SLOAD_H(Kh, Vh, Ch, ((P0 + QB - 1) / KVBLK) * KVBLK, 0); VMW(); SWRITE_HK(0);
    __syncthreads();
}
__device__ __forceinline__ void attn_block(const Tensors& T, const Blk cb, const Blk nb, char* lds, Seam& S) {
    const int tid = threadIdx.x, wid = __builtin_amdgcn_readfirstlane(tid >> 6), lane = tid & 63, r32 = lane & 31, hi = lane >> 5;
    constexpr int W = SEQ;
    const int cbh = blk_bh(cb.L), cP0 = blk_qb(cb.L) * QB;
    const int jhi = (cP0 + QB - 1) / KVBLK; int NT = jhi + 1 - cb.jlo;
    const int qlo = cP0 + wid * QBLK;
    char* V_lds = lds; char* K_lds = lds + 2 * SHM_V; char* ck_lds = lds + CK_OFF;
    float* ws = (float*)(lds + 2 * SHM_V + 2 * SHM_K) + wid * 64; float* li_l = ws, * al_l = ws + 32;
    float m_reg = -1e30f, l_reg = 0; f32x16 o[4] = {};
    const int sr = tid >> 4, sc = (tid & 15) * 8, vst0 = v_st(sr, sc), vst1 = v_st(32 + sr, sc), kws = KSWZ(sr, sc * 2);
    const unsigned so0 = (unsigned)((sr * D + sc) * 2), so1 = so0 + 32 * D * 2, co = (unsigned)(lane * 4), qo = (unsigned)((r32 * D + hi * 8) * 2);
    const int vb0 = (int)(uintptr_t)V_lds + v_rd_base(lane);
    const bf16_t* Kh = T.K + (size_t)cbh * SEQ * D; const bf16_t* Vh = T.V + (size_t)cbh * SEQ * D; const float* Ch = T.C + (size_t)cbh * SEQ;
#define RESC(a) do { if (__any((a) < 1.f)) { if (hi == 0) al_l[r32] = (a); asm volatile("s_waitcnt lgkmcnt(0)" ::: "memory");              \
                     for (int d_ = 0; d_ < 4; ++d_) for (int r = 0; r < 16; ++r) o[d_][r] *= al_l[crow(r, hi)]; } } while (0)
#define KBASE(t) ((jhi - (t)) * KVBLK)
#define MASKT(P0_, P1_, t) do { const int kb_ = KBASE(t); if (kb_ + KVBLK - 1 > qlo) { int l_ = threadIdx.x; asm volatile("" : "+v"(l_)); const int lq_ = (l_ & 31) - 4 * ((l_ >> 5) & 1); mask_tile(P0_, P1_, (qlo - kb_) + lq_, (unsigned)W); } } while (0)
    constexpr int NQL = 8;
#define SEAM_K0() do { VMWN(NQL); SWRITE_HK(0); SBAR(); } while (0)
    f32x16 pA0, pA1, pB0, pB1; float mnA, mnB, alA, alB; bf16x8 pa0, pa1, pa2, pa3;
    SWRITE_HV(0); SBAR();
    if (NT > 1) { SLOAD_H(Kh, Vh, Ch, KBASE(1), 1); }
    SBAR(); qkt<0>(pA0, pA1, K_lds, ck_lds, r32, hi, S.qr);
    MASKT(pA0, pA1, 0); partialSM(pA0, pA1, m_reg, mnA, alA, 0.f);
    if (NT > 1) { VMW(); SWRITE_H(1); }
    __syncthreads();
#define HALF_STEP(PX0, PX1, mnX, alX, PY0, PY1, alY, t, KB, VB, SB) do {                                                      \
        SBAR(); qkt<KB>(PX0, PX1, K_lds, ck_lds, r32, hi, S.qr);                                                          \
        finishSM(PY0, PY1, alY, l_reg, pa0, pa1, pa2, pa3); SBAR();                                                           \
        if ((t) + 1 < NT) { SLOAD_H(Kh, Vh, Ch, KBASE((t) + 1), SB); SBAR(); }                                                    \
        pv_tile<VB>(o, vb0, pa0, pa1, pa2, pa3); MASKT(PX0, PX1, (t)); partialSM(PX0, PX1, m_reg, mnX, alX, (t) <= 4 ? 0.f : THR);     \
        __syncthreads();                                                                                                      \
        if ((t) + 1 < NT) { VMW(); SWRITE_H(SB); }                                                                            \
        RESC(alX); __syncthreads(); } while (0)
    for (int t = 1; t + 1 < NT; t += 2) {
        HALF_STEP(pB0, pB1, mnB, alB, pA0, pA1, alA, t, 1, 0, 0);
        HALF_STEP(pA0, pA1, mnA, alA, pB0, pB1, alB, t + 1, 0, 1, 1);
        if (t == 3 && NT > 6) {
            const float* tab = (const float*)(lds + TBL_OFF + cb.tb * TBL_BYTES); float* tbm = (float*)(lds + TBLM_OFF);
            int mb = (int)__float_as_uint(m_reg);
#define DPP_MIN(ctrl, rmask) mb = (int)__float_as_uint(fminf(__uint_as_float((unsigned)mb), __uint_as_float((unsigned)__builtin_amdgcn_update_dpp(mb, mb, ctrl, rmask, 0xf, false))))
            DPP_MIN(0x111, 0xf); DPP_MIN(0x112, 0xf); DPP_MIN(0x114, 0xf); DPP_MIN(0x118, 0xf); DPP_MIN(0x142, 0xa); DPP_MIN(0x143, 0xc);
#undef DPP_MIN
            const float mwave = __uint_as_float((unsigned)__builtin_amdgcn_readlane(mb, 63));
            if (lane == 0) tbm[wid] = mwave;
            asm volatile("s_waitcnt lgkmcnt(0)" ::: "memory"); __syncthreads();
            const f32x4 t0 = *(const f32x4*)tbm, t1 = *(const f32x4*)(tbm + 4);
            const float mm = fminf(fminf(fminf(t0[0], t0[1]), fminf(t0[2], t0[3])), fminf(fminf(t1[0], t1[1]), fminf(t1[2], t1[3])));
            const float thr = SKIP_EPS * __builtin_amdgcn_exp2f((mm + tab[256] - 0.05f) * 1.4426950408889634f);
            int lane_ = lane; asm volatile("" : "+v"(lane_));
            int jl = jhi - 5;
#pragma unroll
            for (int g = 3; g >= 0; --g) { const int j = g * 64 + lane_; const bool skip = (j <= jhi - 6) && (tab[j] <= thr) && (thr < 1e30f);
                const unsigned long long keep = ~__ballot(skip);
                if (keep) jl = g * 64 + (int)__builtin_ctzll(keep); }
            const int NTr = jhi + 1 - jl;
            NT = NTr < NT ? NTr : NT;
            __syncthreads();
        }
    }
    const bool even = (NT & 1) == 0;
    if (even) { SBAR(); qkt<1>(pB0, pB1, K_lds, ck_lds, r32, hi, S.qr); SBAR(); }
    { const int nbh_ = blk_bh(nb.L), nP0 = blk_qb(nb.L) * QB; const float* nC = T.C + (size_t)nbh_ * SEQ;
      SLOAD_H(T.K + (size_t)nbh_ * SEQ * D, T.V + (size_t)nbh_ * SEQ * D, nC, ((nP0 + QB - 1) / KVBLK) * KVBLK, 0); SBAR();
      const bf16_t* qb_ = T.Q + ((size_t)nbh_ * SEQ + nP0 + wid * QBLK) * D;
#pragma unroll
      for (int d0 = 0; d0 < 8; ++d0) S.qr[d0] = LD16(qb_, qo + d0 * 32);
    }
    SBAR();
    finishSM(pA0, pA1, alA, l_reg, pa0, pa1, pa2, pa3); SBAR();
    pv_tile<0>(o, vb0, pa0, pa1, pa2, pa3);
    if (even) { MASKT(pB0, pB1, NT - 1); partialSM(pB0, pB1, m_reg, mnB, alB); __syncthreads(); RESC(alB);
        finishSM(pB0, pB1, alB, l_reg, pa0, pa1, pa2, pa3); SBAR(); pv_tile<1>(o, vb0, pa0, pa1, pa2, pa3); }
    SBAR(); SEAM_K0();
    if (hi == 0) li_l[r32] = l_reg; asm volatile("s_waitcnt lgkmcnt(0)" ::: "memory");
    float rli[16];
#pragma unroll
    for (int r = 0; r < 16; ++r) rli[r] = __builtin_amdgcn_rcpf(li_l[crow(r, hi)]);
    int el = threadIdx.x; asm volatile("" : "+v"(el));
    const int elane = el & 63, er32 = elane & 31, ehi = elane >> 5, odd = er32 & 1;
    char* ot = lds + (wid < NW - 1 ? OT_OFF + wid * OT_WAVE : 2 * SHM_V + SHM_K);
    const size_t go = ((size_t)(cbh / NHEAD) * SEQ + cP0 + wid * QBLK) * OROW + (size_t)(cbh % NHEAD) * D;
    char* Ob = (char*)(T.O + go); const char* Gb = (const char*)(T.G + go);
    const unsigned rdo = (unsigned)((elane >> 4) * OROW * 2 + (elane & 15) * 16);
    u32x4 gv[8];
#pragma unroll
    for (int it = 0; it < 8; ++it) gv[it] = *(const u32x4*)(Gb + (size_t)it * 4 * OROW * 2 + rdo);
    const unsigned wbase = (unsigned)((4 * ehi + 2 * odd) * OT_RS + (er32 & ~1) * 2);
#pragma unroll
    for (int d0 = 0; d0 < 4; ++d0)
#pragma unroll
        for (int q = 0; q < 8; ++q) { const int r = (q >> 1) * 4 + (q & 1);
            const float X = o[d0][r] * rli[r], Y = o[d0][r + 2] * rli[r + 2];
            const float snd = odd ? X : Y;
            const float rcv = __uint_as_float((unsigned)__builtin_amdgcn_update_dpp((int)__float_as_uint(snd), (int)__float_as_uint(snd), 0xB1, 0xf, 0xf, false));
            const unsigned pk = cvt_pk_bf16(odd ? rcv : X, odd ? Y : rcv);
            *(unsigned*)(ot + wbase + ((r & 3) + 8 * (r >> 2)) * OT_RS + d0 * 64) = pk; }
    asm volatile("s_waitcnt lgkmcnt(0)" ::: "memory");
    const unsigned rbase = (unsigned)((elane >> 4) * OT_RS + (elane & 15) * 16);
#pragma unroll
    for (int it = 0; it < 8; ++it) { const u32x4 ov = *(const u32x4*)(ot + rbase + it * 4 * OT_RS), g = gv[it]; u32x4 w;
        w.x = cvt_pk_bf16(bflo(ov.x) * bflo(g.x), bfhi(ov.x) * bfhi(g.x)); w.y = cvt_pk_bf16(bflo(ov.y) * bflo(g.y), bfhi(ov.y) * bfhi(g.y));
        w.z = cvt_pk_bf16(bflo(ov.z) * bflo(g.z), bfhi(ov.z) * bfhi(g.z)); w.w = cvt_pk_bf16(bflo(ov.w) * bflo(g.w), bfhi(ov.w) * bfhi(g.w));
        *(u32x4*)(Ob + (size_t)it * 4 * OROW * 2 + rdo) = w; }
    __syncthreads();
#undef RESC
#undef KBASE
#undef MASKT
#undef SEAM_K0
#undef HALF_STEP
}
#undef LD16
#undef VMW
#undef VMWN
#undef SLOAD_H
#undef SWRITE_HK
#undef SWRITE_HV
#undef SWRITE_H

__device__ __forceinline__ int find_jlo(const float* Ch, const float* kn2, int P0, float rho, float bnd, float* tab) {
    int lane = threadIdx.x & 63; asm volatile("" : "+v"(lane));
    const int nd = P0 / KVBLK; const float c0 = Ch[P0];
    const float thr0 = SKIP_EPS * __builtin_amdgcn_exp2f(-bnd * 1.4426950408889634f);
    float e[4];
#pragma unroll
    for (int g = 0; g < 4; ++g) { const int j = g * 64 + lane; e[g] = 0.f;
        if (j < nd) e[g] = __builtin_amdgcn_exp2f((fmaf(rho, __builtin_sqrtf(kn2[j]), c0) - Ch[j * KVBLK + KVBLK - 1]) * 1.4426950408889634f); }
    int jlo = 4 * 64; float carry = 0.f;
#pragma unroll
    for (int g = 0; g < 4; ++g) { float p = e[g];
#define DPP_ADD(ctrl, rmask) p += __uint_as_float((unsigned)__builtin_amdgcn_update_dpp(0, (int)__float_as_uint(p), ctrl, rmask, 0xf, true))
        DPP_ADD(0x111, 0xf); DPP_ADD(0x112, 0xf); DPP_ADD(0x114, 0xf); DPP_ADD(0x118, 0xf);
        DPP_ADD(0x142, 0xa); DPP_ADD(0x143, 0xc);
#undef DPP_ADD
        p += carry;
        if (tab && threadIdx.x < 64) tab[g * 64 + lane] = p;
        const bool skip = (g * 64 + lane < nd) && (p <= thr0);
        const unsigned long long keep = ~__ballot(skip);
        if (keep && jlo == 4 * 64) jlo = g * 64 + (int)__builtin_ctzll(keep);
        carry = __uint_as_float((unsigned)__builtin_amdgcn_readlane((int)__float_as_uint(p), 63)); }
    if (tab && threadIdx.x == 0) tab[256] = c0;
    return jlo;
}
__device__ __forceinline__ Blk mkblk(int L, const Tensors& T, char* lds, int tb) {
    const int bh = blk_bh(L), P0 = blk_qb(L) * QB;
    const float qn2 = T.nrm[bh * 64 + blk_qb(L)], dneg = T.nrm[NBH * 64 + bh * 64 + blk_qb(L)];
    const float rho = 1.001f * __builtin_sqrtf(qn2), bnd = 1.001f * dneg + 0.05f;
    Blk r; r.L = L; r.tb = tb; r.jlo = __builtin_amdgcn_readfirstlane(find_jlo(T.C + (size_t)bh * SEQ, T.nrm + 2 * NBH * 64 + bh * 256, P0, rho, bnd, (float*)(lds + TBL_OFF + tb * TBL_BYTES)));
    return r;
}
__device__ __forceinline__ void attn_order(char* lds, const Tensors& T) {
    unsigned short* ord = (unsigned short*)(lds + ORD_OFF); int* cap = (int*)(lds + CAP_OFF);
    int tid = threadIdx.x; asm volatile("" : "+v"(tid));
    const int wid = __builtin_amdgcn_readfirstlane(tid >> 6);
#pragma unroll
    for (int k = 0; k < 4; ++k) { const int bh = wid * 4 + k;
        const float qn2 = T.nrm[bh * 64 + 63], dneg = T.nrm[NBH * 64 + bh * 64 + 63];
        const int jl = find_jlo(T.C + (size_t)bh * SEQ, T.nrm + 2 * NBH * 64 + bh * 256, 63 * QB, 1.001f * __builtin_sqrtf(qn2), 1.001f * dneg + 0.05f, nullptr);
        int c = (63 * 4 - jl + 3) >> 2; c = c > 63 ? 63 : c;
        if ((tid & 63) == 0) cap[bh] = c; }
    asm volatile("s_waitcnt lgkmcnt(0)" ::: "memory"); __syncthreads();
    for (int i = tid; i < NBH * NQB; i += NW * 64) { const int bh = i >> 6, qb = i & 63, capb = cap[bh], lev = qb < capb ? qb : capb;
        int pos = lev == capb ? qb - capb : 0;
        for (int h = 0; h < NBH; ++h) { const int c = cap[h];
            if (lev + 1 <= c) pos += 63 - lev;
            if (h < bh) pos += lev < c ? 1 : (lev == c ? 64 - c : 0); }
        ord[pos] = (unsigned short)i; }
    asm volatile("s_waitcnt lgkmcnt(0)" ::: "memory"); __syncthreads();
}
__device__ __forceinline__ void attn_phase(char* lds, const Tensors& T) {
    constexpr int total = NBH * NQB;
    attn_order(lds, T);
    const unsigned short* ord = (const unsigned short*)(lds + ORD_OFF);
    volatile int* qslot = (volatile int*)(lds + LDS_ATT);
    if (threadIdx.x == 0) *qslot = (int)atomicAdd(T.queue, 1u);
    __syncthreads();
    const int L0 = __builtin_amdgcn_readfirstlane(*qslot);
    __syncthreads();
    if (L0 >= total) return;
    Blk cur = mkblk(__builtin_amdgcn_readfirstlane((int)ord[L0]), T, lds, 0);
    Seam S;
    attn_prime(T, cur, lds, S);
    for (;;) {
        if (threadIdx.x == 0) *qslot = (int)atomicAdd(T.queue, 1u);
        __syncthreads();
        const int Ln = __builtin_amdgcn_readfirstlane(*qslot);
        const bool last = Ln >= total;
        Blk nxt = cur; if (!last) nxt = mkblk(__builtin_amdgcn_readfirstlane((int)ord[Ln]), T, lds, cur.tb ^ 1);
        attn_block(T, cur, nxt, lds, S);
        if (last) break;
        cur = nxt;
    }
}
}

struct Args {
    const float* in[25]; float* out; unsigned char* ws; int ph_lo, ph_hi; int alt, pad;
};
enum { I_X = 0, I_ANORM, I_AWIN, I_ACONVW, I_ACONVB, I_AWREC, I_ABREC, I_AWINP, I_ABINP, I_ALAMBDA, I_AWOUT, I_KVNORM, I_KVW, I_KVBF, I_BNORM, I_BWQG, I_BWO,
       I_MNORM, I_MWGROUP, I_MBGROUP, I_MWROUTER, I_MBROUTER, I_MWIN, I_MWOUT, I_FNORM };
constexpr int NPHASES = 21;

__device__ __forceinline__ void cvt_item(const float* src, int ld, const float* gain, bf16_t* dst, int ldd, LAS float* scr, int lane) {
    const int q = lane & 15, kr = lane >> 4;
#pragma unroll
    for (int hb = 0; hb < 2; ++hb) {
        f32x4 v[8];
#pragma unroll
        for (int it = 0; it < 8; ++it) { const int kk = (hb * 8 + it) * 4 + kr; v[it] = *(const f32x4*)(src + (size_t)kk * ld + q * 4); }
#pragma unroll
        for (int it = 0; it < 8; ++it) { const int kk = (hb * 8 + it) * 4 + kr; const float gk = gain ? gain[kk] : 1.0f;
            *(LAS f32x4*)(scr + kk * 64 + ((4 * q) ^ (4 * (kk >> 3)))) = v[it] * gk; }
    }
    LDS_WAIT(); asm volatile("" ::: "memory");
    const int c = lane & 7;
#pragma unroll
    for (int j = 0; j < 8; ++j) { const int n = (lane >> 3) + 8 * j; const LAS float* s = scr + (8 * c) * 64 + (n ^ (4 * c));
        u32x4 o; o.x = cvt_pk_bf16(s[0 * 64], s[1 * 64]); o.y = cvt_pk_bf16(s[2 * 64], s[3 * 64]); o.z = cvt_pk_bf16(s[4 * 64], s[5 * 64]); o.w = cvt_pk_bf16(s[6 * 64], s[7 * 64]);
        *(u32x4*)(dst + (size_t)n * ldd + 8 * c) = o; }
    LDS_WAIT(); asm volatile("" ::: "memory");
}

constexpr int DEFER_ITEMS = 64 * 256, DEFER_ROUTER = 7168, DEFER_SCATTER = 1024;
static_assert(2 * (DEFER_ROUTER + DEFER_SCATTER) == DEFER_ITEMS, "deferred weight items");
__device__ __forceinline__ void cvt_wout_deferred(const float* mwout, bf16_t* WmoT, int first, int count, int w, int nw, LAS float* scr, int wave, int lane) {
    for (int d = first + w * NWAVES + wave; d < first + count; d += nw * NWAVES) {
        const int le = 64 + (d >> 8), rr = d & 255, kb = rr >> 5, nb = rr & 31;
        cvt_item(mwout + (size_t)le * 512 * DM + (size_t)kb * 64 * DM + nb * 64, DM, nullptr, WmoT + (size_t)le * DM * 512 + (size_t)nb * 64 * 512 + kb * 64, 512, scr, lane); }
}
struct MoeCtx {
    LAS unsigned char* lds; volatile LAS unsigned* MISC; unsigned char* ws; int G, bx, vcu, wave, lo, hi;
    const float* bgroup; const float* brouter; const float* fnorm; float* out; const float* mwout;
};
#ifndef PHASE_MASK
#define PHASE_MASK 0x1fffff
#endif
#define PH_ON(k) (((PHASE_MASK) >> (k)) & 1)
#define IN(k) (PH_ON(k) && lo <= (k) && (k) < hi)
#if !MK_PER_PHASE
#define GRID_BAR() xcd_barrier(bar)
#else
#define GRID_BAR() do { } while (0)
#endif
#define SEAM(k) do { if (IN(k) && IN((k) + 1)) GRID_BAR(); } while (0)
template <int layer>
__device__ __forceinline__ void moe_block(const MoeCtx& C, const XcdBarrier& bar) {
    LAS unsigned char* lds = C.lds; volatile LAS unsigned* MISC = C.MISC; const int G = C.G, bx = C.bx, vcu = C.vcu, wave = C.wave, lo = C.lo, hi = C.hi;
    int tid = threadIdx.x; asm volatile("" : "+v"(tid));
    const int lane = tid & 63;
    constexpr int pb = 7 + 9 * layer;
    unsigned char* ws = C.ws; unsigned* ctl = (unsigned*)(ws + WS_CTL);
    const bf16_t* XRB = (const bf16_t*)(ws + (layer ? WS_X3B : WS_X1B));
    unsigned* gcnt = ctl + CW_GCNT + 64 * layer;
    unsigned char* mb = ws + WS_ASG + (size_t)layer * MOE_LAYER_STRIDE;
    int* asg_e = (int*)mb; int* asg_r = asg_e + 2 * NTOK; float* asg_w = (float*)(asg_r + 2 * NTOK); float* rstd_tok = asg_w + 2 * NTOK; int* TH = (int*)(rstd_tok + NTOK); int* asg_g = TH + 128 * 64;
    int* tokl = (int*)(mb + (WS_TOKL - WS_ASG)); float* rsl = (float*)(mb + (WS_RSL - WS_ASG)); bf16_t* ACT = (bf16_t*)(mb + (WS_ACT - WS_ASG)); bf16_t* YB = (bf16_t*)(mb + (WS_YB - WS_ASG));
    float* X2 = (float*)(ws + WS_X2); bf16_t* XN2 = (bf16_t*)(ws + WS_XN2);
    const bf16_t* WrT = (const bf16_t*)(ws + WS_WR); const bf16_t* WmiT = (const bf16_t*)(ws + WS_WMI); const bf16_t* WmoT = (const bf16_t*)(ws + WS_WMO);
    if (IN(pb)) {
        pg8::Gemm g{XRB, WrT + (size_t)layer * 256 * DM, DM, DM, DM, nullptr, nullptr, nullptr}; pg8::DenseSched S; S.o.init(NTOK / 256, 1, G, bx);
        pg8::EpiRouter E{(const float*)(ws + (layer ? WS_PART3 : WS_PART)), C.bgroup + 8 * layer, C.brouter + 64 * layer, TH, asg_e, asg_r, asg_w, rstd_tok};
        pg8::gemm_phase<pg8::EpiRouter, pg8::DenseSched, false, false>(lds, g, S, E);
        if (G >= 256 && bx >= NTOK / 256) {
            int dl = threadIdx.x; asm volatile("" : "+v"(dl));
            cvt_wout_deferred(C.mwout, (bf16_t*)(ws + WS_WMO), layer * (DEFER_ROUTER + DEFER_SCATTER), DEFER_ROUTER, bx - NTOK / 256, G - NTOK / 256, (LAS float*)(lds + wave * 16384), wave, dl & 63); }
    }
    SEAM(pb);
    if (IN(pb + 1)) {
        LAS int* bs = (LAS int*)lds;
        for (int tile = vcu; tile < NTOK / 256; tile += G) {
            if (tid < 64) { int base = 0;
#pragma unroll 16
                for (int tt = 0; tt < tile; ++tt) base += TH[tt * 64 + tid];
                bs[tid] = base; if (tile == NTOK / 256 - 1) gcnt[tid] = (unsigned)(base + TH[tile * 64 + tid]); }
            LDS_WAIT(); __syncthreads();
            if (tid < 256) { const int t = tile * 256 + tid; const float rs = rstd_tok[t];
#pragma unroll
                for (int k = 0; k < 2; ++k) { const int e = asg_e[2 * t + k], r = bs[e] + asg_r[2 * t + k]; asg_g[2 * t + k] = r; __hip_atomic_store(tokl + (size_t)e * LCAP + r, t, __ATOMIC_RELAXED, __HIP_MEMORY_SCOPE_AGENT); __hip_atomic_store(rsl + (size_t)e * LCAP + r, rs, __ATOMIC_RELAXED, __HIP_MEMORY_SCOPE_AGENT); } }
            __syncthreads();
        }
        if (G >= 256 && vcu >= NTOK / 256) {
            int dl = threadIdx.x; asm volatile("" : "+v"(dl));
            cvt_wout_deferred(C.mwout, (bf16_t*)(ws + WS_WMO), layer * (DEFER_ROUTER + DEFER_SCATTER) + DEFER_ROUTER, DEFER_SCATTER, vcu - NTOK / 256, G - NTOK / 256, (LAS float*)(lds + wave * 16384), wave, dl & 63); }
    }
    SEAM(pb + 1);
    if (IN(pb + 2) || IN(pb + 3) || IN(pb + 4)) {
        __syncthreads();
        if (tid < 64) { const int c = (int)__hip_atomic_load(gcnt + tid, __ATOMIC_RELAXED, __HIP_MEMORY_SCOPE_AGENT); const int ntile = (c + 255) >> 8; int incl = ntile;
#pragma unroll
            for (int o = 1; o < 64; o <<= 1) { const int nb = __shfl_up(incl, o); if (lane >= o) incl += nb; }
            MISC[MI_CNT + tid] = (unsigned)c; MISC[MI_TSTART + tid + 1] = (unsigned)incl; if (tid == 0) MISC[MI_TSTART] = 0u; }
        LDS_WAIT(); __syncthreads();
    }
    const LAS int* tstart = (const LAS int*)(lds + MISC_OFF) + MI_TSTART; const LAS int* ecnt = (const LAS int*)(lds + MISC_OFF) + MI_CNT;
    if (IN(pb + 2)) {
        pg8::Gemm g{XRB, WmiT + (size_t)layer * 64 * 1024 * DM, DM, DM, DM, tokl, nullptr, nullptr};
        pg8::MoeSched<true> S{tstart, ecnt, 4, G, bx, tstart[64] * 4, 1024};
        pg8::EpiMoe1 E{rsl, ACT};
        pg8::gemm_phase<pg8::EpiMoe1, pg8::MoeSched<true>, true, true>(lds, g, S, E);
    }
    SEAM(pb + 2);
    if (IN(pb + 3)) {
        pg8::Gemm g{ACT, WmoT + (size_t)layer * 64 * DM * 512, DEXP, DEXP, DEXP, nullptr, nullptr, nullptr};
        pg8::MoeSched<false> S{tstart, ecnt, 8, G, bx, tstart[64] * 8, 2048};
        pg8::EpiMoe2 E{YB};
        pg8::gemm_phase<pg8::EpiMoe2, pg8::MoeSched<false>, false, true>(lds, g, S, E);
    }
    SEAM(pb + 3);
    if (IN(pb + 4)) {
        const int gw = vcu * NWAVES + wave, NGW = G * NWAVES;
        const float* fn = C.fnorm;
        struct Asg { int e0, e1, r0, r1; float w0, w1; };
#define CB_LD_ASG(A_, t_) do { (A_).e0 = asg_e[2 * (t_)]; (A_).e1 = asg_e[2 * (t_) + 1]; (A_).r0 = asg_g[2 * (t_)]; (A_).r1 = asg_g[2 * (t_) + 1]; (A_).w0 = asg_w[2 * (t_)]; (A_).w1 = asg_w[2 * (t_) + 1]; } while (0)
#define CB_LD_ROW(X_, A0_, B0_, A_, t_) do { const size_t p0_ = (size_t)(tstart[(A_).e0] * 256 + (A_).r0), p1_ = (size_t)(tstart[(A_).e1] * 256 + (A_).r1);               \
            const u32x2* xr_ = (const u32x2*)(XRB + (size_t)(t_) * DM) + lane; const u32x2* y0_ = (const u32x2*)(YB + p0_ * DM) + lane; const u32x2* y1_ = (const u32x2*)(YB + p1_ * DM) + lane; \
            _Pragma("unroll") for (int j = 0; j < 8; ++j) { (X_)[j] = __builtin_nontemporal_load(xr_ + 64 * j); (A0_)[j] = __builtin_nontemporal_load(y0_ + 64 * j); (B0_)[j] = __builtin_nontemporal_load(y1_ + 64 * j); } } while (0)
        Asg ac, an; u32x2 xw[8], aw[8], bw[8];
        { const int t0 = gw; ac.e0 = ac.e1 = ac.r0 = ac.r1 = 0; ac.w0 = ac.w1 = 0.f; an = ac;
          if (t0 < NTOK) { CB_LD_ASG(ac, t0); CB_LD_ROW(xw, aw, bw, ac, t0); }
          if (t0 + NGW < NTOK) CB_LD_ASG(an, t0 + NGW); }
        for (int t = gw; t < NTOK; t += NGW) {
            const int tn = t + NGW;
            Asg a2 = an; if (tn + NGW < NTOK) CB_LD_ASG(a2, tn + NGW);
            u32x2 xn[8], yn0[8], yn1[8];
            if (tn < NTOK) CB_LD_ROW(xn, yn0, yn1, an, tn);
            else {
#pragma unroll
                for (int j = 0; j < 8; ++j) { xn[j] = xw[j]; yn0[j] = aw[j]; yn1[j] = bw[j]; } }
            float w0 = ac.w0, w1 = ac.w1;
#ifdef DBG_ZERO_MOE1
                if (layer == 1) { w0 = 0.f; w1 = 0.f; }
#endif
            f32x4 v[8]; float s = 0.f;
#pragma unroll
            for (int j = 0; j < 8; ++j) { const u32x2 xv = xw[j]; v[j] = (f32x4){bflo(xv.x), bfhi(xv.x), bflo(xv.y), bfhi(xv.y)}; const u32x2 a = aw[j], b = bw[j];
                v[j][0] += w0 * bflo(a.x) + w1 * bflo(b.x); v[j][1] += w0 * bfhi(a.x) + w1 * bfhi(b.x); v[j][2] += w0 * bflo(a.y) + w1 * bflo(b.y); v[j][3] += w0 * bfhi(a.y) + w1 * bfhi(b.y);
                s += (v[j][0] * v[j][0] + v[j][1] * v[j][1]) + (v[j][2] * v[j][2] + v[j][3] * v[j][3]); }
            const float rstd = 1.0f / sqrtf(wave_sum(s) * (1.0f / DM) + RMS_EPS);
            if (layer == 0) {
                u32x2* o8 = (u32x2*)(XN2 + (size_t)t * DM) + lane;
#pragma unroll
                for (int j = 0; j < 8; ++j) { u32x2 w; w.x = cvt_pk_bf16(v[j][0], v[j][1]); w.y = cvt_pk_bf16(v[j][2], v[j][3]); __builtin_nontemporal_store(w, o8 + 64 * j); }
                if (lane == 0) X2[t] = rstd;
            } else {
                f32x4* oo = (f32x4*)(C.out + (size_t)t * DM) + lane; const f32x4* fg = (const f32x4*)fn + lane;
#pragma unroll
                for (int j = 0; j < 8; ++j) __builtin_nontemporal_store(v[j] * rstd * fg[64 * j], oo + 64 * j);
            }
            ac = an; an = a2;
#pragma unroll
            for (int j = 0; j < 8; ++j) { xw[j] = xn[j]; aw[j] = yn0[j]; bw[j] = yn1[j]; }
        }
#undef CB_LD_ASG
#undef CB_LD_ROW
    }
    if (layer == 0) SEAM(pb + 4);
}

__global__ void __launch_bounds__(NTHREADS, 2) fwd_kernel(Args args) {
    extern __shared__ __attribute__((aligned(16))) unsigned char lds_raw[];
    LAS unsigned char* lds = (LAS unsigned char*)lds_raw;
    volatile LAS unsigned* MISC = (volatile LAS unsigned*)(lds + MISC_OFF);
    const int tid = threadIdx.x, lane = tid & 63, wave = __builtin_amdgcn_readfirstlane(tid >> 6);
    const int G = gridDim.x; const int bx = blockIdx.x; const int vcu = (G % 8 == 0) ? (bx % 8) * (G / 8) + bx / 8 : bx;
    unsigned char* ws = args.ws;
    unsigned* ctl = (unsigned*)(ws + WS_CTL);
    for (int u = tid; u < (LDS_BYTES - MISC_OFF) / 4; u += NTHREADS) MISC[u] = 0u;
    __syncthreads();
#if !MK_PER_PHASE
    XcdBarrier bar = xcd_barrier_post(ctl + CW_BAR, MISC + MI_BAR);
#else
    XcdBarrier bar; bar.bar = nullptr; bar.x = 0; bar.st = nullptr;
#endif
    const int lo = args.ph_lo, hi = args.ph_hi;

    bf16_t* WinT = (bf16_t*)(ws + WS_WIN); bf16_t* WgT = (bf16_t*)(ws + WS_WG); bf16_t* WoutT = (bf16_t*)(ws + WS_WOUT); bf16_t* WkvqgT = (bf16_t*)(ws + WS_WKVQG);
    bf16_t* WoT = (bf16_t*)(ws + WS_WO); bf16_t* WrT = (bf16_t*)(ws + WS_WR); bf16_t* WmiT = (bf16_t*)(ws + WS_WMI); bf16_t* WmoT = (bf16_t*)(ws + WS_WMO);
    float* Lvec = (float*)(ws + WS_LVEC);
    bf16_t* H0 = (bf16_t*)(ws + WS_H0); bf16_t* Ub = (bf16_t*)(ws + WS_U); bf16_t* GY = (bf16_t*)(ws + WS_GY); bf16_t* UC = (bf16_t*)(ws + WS_UC);
    bf16_t* LAb = (bf16_t*)(ws + WS_LA); bf16_t* BBb = (bf16_t*)(ws + WS_BB); bf16_t* HS = (bf16_t*)(ws + WS_HS);
    bf16_t* X1B = (bf16_t*)(ws + WS_X1B); float* PART = (float*)(ws + WS_PART);
    bf16_t* IDN = (bf16_t*)(ws + WS_X2 + 4 * MiB);
    float* cLA = (float*)(ws + WS_CARRY); float* cH = cLA + 256 * DM;
    int* asg_e = (int*)(ws + WS_ASG); int* asg_r = asg_e + 2 * NTOK; float* asg_w = (float*)(asg_r + 2 * NTOK); float* rstd_tok = asg_w + 2 * NTOK; int* TH = (int*)(rstd_tok + NTOK);
    int* tokl = (int*)(ws + WS_TOKL); float* rsl = (float*)(ws + WS_RSL);
    bf16_t* ACT = (bf16_t*)(ws + (args.alt ? (size_t)3400 * MiB : WS_ACT)); bf16_t* YB = (bf16_t*)(ws + WS_YB);
    float* X2 = (float*)(ws + WS_X2); bf16_t* XN2 = (bf16_t*)(ws + WS_XN2);
    bf16_t* Kb = (bf16_t*)(ws + WS_KB); bf16_t* Vb = (bf16_t*)(ws + WS_VB); bf16_t* Qb = (bf16_t*)(ws + WS_QB); bf16_t* SG = (bf16_t*)(ws + WS_SG);
    float* FLOG = (float*)(ws + WS_FLOG); float* CUM = (float*)(ws + WS_CUM); bf16_t* OG = (bf16_t*)(ws + WS_OG);
    float* RS0 = (float*)(ws + WS_X2 + 2 * MiB);
    float* NRMF = (float*)(ws + WS_X2 + 1 * MiB);
    bf16_t* X3B = (bf16_t*)(ws + WS_X3B); float* PART3 = (float*)(ws + WS_PART3);
    const float* x_in = args.in[I_X];

    if (IN(0)) {
        LAS float* scr = (LAS float*)(lds + wave * 16384);
        const int gw = vcu * NWAVES + wave, NGW = G * NWAVES;
        constexpr int I1 = 32 * 64, I2 = 256, I3 = 32 * 32, I4 = 32 * 64, I5 = 32 * 64, I6 = 32 * 32, I8 = 2 * 64 * 512, I9 = 2 * 64 * 256;
        const int NITEMS = I1 + I2 + I3 + I4 + I5 + I6 + I8 + (G >= 256 ? I9 - DEFER_ITEMS : I9);
        for (int it = gw; it < NITEMS; it += NGW) {
            int r = it; const float* src; const float* gain = nullptr; bf16_t* dst; int ld, ldd;
            if (r < I1) { const int kb = r >> 6, nb = r & 63;
                src = args.in[I_AWIN] + (size_t)kb * 64 * 4096 + nb * 64; ld = 4096; gain = args.in[I_ANORM] + kb * 64; dst = WinT + (size_t)nb * 64 * DM + kb * 64; ldd = DM; }
            else if ((r -= I1) < I2) { const int which = r & 1, kb = (r >> 1) & 3, nh = (r >> 3) & 1, q = (r >> 4) & 1, nblk = r >> 5;
                src = args.in[which ? I_AWINP : I_AWREC] + (size_t)nblk * 65536 + (size_t)kb * 64 * 256 + q * 128 + nh * 64; ld = 256;
                dst = WgT + (size_t)(nblk * 512 + q * 256 + which * 128 + nh * 64) * 256 + kb * 64; ldd = 256; }
            else if ((r -= I2) < I3) { const int kb = r >> 5, nb = r & 31;
                src = args.in[I_AWOUT] + (size_t)kb * 64 * DM + nb * 64; ld = DM; dst = WoutT + (size_t)nb * 64 * DM + kb * 64; ldd = DM; }
            else if ((r -= I3) < I4) { const int kb = r >> 6, nb = r & 63;
                src = args.in[I_KVW] + (size_t)kb * 64 * 4112 + nb * 64; ld = 4112; gain = args.in[I_KVNORM] + kb * 64; dst = WkvqgT + (size_t)nb * 64 * DM + kb * 64; ldd = DM; }
            else if ((r -= I4) < I5) { const int kb = r >> 6, nb = r & 63;
                src = args.in[I_BWQG] + (size_t)kb * 64 * 4096 + nb * 64; ld = 4096; gain = args.in[I_BNORM] + kb * 64; dst = WkvqgT + (size_t)(4352 + nb * 64) * DM + kb * 64; ldd = DM; }
            else if ((r -= I5) < I6) { const int kb = r >> 5, nb = r & 31;
                src = args.in[I_BWO] + (size_t)kb * 64 * DM + nb * 64; ld = DM; dst = WoT + (size_t)nb * 64 * DM + kb * 64; ldd = DM; }
            else if ((r -= I6) < I8) { const int le = r >> 9, rr = r & 511, kb = rr >> 4, nb = rr & 15;
                const int pn = nb >> 2, half = (nb >> 1) & 1, sub = nb & 1; const int scol = half * 512 + pn * 128 + sub * 64, layer = le >> 6;
                src = args.in[I_MWIN] + (size_t)le * 2048 * 1024 + (size_t)kb * 64 * 1024 + scol; ld = 1024; gain = args.in[I_MNORM] + layer * DM + kb * 64;
                dst = WmiT + (size_t)le * 1024 * DM + (size_t)nb * 64 * DM + kb * 64; ldd = DM; }
            else { r -= I8; const int le = r >> 8, rr = r & 255, kb = rr >> 5, nb = rr & 31;
                src = args.in[I_MWOUT] + (size_t)le * 512 * DM + (size_t)kb * 64 * DM + nb * 64; ld = DM; dst = WmoT + (size_t)le * DM * 512 + (size_t)nb * 64 * 512 + kb * 64; ldd = 512; }
            cvt_item(src, ld, gain, dst, ldd, scr, lane);
        }
        const int gt = vcu * NTHREADS + tid, NGT = G * NTHREADS;
        for (int i = gt; i < 256 * DM; i += NGT) {
            const int n = i / DM, k = i % DM; float v = 0.f; if (n < 16) v = args.in[I_KVW][(size_t)k * 4112 + 4096 + n] * args.in[I_KVNORM][k];
            WkvqgT[(size_t)(4096 + n) * DM + k] = (bf16_t)(cvt_pk_bf16(v, 0.f) & 0xffffu); }
        for (int i = gt; i < 2 * 256 * DM; i += NGT) {
            const int layer = i / (256 * DM), n = (i / DM) % 256, k = i % DM; float v = 0.f;
            if (n < 8) v = args.in[I_MWGROUP][(size_t)layer * DM * 8 + (size_t)k * 8 + n]; else if (n < 72) v = args.in[I_MWROUTER][(size_t)layer * DM * 64 + (size_t)k * 64 + (n - 8)];
            v *= args.in[I_MNORM][layer * DM + k];
            WrT[i] = (bf16_t)(cvt_pk_bf16(v, 0.f) & 0xffffu); }
        for (int i = gt; i < 256 * 256; i += NGT) IDN[(size_t)(i >> 8) * DM + (i & 255)] = (bf16_t)((i >> 8) == (i & 255) ? 0x3F80 : 0);
        for (int i = gt; i < DM; i += NGT) { const float lam = args.in[I_ALAMBDA][i]; const float sp = fmaxf(-lam, 0.f) + log1pf(expf(-fabsf(lam))); Lvec[i] = -8.0f * sp; }
        for (int m = gw; m < NTOK; m += NGW) {
            const f32x4* xr = (const f32x4*)(x_in + (size_t)m * DM) + lane; f32x4 v[8]; float s = 0.f;
#pragma unroll
            for (int j = 0; j < 8; ++j) { v[j] = xr[64 * j]; s += (v[j][0] * v[j][0] + v[j][1] * v[j][1]) + (v[j][2] * v[j][2] + v[j][3] * v[j][3]); }
            const float rstd = 1.0f / sqrtf(wave_sum(s) * (1.0f / DM) + RMS_EPS);
            u32x2* o8 = (u32x2*)(H0 + (size_t)m * DM) + lane;
#pragma unroll
            for (int j = 0; j < 8; ++j) { u32x2 w; w.x = cvt_pk_bf16(v[j][0], v[j][1]); w.y = cvt_pk_bf16(v[j][2], v[j][3]); o8[64 * j] = w; }
            if (lane == 0) RS0[m] = rstd;
        }
    }
    SEAM(0);

    if (IN(1)) {
        pg8::Gemm g{H0, WinT, DM, DM, DM, nullptr, nullptr, nullptr}; pg8::DenseSched S; S.o.init(NTOK / 256, 4096 / 256, G, bx);
        pg8::EpiInProj E{Ub, GY, RS0};
        pg8::gemm_phase<pg8::EpiInProj, pg8::DenseSched, false, true>(lds, g, S, E);
    }
    SEAM(1);

    if (IN(2)) {
        const int tc = tid & 255, c0 = tc * 8; const float* cw = args.in[I_ACONVW]; const float* cbp = args.in[I_ACONVB];
        float w[4][8], cb[8];
#pragma unroll
        for (int j = 0; j < 4; ++j) { const f32x4 a = *(const f32x4*)(cw + j * DM + c0), b = *(const f32x4*)(cw + j * DM + c0 + 4);
#pragma unroll
            for (int e = 0; e < 4; ++e) { w[j][e] = a[e]; w[j][4 + e] = b[e]; } }
        { const f32x4 a = *(const f32x4*)(cbp + c0), b = *(const f32x4*)(cbp + c0 + 4);
#pragma unroll
          for (int e = 0; e < 4; ++e) { cb[e] = a[e]; cb[4 + e] = b[e]; } }
        for (int grp = vcu * 2 + (tid >> 8); grp < NTOK / 64; grp += G * 2) {
            const int row0 = grp * 64; float p1[8], p2[8], p3[8];
#pragma unroll
            for (int e = 0; e < 8; ++e) { p1[e] = 0.f; p2[e] = 0.f; p3[e] = 0.f; }
            if ((row0 % SEQ) != 0) {
                const u32x4 a = *(const u32x4*)(Ub + (size_t)(row0 - 1) * DM + c0), b = *(const u32x4*)(Ub + (size_t)(row0 - 2) * DM + c0), c = *(const u32x4*)(Ub + (size_t)(row0 - 3) * DM + c0);
                p1[0] = bflo(a.x); p1[1] = bfhi(a.x); p1[2] = bflo(a.y); p1[3] = bfhi(a.y); p1[4] = bflo(a.z); p1[5] = bfhi(a.z); p1[6] = bflo(a.w); p1[7] = bfhi(a.w);
                p2[0] = bflo(b.x); p2[1] = bfhi(b.x); p2[2] = bflo(b.y); p2[3] = bfhi(b.y); p2[4] = bflo(b.z); p2[5] = bfhi(b.z); p2[6] = bflo(b.w); p2[7] = bfhi(b.w);
                p3[0] = bflo(c.x); p3[1] = bfhi(c.x); p3[2] = bflo(c.y); p3[3] = bfhi(c.y); p3[4] = bflo(c.z); p3[5] = bfhi(c.z); p3[6] = bflo(c.w); p3[7] = bfhi(c.w);
            }
#pragma unroll 4
            for (int i = 0; i < 64; ++i) {
                const u32x4 a = __builtin_nontemporal_load((const u32x4*)(Ub + (size_t)(row0 + i) * DM + c0));
                const float cu[8] = {bflo(a.x), bfhi(a.x), bflo(a.y), bfhi(a.y), bflo(a.z), bfhi(a.z), bflo(a.w), bfhi(a.w)};
                float o[8];
#pragma unroll
                for (int e = 0; e < 8; ++e) { o[e] = cb[e] + w[3][e] * cu[e] + w[2][e] * p1[e] + w[1][e] * p2[e] + w[0][e] * p3[e]; p3[e] = p2[e]; p2[e] = p1[e]; p1[e] = cu[e]; }
                u32x4 ow; ow.x = cvt_pk_bf16(o[0], o[1]); ow.y = cvt_pk_bf16(o[2], o[3]); ow.z = cvt_pk_bf16(o[4], o[5]); ow.w = cvt_pk_bf16(o[6], o[7]);
                __builtin_nontemporal_store(ow, (u32x4*)(UC + (size_t)(row0 + i) * DM + c0));
            }
        }
    }
    SEAM(2);

    if (IN(3)) {
        pg8::Gemm g{UC, WgT, DM, 256, 256, nullptr, nullptr, nullptr}; pg8::GateSched S; S.o.init(NTOK / 256, 16, G, bx);
        pg8::EpiGates E{UC, LAb, BBb, Lvec, args.in[I_ABREC], args.in[I_ABINP]};
        pg8::gemm_phase<pg8::EpiGates, pg8::GateSched, false, true>(lds, g, S, E);
    }
    SEAM(3);

    if (IN(4)) {
        for (int it = vcu; it < 256; it += G) {
            const size_t base = (size_t)it * 128 * DM + 4 * tid;
            float h[4] = {0.f, 0.f, 0.f, 0.f}, sl[4] = {0.f, 0.f, 0.f, 0.f};
#pragma unroll 8
            for (int i = 0; i < 128; ++i) { const u32x2 lw = *(const u32x2*)(LAb + base + (size_t)i * DM), bw = *(const u32x2*)(BBb + base + (size_t)i * DM);
                const float l[4] = {bflo(lw.x), bfhi(lw.x), bflo(lw.y), bfhi(lw.y)}, b[4] = {bflo(bw.x), bfhi(bw.x), bflo(bw.y), bfhi(bw.y)};
#pragma unroll
                for (int e = 0; e < 4; ++e) { h[e] = fast_exp(l[e]) * h[e] + b[e]; sl[e] += l[e]; } }
            *(f32x4*)(cLA + (size_t)it * DM + 4 * tid) = (f32x4){sl[0], sl[1], sl[2], sl[3]}; *(f32x4*)(cH + (size_t)it * DM + 4 * tid) = (f32x4){h[0], h[1], h[2], h[3]};
        }
    }
    SEAM(4);

    if (IN(5)) {
        for (int it = vcu; it < 256; it += G) {
            const int chunk = it & 127, it0 = it - chunk;
            float h[4] = {0.f, 0.f, 0.f, 0.f};
#pragma unroll 4
            for (int j = 0; j < chunk; ++j) { const f32x4 a = *(const f32x4*)(cLA + (size_t)(it0 + j) * DM + 4 * tid), hh = *(const f32x4*)(cH + (size_t)(it0 + j) * DM + 4 * tid);
#pragma unroll
                for (int e = 0; e < 4; ++e) h[e] = fast_exp(a[e]) * h[e] + hh[e]; }
            const size_t base = (size_t)it * 128 * DM + 4 * tid;
#pragma unroll 8
            for (int i = 0; i < 128; ++i) { const u32x2 lw = __builtin_nontemporal_load((const u32x2*)(LAb + base + (size_t)i * DM)), bw = __builtin_nontemporal_load((const u32x2*)(BBb + base + (size_t)i * DM)), gw2 = __builtin_nontemporal_load((const u32x2*)(GY + base + (size_t)i * DM));
                const float l[4] = {bflo(lw.x), bfhi(lw.x), bflo(lw.y), bfhi(lw.y)}, b[4] = {bflo(bw.x), bfhi(bw.x), bflo(bw.y), bfhi(bw.y)}, gy[4] = {bflo(gw2.x), bfhi(gw2.x), bflo(gw2.y), bfhi(gw2.y)};
                float o[4];
#pragma unroll
                for (int e = 0; e < 4; ++e) { h[e] = fast_exp(l[e]) * h[e] + b[e]; o[e] = h[e] * gy[e]; }
                u32x2 ow; ow.x = cvt_pk_bf16(o[0], o[1]); ow.y = cvt_pk_bf16(o[2], o[3]); __builtin_nontemporal_store(ow, (u32x2*)(HS + base + (size_t)i * DM)); }
        }
    }
    SEAM(5);

    if (IN(6)) {
        pg8::Gemm g{HS, WoutT, DM, DM, DM, nullptr, H0, IDN}; pg8::DenseSched S; S.o.init(NTOK / 256, DM / 256, G, bx);
        pg8::EpiStoreRes E{X1B, PART};
        pg8::gemm_phase<pg8::EpiStoreRes, pg8::DenseSched, false, true>(lds, g, S, E);
    }
    SEAM(6);

    { MoeCtx MC{lds, MISC, ws, G, bx, vcu, wave, lo, hi, args.in[I_MBGROUP], args.in[I_MBROUTER], args.in[I_FNORM], args.out, args.in[I_MWOUT]};
      moe_block<0>(MC, bar); }

    if (IN(12)) {
        pg8::Gemm g{XN2, WkvqgT, DM, DM, DM, nullptr, nullptr, nullptr}; pg8::DenseSched S; S.o.init(NTOK / 256, NKVQG / 256, G, bx);
        pg8::EpiKVQG E{Kb, Vb, Qb, SG, FLOG, args.in[I_KVBF], X2};
        pg8::gemm_phase<pg8::EpiKVQG, pg8::DenseSched, false, true>(lds, g, S, E);
    }
    SEAM(12);
    if (IN(13)) {
        LAS float* wt = (LAS float*)lds;
        for (int it = vcu; it < NB * NHEAD; it += G) {
            const int b = it / NHEAD, h = it % NHEAD; float v[32]; float tot = 0.f;
#pragma unroll
            for (int i = 0; i < 32; ++i) { v[i] = FLOG[((size_t)b * SEQ + 32 * tid + i) * 16 + h]; tot += v[i]; v[i] = tot; }
            float incl = tot;
#pragma unroll
            for (int o = 1; o < 64; o <<= 1) { const float nb = __shfl_up(incl, o); if (lane >= o) incl += nb; }
            if (lane == 63) wt[wave] = incl;
            LDS_WAIT(); __syncthreads();
            float off = incl - tot;
            for (int w = 0; w < wave; ++w) off += wt[w];
            float* dst = CUM + (size_t)it * SEQ + 32 * tid;
#pragma unroll
            for (int i = 0; i < 8; ++i) *(f32x4*)(dst + 4 * i) = (f32x4){v[4 * i] + off, v[4 * i + 1] + off, v[4 * i + 2] + off, v[4 * i + 3] + off};
            __syncthreads();
        }
        const int nW = G > 64 ? G - 32 : G, w0 = G > 64 ? vcu - 32 : vcu;
        if (w0 >= 0) {
            LAS float* red = (LAS float*)(lds + 1024);
            float* QN2 = NRMF; float* DNG = NRMF + NB * NHEAD * 64; float* KN2 = NRMF + 2 * NB * NHEAD * 64;
            for (int u = w0; u < NB * NHEAD * 32; u += nW) {
                const int bh = u >> 5, ch = u & 31;
                const size_t base = (((size_t)bh * SEQ + ch * 512 + wave * 64 + (lane >> 4)) * HDIM + (lane & 15) * 8) * 2;
                const char* qp = (const char*)Qb + base; const char* kp = (const char*)Kb + base;
                float mq = 0.f, mk = 0.f, md = 0.f;
#pragma unroll 4
                for (int st = 0; st < 16; ++st) {
                    const u32x4 q = __builtin_nontemporal_load((const u32x4*)(qp + st * 1024)), k = __builtin_nontemporal_load((const u32x4*)(kp + st * 1024));
                    float qq = 0.f, kk = 0.f, qk = 0.f;
#pragma unroll
                    for (int c = 0; c < 4; ++c) { const float ql = __uint_as_float(q[c] << 16), qh = __uint_as_float(q[c] & 0xffff0000u), kl = __uint_as_float(k[c] << 16), kh = __uint_as_float(k[c] & 0xffff0000u);
                        qq = fmaf(ql, ql, fmaf(qh, qh, qq)); kk = fmaf(kl, kl, fmaf(kh, kh, kk)); qk = fmaf(ql, kl, fmaf(qh, kh, qk)); }
#pragma unroll
                    for (int o = 1; o < 16; o <<= 1) { qq += __shfl_xor(qq, o); kk += __shfl_xor(kk, o); qk += __shfl_xor(qk, o); }
                    mq = fmaxf(mq, qq); mk = fmaxf(mk, kk); md = fmaxf(md, -qk);
                }
#pragma unroll
                for (int o = 16; o < 64; o <<= 1) { mq = fmaxf(mq, __shfl_xor(mq, o)); mk = fmaxf(mk, __shfl_xor(mk, o)); md = fmaxf(md, __shfl_xor(md, o)); }
                if (lane == 0) { KN2[bh * 256 + ch * 8 + wave] = mk; red[wave * 2 + 0] = mq; red[wave * 2 + 1] = md; }
                LDS_WAIT(); __syncthreads();
                if (tid < 4) { const int bq = tid >> 1, wq = tid & 1;
                    const float m = fmaxf(fmaxf(red[(bq * 4 + 0) * 2 + wq], red[(bq * 4 + 1) * 2 + wq]), fmaxf(red[(bq * 4 + 2) * 2 + wq], red[(bq * 4 + 3) * 2 + wq]));
                    (wq ? DNG : QN2)[bh * 64 + ch * 2 + bq] = m; }
                __syncthreads();
            }
        }
    }
    SEAM(13);
    if (IN(14)) {
        att::Tensors T{Qb, Kb, Vb, CUM, SG, OG, NRMF, ctl + CW_AQ};
        att::attn_phase((char*)lds_raw, T);
    }
    SEAM(14);
    if (IN(15)) {
        pg8::Gemm g{OG, WoT, DM, DM, DM, nullptr, XN2, IDN}; pg8::DenseSched S; S.o.init(NTOK / 256, DM / 256, G, bx);
        pg8::EpiStoreRes E{X3B, PART3};
        pg8::gemm_phase<pg8::EpiStoreRes, pg8::DenseSched, false, true>(lds, g, S, E);
    }
    SEAM(15);

    { MoeCtx MC{lds, MISC, ws, G, bx, vcu, wave, lo, hi, args.in[I_MBGROUP], args.in[I_MBROUTER], args.in[I_FNORM], args.out, args.in[I_MWOUT]};
      moe_block<1>(MC, bar); }

#ifdef DBG_CHECK_ATTN
    GRID_BAR();
    if (bx == 0 && threadIdx.x == 0) args.out[0] = 0.f;
    GRID_BAR();
    if (bx < 64) {
        int ctid = threadIdx.x; asm volatile("" : "+v"(ctid));
        LAS float* red = (LAS float*)lds; LAS float* qv = red + 512; LAS float* sc = qv + 128;
        const int smp = bx; const int bh = (smp * 7) % 32;
        const int tlist[16] = {0, 1, 31, 32, 63, 64, 255, 256, 257, 511, 4095, 4096, 8191, 12345, 15000, 16383};
        const int t = tlist[smp % 16]; const int b = bh / 16, h = bh % 16;
        if (ctid < 128) qv[ctid] = bf2f(Qb[((size_t)bh * SEQ + t) * 128 + ctid]);
        LDS_WAIT(); __syncthreads();
        const float ct = CUM[(size_t)bh * SEQ + t];
        float mx = -1e30f;
        for (int s0 = ctid; s0 <= t; s0 += NTHREADS) { float d = 0.f; for (int k = 0; k < 128; ++k) d += qv[k] * bf2f(Kb[((size_t)bh * SEQ + s0) * 128 + k]); d += ct - CUM[(size_t)bh * SEQ + s0]; sc[s0] = d; mx = fmaxf(mx, d); }
        red[ctid] = mx; LDS_WAIT(); __syncthreads(); for (int o = 256; o > 0; o >>= 1) { if (ctid < o) red[ctid] = fmaxf(red[ctid], red[ctid + o]); LDS_WAIT(); __syncthreads(); }
        const float m = red[0]; __syncthreads();
        float ls = 0.f;
        for (int s0 = ctid; s0 <= t; s0 += NTHREADS) { const float p = expf(sc[s0] - m); sc[s0] = p; ls += p; }
        red[ctid] = ls; LDS_WAIT(); __syncthreads(); for (int o = 256; o > 0; o >>= 1) { if (ctid < o) red[ctid] += red[ctid + o]; LDS_WAIT(); __syncthreads(); }
        const float l = red[0]; __syncthreads();
        float err = 0.f;
        if (ctid < 128) { float o = 0.f; for (int s0 = 0; s0 <= t; ++s0) o += sc[s0] * bf2f(Vb[((size_t)bh * SEQ + s0) * 128 + ctid]);
            const size_t gi = ((size_t)b * SEQ + t) * DM + h * 128 + ctid; const float ref = o / l * bf2f(SG[gi]); err = fabsf(ref - bf2f(OG[gi])); }
        red[ctid] = err; LDS_WAIT(); __syncthreads(); for (int o = 256; o > 0; o >>= 1) { if (ctid < o) red[ctid] = fmaxf(red[ctid], red[ctid + o]); LDS_WAIT(); __syncthreads(); }
        if (ctid == 0) atomicMax((int*)args.out, __float_as_int(red[0] * 1000.f));
    }
#endif

#ifdef DBG_CHECK_RGLRU
    GRID_BAR();
    if (bx == 0 && threadIdx.x == 0) args.out[0] = 0.f;
    GRID_BAR();
    if (bx < 16) {
        int ctid = threadIdx.x; asm volatile("" : "+v"(ctid));
        LAS float* lav = (LAS float*)lds; LAS float* bbv = lav + 16384;
        const int clist[8] = {0, 5, 255, 256, 1000, 1029, 1800, 2047};
        const int b = bx >> 3, c = clist[bx & 7], nb = c >> 8, cc = c & 255;
        const float* wr_ = args.in[I_AWREC] + (size_t)nb * 65536 + cc; const float* wi_ = args.in[I_AWINP] + (size_t)nb * 65536 + cc;
        const float brc = args.in[I_ABREC][c], bic = args.in[I_ABINP][c], lam = args.in[I_ALAMBDA][c];
        const float sp = fmaxf(-lam, 0.f) + log1pf(expf(-fabsf(lam)));
        for (int s0 = ctid; s0 < SEQ; s0 += NTHREADS) { const bf16_t* ur = UC + ((size_t)b * SEQ + s0) * DM + nb * 256; float rl = brc, il = bic;
            for (int k = 0; k < 256; ++k) { const float uk = bf2f(ur[k]); rl += uk * wr_[(size_t)k * 256]; il += uk * wi_[(size_t)k * 256]; }
            const float r = 1.f / (1.f + expf(-rl)), ig = 1.f / (1.f + expf(-il)); const float la = -8.f * r * sp; const float a2 = expf(2.f * la);
            lav[s0] = la; bbv[s0] = sqrtf(fmaxf(1.f - a2, 0.f)) * ig * bf2f(ur[cc]); }
        LDS_WAIT(); __syncthreads();
        if (ctid == 0) { float h = 0.f, err = 0.f;
            for (int s0 = 0; s0 < SEQ; ++s0) { h = expf(lav[s0]) * h + bbv[s0];
                if ((s0 & 127) == 127 || (s0 & 127) == 0 || s0 < 8) { const size_t gi = ((size_t)b * SEQ + s0) * DM + c; err = fmaxf(err, fabsf(h * bf2f(GY[gi]) - bf2f(HS[gi]))); } }
            atomicMax((int*)args.out, __float_as_int(err * 1000.f)); }
    }
#endif
#undef IN
#undef SEAM
}


#ifdef DBG_CMP
__global__ void dbg_cmp_kernel(const unsigned* a, const unsigned* b, const unsigned* gcnt, float* out, size_t nout) {
    unsigned long long bad = 0; size_t rows = 0;
    for (int e = 0; e < 64; ++e) rows += ((gcnt[e] + 255u) >> 8) << 8;
    const size_t n = rows * 512 / 2;
    for (size_t i = (size_t)blockIdx.x * blockDim.x + threadIdx.x; i < n; i += (size_t)gridDim.x * blockDim.x) if (a[i] != b[i]) ++bad;
    for (size_t i = (size_t)blockIdx.x * blockDim.x + threadIdx.x; i < nout; i += (size_t)gridDim.x * blockDim.x) out[i] = 0.f;
    if (bad) atomicAdd(out, (float)bad);
}
#endif

#ifdef DBG_VALID
__global__ void dbg_valid_kernel(const unsigned* buf, int nwords, const unsigned* gcnt, unsigned* out, size_t nout) {
    __shared__ int ts[65]; __shared__ int cn[64];
    if (threadIdx.x == 0) { int t = 0; for (int e = 0; e < 64; ++e) { ts[e] = t; cn[e] = (int)gcnt[e]; t += ((int)gcnt[e] + 255) >> 8; } ts[64] = t; }
    __syncthreads();
    for (size_t i = (size_t)blockIdx.x * blockDim.x + threadIdx.x; i < nout; i += (size_t)gridDim.x * blockDim.x) {
        const size_t row = i / nwords; unsigned v = 0u;
        if (row < (size_t)ts[64] * 256) { const int tile = (int)(row >> 8); int e = 0; while (e < 63 && ts[e + 1] <= tile) ++e;
            const int r = (int)(row - (size_t)ts[e] * 256); if (r < cn[e]) v = buf[i]; }
        out[i] = v; }
}
#endif

extern "C" void kernel_launch(void* const* d_in, const int* in_sizes, int n_in, void* d_out, int out_size, void* d_ws, size_t ws_size, hipStream_t stream) {
    static int grid = 0;
    if (grid == 0) {
        if (n_in != 25 || in_sizes[0] != NTOK * DM || out_size != NTOK * DM || ws_size < WS_END) {
            fprintf(stderr, "kernel_launch: unexpected shapes (n_in %d, in0 %d, out %d, ws %zu < %zu); nothing launched\n", n_in, n_in > 0 ? in_sizes[0] : -1, out_size, ws_size, (size_t)WS_END); grid = -1; return; }
        int dev = 0, cus = 0, per_cu = 0;
        if (hipGetDevice(&dev) != hipSuccess || hipDeviceGetAttribute(&cus, hipDeviceAttributeMultiprocessorCount, dev) != hipSuccess) { fprintf(stderr, "kernel_launch: device query failed\n"); grid = -1; return; }
        if (hipFuncSetAttribute((const void*)fwd_kernel, hipFuncAttributeMaxDynamicSharedMemorySize, LDS_BYTES) != hipSuccess) { fprintf(stderr, "kernel_launch: hipFuncSetAttribute failed\n"); grid = -1; return; }
        if (hipOccupancyMaxActiveBlocksPerMultiprocessor(&per_cu, (const void*)fwd_kernel, NTHREADS, LDS_BYTES) != hipSuccess || per_cu < 1)
            fprintf(stderr, "kernel_launch: note: occupancy query reports %d workgroups per CU\n", per_cu);
        (void)hipGetLastError();
        grid = cus;
    }
    if (grid < 0) return;
    if (hipMemsetAsync((char*)d_ws + WS_CTL, 0, CTL_ZERO_BYTES, stream) != hipSuccess) { fprintf(stderr, "kernel_launch: memset failed\n"); return; }
    Args a{};
    for (int i = 0; i < 25; ++i) a.in[i] = (const float*)d_in[i];
    a.out = (float*)d_out; a.ws = (unsigned char*)d_ws;
#if MK_PER_PHASE
#ifndef DBG_LAST
#define DBG_LAST (NPHASES - 1)
#endif
    for (int p = 0; p <= DBG_LAST; ++p) { a.ph_lo = p; a.ph_hi = p + 1; hipLaunchKernelGGL(fwd_kernel, dim3(grid), dim3(NTHREADS), LDS_BYTES, stream, a); }
#ifdef DBG_OUT
    hipMemcpyAsync(d_out, (char*)d_ws + DBG_OUT, (size_t)NTOK * DM * 4, hipMemcpyDeviceToDevice, stream);
#endif
#ifdef DBG_VALID
    hipLaunchKernelGGL(dbg_valid_kernel, dim3(2048), dim3(256), 0, stream, (const unsigned*)((char*)d_ws + DBG_VALID), DBG_VALID_WORDS, (const unsigned*)d_ws + CW_GCNT + 64 * DBG_VALID_LAYER, (unsigned*)d_out, (size_t)NTOK * DM);
#endif
#ifdef DBG_CMP
    a.alt = 1; a.ph_lo = DBG_LAST; a.ph_hi = DBG_LAST + 1; hipLaunchKernelGGL(fwd_kernel, dim3(grid), dim3(NTHREADS), LDS_BYTES, stream, a); a.alt = 0;
    hipLaunchKernelGGL(dbg_cmp_kernel, dim3(1024), dim3(256), 0, stream, (const unsigned*)((char*)d_ws + WS_ACT), (const unsigned*)((char*)d_ws + (size_t)3400 * MiB), (const unsigned*)d_ws + CW_GCNT + 64, (float*)d_out, (size_t)NTOK * DM);
#endif
#else
    a.ph_lo = 0; a.ph_hi = NPHASES;
    hipLaunchKernelGGL(fwd_kernel, dim3(grid), dim3(NTHREADS), LDS_BYTES, stream, a);
#ifdef PROBE_EXTRA
    { const int plist[] = {PROBE_EXTRA}; for (int r = 0; r < PROBE_REPS; ++r) for (int p : plist) { if (p == 14) hipMemsetAsync((char*)d_ws + WS_CTL + CW_AQ * 4, 0, 4, stream); a.ph_lo = p; a.ph_hi = p + 1; hipLaunchKernelGGL(fwd_kernel, dim3(grid), dim3(NTHREADS), LDS_BYTES, stream, a); } }
#endif
#endif
    const hipError_t le = hipPeekAtLastError();
    if (le != hipSuccess) fprintf(stderr, "kernel_launch: launch failed: %s\n", hipGetErrorName(le));
}
```

```cpp
#include <hip/hip_runtime.h>
#include <cstdio>
#include <cstdint>


#ifndef MK_PER_PHASE
#define MK_PER_PHASE 0
#endif

#define LAS __attribute__((address_space(3)))
#define GAS __attribute__((address_space(1)))
typedef unsigned short bf16_t;
typedef short bf16x8 __attribute__((ext_vector_type(8)));
typedef short s16x4 __attribute__((ext_vector_type(4)));
typedef float f32x4 __attribute__((ext_vector_type(4)));
typedef float f32x2 __attribute__((ext_vector_type(2)));
typedef float f32x16 __attribute__((ext_vector_type(16)));
typedef unsigned u32x4 __attribute__((ext_vector_type(4)));
typedef unsigned u32x2 __attribute__((ext_vector_type(2)));

constexpr int NB = 2, SEQ = 16384, DM = 2048, NTOK = NB * SEQ;
constexpr int NHEAD = 16, HDIM = 128;
constexpr int NEXP = 64, DEXP = 512, LCAP = 65536;
constexpr int NKVQG = 8448;
constexpr float RMS_EPS = 1e-6f;
constexpr int NWAVES = 8, NTHREADS = 512;

constexpr size_t MiB = (size_t)1 << 20;
constexpr size_t WS_CTL = 0, CTL_ZERO_BYTES = 1 * MiB;
constexpr size_t WS_WIN = 1 * MiB, WS_WG = 17 * MiB, WS_WOUT = 19 * MiB, WS_WKVQG = 27 * MiB, WS_WO = 60 * MiB, WS_WR = 68 * MiB;
constexpr size_t WS_WMI = 70 * MiB, WS_WMO = 582 * MiB, WS_LVEC = 838 * MiB;
constexpr size_t WS_H0 = 839 * MiB, WS_U = 967 * MiB, WS_GY = 1095 * MiB, WS_UC = 1223 * MiB, WS_LA = 1351 * MiB, WS_BB = 1479 * MiB, WS_HS = 1607 * MiB;
constexpr size_t WS_X1B = 1735 * MiB, WS_PART = 1863 * MiB, WS_CARRY = 1867 * MiB;
constexpr size_t WS_ASG = 1871 * MiB, WS_TOKL = 1873 * MiB, WS_RSL = 1889 * MiB, WS_ACT = 1905 * MiB, WS_YB = 1985 * MiB;
constexpr size_t WS_X2 = 2305 * MiB, WS_XN2 = 2561 * MiB;
constexpr size_t WS_KB = 2689 * MiB, WS_VB = 2817 * MiB, WS_QB = 2945 * MiB, WS_SG = 3073 * MiB, WS_OG = 3201 * MiB;
constexpr size_t WS_FLOG = 3329 * MiB, WS_CUM = 3331 * MiB;
constexpr size_t WS_X3B = 3333 * MiB, WS_PART3 = 3461 * MiB;
constexpr size_t WS_MOE1 = 3465 * MiB, MOE_LAYER_STRIDE = WS_MOE1 - WS_ASG;
constexpr size_t WS_END = WS_MOE1 + 434 * MiB;
constexpr int CW_BAR = 4096;
constexpr int CW_GCNT = 8192;
constexpr int CW_NRM = 12288;
constexpr int CW_AQ = 13440;

constexpr int RING_BYTES = 131072;
constexpr int MISC_OFF = 139264;
constexpr int LDS_BYTES = 147456;
constexpr int MI_BAR = 0, MI_TSTART = 16, MI_CNT = 96;

__device__ __forceinline__ unsigned cvt_pk_bf16(float lo, float hi) { unsigned r; asm volatile("s_nop 0\n\tv_cvt_pk_bf16_f32 %0, %1, %2" : "=v"(r) : "v"(lo), "v"(hi)); return r; }
__device__ __forceinline__ float bflo(unsigned w) { return __uint_as_float(w << 16); }
__device__ __forceinline__ float bfhi(unsigned w) { return __uint_as_float(w & 0xffff0000u); }
__device__ __forceinline__ float bf2f(bf16_t h) { return __uint_as_float(((unsigned)h) << 16); }
__device__ __forceinline__ float fast_exp(float x) { return __builtin_amdgcn_exp2f(x * 1.4426950408889634f); }
__device__ __forceinline__ float fast_sigmoid(float x) { return __builtin_amdgcn_rcpf(1.0f + fast_exp(-x)); }
__device__ __forceinline__ float wave_sum(float v) {
#pragma unroll
    for (int o = 1; o < 64; o <<= 1) v += __shfl_xor(v, o);
    return v;
}
#define LDS_WAIT() asm volatile("s_waitcnt lgkmcnt(0)" ::: "memory")
#define VM_WAIT() asm volatile("s_waitcnt vmcnt(0)" ::: "memory")

#define XB_TMO      128
#define XB_XCNT(j)  (256  + 64 * (j))
#define XB_XSUB(j)  (1280 + 64 * (j))
#define XB_XGEN(j)  (2304 + 64 * (j))
#define XB_TOP      3328
#define XB_TOPGEN   3392
#define XCD_BAR_WORDS 3456
#define XB_SPIN_CAP (1u << 18)

__device__ __forceinline__ unsigned xb_ld(unsigned* p)              { return __hip_atomic_load(p, __ATOMIC_RELAXED, __HIP_MEMORY_SCOPE_AGENT); }
__device__ __forceinline__ unsigned xb_add(unsigned* p, unsigned v) { return __hip_atomic_fetch_add(p, v, __ATOMIC_RELAXED, __HIP_MEMORY_SCOPE_AGENT); }
__device__ __forceinline__ unsigned xb_xcc_id() { return (unsigned)__builtin_amdgcn_s_getreg((3 << 11) | 20) & 0xFu; }
#define XB_SPIN(cond, bar) do { unsigned _sp = 0; while (cond) { __builtin_amdgcn_s_sleep(1); \
    if ((++_sp & 255u) == 0u) { if (xb_ld(&(bar)[XB_TMO])) break; if (_sp > XB_SPIN_CAP) { atomicAdd(&(bar)[XB_TMO], 1u); break; } } } } while (0)

struct XcdBarrier { unsigned* bar; unsigned x; volatile LAS unsigned* st; };

__device__ __forceinline__ XcdBarrier xcd_barrier_post(unsigned* bar, volatile LAS unsigned* st) {
    XcdBarrier b; b.bar = bar; b.x = xb_xcc_id(); b.st = st;
    if (threadIdx.x == 0) (void)xb_add(&bar[XB_XCNT(b.x)], 1u);
    return b;
}
__device__ __forceinline__ void xcd_barrier_complete(unsigned* bar, unsigned x, unsigned& nloc, unsigned& nx) {
    const unsigned G = gridDim.x * gridDim.y * gridDim.z;
    unsigned sum, cnt, mine, sp = 0u;
    for (;;) {
        sum = 0u; cnt = 0u; mine = 0u;
#pragma unroll
        for (unsigned j = 0; j < 16; ++j) { const unsigned c = xb_ld(&bar[XB_XCNT(j)]); sum += c; cnt += (c > 0u) ? 1u : 0u; mine = (j == x) ? c : mine; }
        if (sum == G) break;
        __builtin_amdgcn_s_sleep(1);
        if ((++sp & 255u) == 0u) { if (xb_ld(&bar[XB_TMO])) break; if (sp > XB_SPIN_CAP) { atomicAdd(&bar[XB_TMO], 1u); break; } }
    }
    nloc = mine > 0u ? mine : 1u; nx = cnt > 0u ? cnt : 1u;
}
__device__ __forceinline__ void xcd_barrier(const XcdBarrier& b) {
    asm volatile("s_waitcnt vmcnt(0)" ::: "memory");
    __syncthreads();
    if (threadIdx.x == 0) {
        unsigned* bar = b.bar;
        __builtin_amdgcn_s_waitcnt(0);
        unsigned nloc = b.st[0], nx = b.st[1];
        if (nloc == 0u) { xcd_barrier_complete(bar, b.x, nloc, nx); b.st[0] = nloc; b.st[1] = nx; }
        const unsigned old = xb_add(&bar[XB_XSUB(b.x)], 1u);
        const unsigned gen = old / nloc;
        if (old + 1u == (gen + 1u) * nloc) {
            __builtin_amdgcn_fence(__ATOMIC_RELEASE, "agent");
            asm volatile("s_waitcnt vmcnt(0)" ::: "memory");
            const unsigned og = xb_add(&bar[XB_TOP], 1u);
            const unsigned tg = og / nx;
            if (og + 1u == (tg + 1u) * nx) xb_add(&bar[XB_TOPGEN], 1u);
            else XB_SPIN(xb_ld(&bar[XB_TOPGEN]) == tg, bar);
            __builtin_amdgcn_fence(__ATOMIC_ACQUIRE, "agent");
            xb_add(&bar[XB_XGEN(b.x)], 1u);
            asm volatile("s_waitcnt vmcnt(0)" ::: "memory");
        } else {
            XB_SPIN(xb_ld(&bar[XB_XGEN(b.x)]) == gen, bar);
            __builtin_amdgcn_fence(__ATOMIC_ACQUIRE, "agent");
            asm volatile("s_waitcnt vmcnt(0)" ::: "memory");
        }
    }
    __syncthreads();
}

namespace pg8 {
constexpr int BM = 256, BK = 64, HALF = 128, HTB = HALF * BK * 2, STAGE_BYTES = 8 * HTB, NXCD = 8, WGM = 8;
__host__ __device__ __forceinline__ int lds_byte(int r, int c) { const int st = (r >> 4) * 2 + (c >> 5), rr = r & 15, cc = c & 31, ob = rr * 64 + cc * 2; return st * 1024 + (ob ^ (((ob >> 9) & 1) << 5)); }
__host__ __device__ __forceinline__ void stage_rc(int b, int& R, int& C) { const int st = b / 1024, sb = b % 1024, swz = sb ^ (((sb >> 9) & 1) << 5); R = (st >> 1) * 16 + swz / 64; C = (st & 1) * 32 + (swz % 64) / 2; }
__host__ __device__ __forceinline__ int perm32(int rho) { const int n = rho >> 4, i = rho & 15; return 8 * (i >> 2) + 4 * n + (i & 3); }

struct Unit { int a0, acol, b0, pm, pn, e, nv, prow0; };
struct Gemm { const bf16_t* A; const bf16_t* Bt; int lda, ldb, K; const int* glist; const bf16_t* R; const bf16_t* I; };

__device__ __forceinline__ int xcd_remap(int L, int nwg) { const int q = nwg / NXCD, r = nwg % NXCD, xcd = L % NXCD, off = L / NXCD; return (xcd < r ? xcd * (q + 1) : r * (q + 1) + (xcd - r) * q) + off; }
struct GridOrder {
    int nM, nN, nwg, G, c;
    __device__ __forceinline__ void init(int nM_, int nN_, int G_, int c_) { nM = nM_; nN = nN_; nwg = nM * nN; G = G_; c = c_; }
    __device__ __forceinline__ bool tile(int i, int& pm, int& pn) const {
        const long L = (long)i * G + c; if (L >= nwg) return false;
        const int wgid = xcd_remap((int)L, nwg);
        const int nig = WGM * nN, gid = wgid / nig, fm = gid * WGM, gsz = (nM - fm) < WGM ? (nM - fm) : WGM;
        pm = fm + ((wgid % nig) % gsz); pn = (wgid % nig) / gsz; return true;
    }
};
struct DenseSched { GridOrder o;
    __device__ __forceinline__ bool next(int i, Unit& u) const { int pm, pn; if (!o.tile(i, pm, pn)) return false; u.pm = pm; u.pn = pn; u.a0 = pm * BM; u.acol = 0; u.b0 = pn * BM; u.e = 0; u.nv = BM; u.prow0 = pm * BM; return true; } };
struct GateSched { GridOrder o;
    __device__ __forceinline__ bool next(int i, Unit& u) const { int pm, pn; if (!o.tile(i, pm, pn)) return false; u.pm = pm; u.pn = pn; u.a0 = pm * BM; u.acol = (pn >> 1) * 256; u.b0 = pn * BM; u.e = 0; u.nv = BM; u.prow0 = pm * BM; return true; } };
template <bool GATHER> struct MoeSched {
    const LAS int* tstart; const LAS int* cnt; int NTN, G, c, nunits, brows;
    __device__ __forceinline__ bool next(int i, Unit& u) const {
        const long L = (long)i * G + c; if (L >= nunits) return false;
        const int wgid = xcd_remap((int)L, nunits);
        int lane = threadIdx.x & 63; asm volatile("" : "+v"(lane));
        const int uend = tstart[lane + 1] * NTN;
        const int e = __builtin_popcountll(__ballot(uend <= wgid));
        const int ts = tstart[e], nte = tstart[e + 1] - ts, idx = wgid - ts * NTN;
        const int mt = idx % nte, nt = idx / nte;
        const int ce = cnt[e];
        u.e = e; u.pm = mt; u.pn = nt; u.prow0 = (ts + mt) * BM; u.nv = (ce - mt * BM) < BM ? (ce - mt * BM) : BM;
        u.a0 = GATHER ? (e * LCAP + mt * BM) : u.prow0; u.acol = 0; u.b0 = e * brows + nt * BM;
        return true;
    }
};

template <class Epi, class Sched, bool GATHER, bool ALIGN_EPI>
__device__ __forceinline__ void gemm_phase(LAS unsigned char* lds, const Gemm g, const Sched& S, const Epi& E) {
    int tid = threadIdx.x; asm volatile("" : "+v"(tid));
    const int wid = __builtin_amdgcn_readfirstlane(tid >> 6), lane = tid & 63, wr = wid >> 2, wc = wid & 3, fr = lane & 15, fq = lane >> 4;
    const int K = g.K, nt = K / BK, ntot = nt + (Epi::RESK ? BM / BK : 0);
    int Rr[2], Cc[2];
    unsigned voffB[2];
#pragma unroll
    for (int i = 0; i < 2; ++i) { int R, C; stage_rc(tid * 16 + i * 8192, R, C); Rr[i] = R; Cc[i] = C; const int Rb = Epi::PERM ? ((R & ~31) + perm32(R & 31)) : R;
        voffB[i] = (unsigned)(Rb * g.ldb + C) * 2u; }
    const size_t kstep = (size_t)(BK * 2);
    const size_t hstepB = (size_t)HALF * g.ldb * 2;
    const unsigned ldsw = (unsigned)wid * 1024u;
    const int aoff = lds_byte(wr * 64 + fr, fq * 8), boff = lds_byte(wc * 32 + fr, fq * 8);
#define PG8_SA(b, h) (((b) * 2 + (h)) * HTB)
#define PG8_SB(b, h) ((4 + (b) * 2 + (h)) * HTB)
#define PG8_STAGE_B(bufoff, gbase) do { _Pragma("unroll") for (int _i = 0; _i < 2; ++_i) \
        __builtin_amdgcn_global_load_lds((const unsigned*)((const char*)(gbase) + voffB[_i]), (LAS unsigned*)(lds + (bufoff) + ldsw + _i * 8192), 16, 0, 0); } while (0)
#define PG8_STAGE_A(bufoff, gbase, vo, h) do { _Pragma("unroll") for (int _i = 0; _i < 2; ++_i) \
        __builtin_amdgcn_global_load_lds((const unsigned*)((const char*)(gbase) + (vo)[h][_i]), (LAS unsigned*)(lds + (bufoff) + ldsw + _i * 8192), 16, 0, 0); } while (0)
#define PG8_LDA(dst, b, h) do { _Pragma("unroll") for (int m = 0; m < 4; ++m) _Pragma("unroll") for (int k = 0; k < 2; ++k) dst[m][k] = *(const LAS bf16x8*)(lds + PG8_SA(b, h) + aoff + m * 2048 + k * 1024); } while (0)
#define PG8_LDB(dst, b, h) do { _Pragma("unroll") for (int n = 0; n < 2; ++n) _Pragma("unroll") for (int k = 0; k < 2; ++k) dst[n][k] = *(const LAS bf16x8*)(lds + PG8_SB(b, h) + boff + n * 2048 + k * 1024); } while (0)
#define PG8_MMA(ai, bj, At, Bt) do { __builtin_amdgcn_s_setprio(1); _Pragma("unroll") for (int m = 0; m < 4; ++m) _Pragma("unroll") for (int n = 0; n < 2; ++n) _Pragma("unroll") for (int k = 0; k < 2; ++k) \
        acc[ai][bj][m][n] = __builtin_amdgcn_mfma_f32_16x16x32_bf16(Bt[n][k], At[m][k], acc[ai][bj][m][n], 0, 0, 0); __builtin_amdgcn_s_setprio(0); } while (0)
#define PG8_WAIT_V(n) asm volatile("s_waitcnt vmcnt(" #n ")" ::: "memory")
#define PG8_WAIT_L(n) asm volatile("s_waitcnt lgkmcnt(" #n ")" ::: "memory")
#define PG8_BAR __builtin_amdgcn_s_barrier()
#define PG8_SCHED __builtin_amdgcn_sched_barrier(0)
#define PG8_AOFFS(vo, u) do { _Pragma("unroll") for (int _h = 0; _h < 2; ++_h) _Pragma("unroll") for (int _i = 0; _i < 2; ++_i) { const int _r = _h * HALF + Rr[_i]; \
        if (GATHER) { int _t = g.glist[(u).a0 + _r]; _t = (_r < (u).nv) ? _t : 0; (vo)[_h][_i] = (unsigned)(_t * g.lda + Cc[_i]) * 2u; } \
        else (vo)[_h][_i] = (unsigned)(_r * g.lda + Cc[_i]) * 2u; } } while (0)
#define PG8_ABASE(u) ((const char*)g.A + (GATHER ? (size_t)(u).acol * 2 : ((size_t)(u).a0 * g.lda + (u).acol) * 2))
    Unit cur, nxt; int ui = 0;
    if (!S.next(0, cur)) return;
    f32x4 acc[2][2][4][2];
#pragma unroll
    for (int a = 0; a < 2; ++a)
#pragma unroll
        for (int b = 0; b < 2; ++b)
#pragma unroll
            for (int m = 0; m < 4; ++m)
#pragma unroll
                for (int n = 0; n < 2; ++n) acc[a][b][m][n] = (f32x4){0.f, 0.f, 0.f, 0.f};
    bf16x8 At[4][2], B0[2][2], B1[2][2];
    unsigned vA[2][2], vN[2][2];
    PG8_AOFFS(vA, cur);
    const char* cA = PG8_ABASE(cur); const char* cB = (const char*)g.Bt + (size_t)cur.b0 * g.ldb * 2;
    PG8_STAGE_B(PG8_SB(0, 0), cB); PG8_STAGE_B(PG8_SB(0, 1), cB + hstepB); PG8_STAGE_A(PG8_SA(0, 0), cA, vA, 0); PG8_STAGE_A(PG8_SA(0, 1), cA, vA, 1);
    if (wr == 1) PG8_BAR;
    PG8_WAIT_V(2); PG8_BAR;
    PG8_STAGE_B(PG8_SB(1, 0), cB + kstep); PG8_STAGE_A(PG8_SA(1, 0), cA + kstep, vA, 0); PG8_STAGE_B(PG8_SB(1, 1), cB + hstepB + kstep);
    PG8_WAIT_V(6); PG8_BAR;
    for (;;) {
        const bool has_next = S.next(ui + 1, nxt);
        const char* nA = cA; const char* nB = cB;
        if (has_next) { nA = PG8_ABASE(nxt); nB = (const char*)g.Bt + (size_t)nxt.b0 * g.ldb * 2; }
        if (GATHER) { if (has_next) { PG8_AOFFS(vN, nxt); } else {
#pragma unroll
            for (int _h = 0; _h < 2; ++_h)
#pragma unroll
                for (int _i = 0; _i < 2; ++_i) vN[_h][_i] = vA[_h][_i]; } }
#pragma nounroll
        for (int t = 0; t < ntot; t += 2) {
            const bool last = (t == ntot - 2);
            const char* a1; const char* a2; const char* b2;
            if constexpr (Epi::RESK) {
                const char* rA = (const char*)g.R + ((size_t)cur.prow0 * g.lda + (size_t)cur.pn * BM) * 2;
                a1 = (t < nt ? cA + (size_t)t * kstep : rA + (size_t)(t - nt) * kstep) + kstep;
                a2 = last ? nA : (t + 2 < nt ? cA + (size_t)(t + 2) * kstep : rA + (size_t)(t + 2 - nt) * kstep);
                b2 = last ? nB : (t + 2 < nt ? cB + (size_t)(t + 2) * kstep : (const char*)g.I + (size_t)(t + 2 - nt) * kstep);
            } else {
                a1 = cA + (size_t)(t + 1) * kstep;
                a2 = last ? nA : cA + (size_t)(t + 2) * kstep; b2 = last ? nB : cB + (size_t)(t + 2) * kstep; }
            const char* a3 = a2 + kstep; const char* b3 = b2 + kstep;
            unsigned v2[2][2];
#pragma unroll
            for (int _h = 0; _h < 2; ++_h)
#pragma unroll
                for (int _i = 0; _i < 2; ++_i) v2[_h][_i] = (GATHER && last) ? vN[_h][_i] : vA[_h][_i];
            PG8_LDB(B0, 0, 0); PG8_LDB(B1, 0, 1); PG8_SCHED; PG8_LDA(At, 0, 0); PG8_STAGE_A(PG8_SA(1, 1), a1, vA, 1);
            PG8_WAIT_V(8); PG8_WAIT_L(0); PG8_BAR; PG8_MMA(0, 0, At, B0); PG8_MMA(0, 1, At, B1); PG8_BAR; PG8_SCHED;
            PG8_LDA(At, 0, 1); PG8_STAGE_B(PG8_SB(0, 0), b2); PG8_STAGE_B(PG8_SB(0, 1), b2 + hstepB); PG8_STAGE_A(PG8_SA(0, 0), a2, v2, 0);
            PG8_WAIT_V(8); PG8_WAIT_L(0); PG8_BAR; PG8_MMA(1, 0, At, B0); PG8_MMA(1, 1, At, B1); PG8_BAR; PG8_SCHED;
            PG8_LDB(B0, 1, 0); PG8_LDB(B1, 1, 1); PG8_SCHED; PG8_LDA(At, 1, 0); PG8_STAGE_A(PG8_SA(0, 1), a2, v2, 1);
            PG8_WAIT_V(8); PG8_WAIT_L(0); PG8_BAR; PG8_MMA(0, 0, At, B0); PG8_MMA(0, 1, At, B1); PG8_BAR; PG8_SCHED;
            PG8_LDA(At, 1, 1); PG8_STAGE_B(PG8_SB(1, 0), b3); PG8_STAGE_B(PG8_SB(1, 1), b3 + hstepB); PG8_STAGE_A(PG8_SA(1, 0), a3, v2, 0);
            PG8_WAIT_V(8); PG8_WAIT_L(0); PG8_BAR; PG8_MMA(1, 0, At, B0); PG8_MMA(1, 1, At, B1); PG8_BAR; PG8_SCHED;
        }
        if constexpr (ALIGN_EPI) { if (wr == 0) PG8_BAR; }
        if constexpr (!Epi::AFTER_DRAIN) { E(acc, cur, wr, wc, fr, fq); }
        if (!has_next) break;
#pragma unroll
        for (int a = 0; a < 2; ++a)
#pragma unroll
            for (int b = 0; b < 2; ++b)
#pragma unroll
                for (int m = 0; m < 4; ++m)
#pragma unroll
                    for (int n = 0; n < 2; ++n) acc[a][b][m][n] = (f32x4){0.f, 0.f, 0.f, 0.f};
        cur = nxt; cA = nA; cB = nB; ++ui;
        if (GATHER) {
#pragma unroll
            for (int _h = 0; _h < 2; ++_h)
#pragma unroll
                for (int _i = 0; _i < 2; ++_i) vA[_h][_i] = vN[_h][_i]; }
        if constexpr (ALIGN_EPI) { if (wr == 1) PG8_BAR; }
    }
    PG8_WAIT_V(0);
    if constexpr (!ALIGN_EPI) { if (wr == 0) PG8_BAR; }
    PG8_BAR;
    if constexpr (Epi::AFTER_DRAIN) { E.fused(acc, cur, wr, wc, fr, fq, lds, wid, lane); }
#undef PG8_SA
#undef PG8_SB
#undef PG8_STAGE_A
#undef PG8_STAGE_B
#undef PG8_LDA
#undef PG8_LDB
#undef PG8_MMA
#undef PG8_WAIT_V
#undef PG8_WAIT_L
#undef PG8_BAR
#undef PG8_SCHED
#undef PG8_AOFFS
#undef PG8_ABASE
}

__device__ __forceinline__ u32x4 pack8(const f32x4& a, const f32x4& b) { u32x4 w; w.x = cvt_pk_bf16(a[0], a[1]); w.y = cvt_pk_bf16(a[2], a[3]); w.z = cvt_pk_bf16(b[0], b[1]); w.w = cvt_pk_bf16(b[2], b[3]); return w; }
__device__ __forceinline__ float gelu_tanh(float y) {
    const float t = y * (1.0f + 0.044715f * y * y);
    return y * __builtin_amdgcn_rcpf(1.0f + __builtin_amdgcn_exp2f(t * (-2.0f * 0.7978845608028654f * 1.4426950408889634f)));
}

struct EpiInProj {
    static constexpr bool PERM = true, AFTER_DRAIN = false, RESK = false;
    bf16_t* U; bf16_t* GY; const float* RS;
    __device__ __forceinline__ void operator()(const f32x4 (&acc)[2][2][4][2], const Unit& u, int wr, int wc, int fr, int fq) const {
        const bool isy = u.pn >= 8; bf16_t* base = isy ? GY : U; const int colt = (isy ? u.pn - 8 : u.pn) * BM + wc * 32 + 8 * fq;
        float rs[2][4];
#pragma unroll
        for (int ai = 0; ai < 2; ++ai)
#pragma unroll
            for (int m = 0; m < 4; ++m) rs[ai][m] = RS[u.pm * BM + ai * HALF + wr * 64 + m * 16 + fr];
#pragma unroll
        for (int ai = 0; ai < 2; ++ai)
#pragma unroll
            for (int m = 0; m < 4; ++m) { bf16_t* rowp = base + (size_t)(u.pm * BM + ai * HALF + wr * 64 + m * 16 + fr) * DM + colt;
#pragma unroll
                for (int bj = 0; bj < 2; ++bj) { f32x4 v0 = acc[ai][bj][m][0] * rs[ai][m], v1 = acc[ai][bj][m][1] * rs[ai][m];
                    if (isy) {
#pragma unroll
                        for (int j = 0; j < 4; ++j) { v0[j] = gelu_tanh(v0[j]); v1[j] = gelu_tanh(v1[j]); } }
                    *(u32x4*)(rowp + bj * HALF) = pack8(v0, v1); } }
    }
};
struct EpiGates {
    static constexpr bool PERM = true, AFTER_DRAIN = false, RESK = false;
    const bf16_t* UC; bf16_t* LA; bf16_t* BB; const float* Lv; const float* brec; const float* binp;
    __device__ __forceinline__ void operator()(const f32x4 (&acc)[2][2][4][2], const Unit& u, int wr, int wc, int fr, int fq) const {
        const int cb = (u.pn >> 1) * 256 + (u.pn & 1) * 128 + wc * 32 + 8 * fq;
        u32x4 uw[2][4];
#pragma unroll
        for (int ai = 0; ai < 2; ++ai)
#pragma unroll
            for (int m = 0; m < 4; ++m) uw[ai][m] = *(const u32x4*)(UC + (size_t)(u.pm * BM + ai * HALF + wr * 64 + m * 16 + fr) * DM + cb);
#pragma unroll
        for (int ai = 0; ai < 2; ++ai)
#pragma unroll
            for (int m = 0; m < 4; ++m) { const size_t off = (size_t)(u.pm * BM + ai * HALF + wr * 64 + m * 16 + fr) * DM + cb;
                u32x4 lw, bw;
#pragma unroll
                for (int n = 0; n < 2; ++n) {
                    const f32x4 Lc = *(const f32x4*)(Lv + cb + 4 * n), rb = *(const f32x4*)(brec + cb + 4 * n), ib = *(const f32x4*)(binp + cb + 4 * n);
                    const unsigned ux = n ? uw[ai][m].z : uw[ai][m].x, uy = n ? uw[ai][m].w : uw[ai][m].y;
                    const float uu[4] = {bflo(ux), bfhi(ux), bflo(uy), bfhi(uy)};
                    float la[4], bb[4];
#pragma unroll
                    for (int j = 0; j < 4; ++j) {
                        const float r = fast_sigmoid(acc[ai][0][m][n][j] + rb[j]), ig = fast_sigmoid(acc[ai][1][m][n][j] + ib[j]);
                        const float l = r * Lc[j];
                        const float a2 = fast_exp(2.0f * l);
                        la[j] = l; bb[j] = __builtin_amdgcn_sqrtf(fmaxf(1.0f - a2, 0.0f)) * ig * uu[j]; }
                    if (n == 0) { lw.x = cvt_pk_bf16(la[0], la[1]); lw.y = cvt_pk_bf16(la[2], la[3]); bw.x = cvt_pk_bf16(bb[0], bb[1]); bw.y = cvt_pk_bf16(bb[2], bb[3]); }
                    else        { lw.z = cvt_pk_bf16(la[0], la[1]); lw.w = cvt_pk_bf16(la[2], la[3]); bw.z = cvt_pk_bf16(bb[0], bb[1]); bw.w = cvt_pk_bf16(bb[2], bb[3]); } }
                *(u32x4*)(LA + off) = lw; *(u32x4*)(BB + off) = bw; }
    }
};
struct EpiResid {
    static constexpr bool PERM = true, AFTER_DRAIN = false, RESK = false;
    const float* base; bf16_t* XB;
    __device__ __forceinline__ void operator()(const f32x4 (&acc)[2][2][4][2], const Unit& u, int wr, int wc, int fr, int fq) const {
        const int col0 = u.pn * BM + wc * 32 + 8 * fq;
#pragma unroll
        for (int ai = 0; ai < 2; ++ai)
#pragma unroll
            for (int m = 0; m < 4; ++m) { const int row = u.pm * BM + ai * HALF + wr * 64 + m * 16 + fr; const size_t off = (size_t)row * DM + col0;
#pragma unroll
                for (int bj = 0; bj < 2; ++bj) { const f32x4 b0 = *(const f32x4*)(base + off + bj * HALF), b1 = *(const f32x4*)(base + off + bj * HALF + 4);
                    *(u32x4*)(XB + off + bj * HALF) = pack8(acc[ai][bj][m][0] + b0, acc[ai][bj][m][1] + b1); } }
    }
};
struct EpiResidB {
    static constexpr bool PERM = true, AFTER_DRAIN = false, RESK = false;
    const bf16_t* base; bf16_t* XB;
    __device__ __forceinline__ void operator()(const f32x4 (&acc)[2][2][4][2], const Unit& u, int wr, int wc, int fr, int fq) const {
        const int col0 = u.pn * BM + wc * 32 + 8 * fq;
        u32x4 bw[2][4][2];
#pragma unroll
        for (int ai = 0; ai < 2; ++ai)
#pragma unroll
            for (int m = 0; m < 4; ++m)
#pragma unroll
                for (int bj = 0; bj < 2; ++bj) bw[ai][m][bj] = *(const u32x4*)(base + (size_t)(u.pm * BM + ai * HALF + wr * 64 + m * 16 + fr) * DM + col0 + bj * HALF);
#pragma unroll
        for (int ai = 0; ai < 2; ++ai)
#pragma unroll
            for (int m = 0; m < 4; ++m) { const int row = u.pm * BM + ai * HALF + wr * 64 + m * 16 + fr; const size_t off = (size_t)row * DM + col0;
#pragma unroll
                for (int bj = 0; bj < 2; ++bj) { const u32x4 b = bw[ai][m][bj];
                    const f32x4 b0 = {bflo(b.x), bfhi(b.x), bflo(b.y), bfhi(b.y)}, b1 = {bflo(b.z), bfhi(b.z), bflo(b.w), bfhi(b.w)};
                    *(u32x4*)(XB + off + bj * HALF) = pack8(acc[ai][bj][m][0] + b0, acc[ai][bj][m][1] + b1); } }
    }
};
struct EpiStoreRes {
    static constexpr bool PERM = true, AFTER_DRAIN = false, RESK = true;
    bf16_t* XB; float* part;
    __device__ __forceinline__ void operator()(const f32x4 (&acc)[2][2][4][2], const Unit& u, int wr, int wc, int fr, int fq) const {
        const int col0 = u.pn * BM + wc * 32 + 8 * fq;
#pragma unroll
        for (int ai = 0; ai < 2; ++ai)
#pragma unroll
            for (int m = 0; m < 4; ++m) { const int row = u.pm * BM + ai * HALF + wr * 64 + m * 16 + fr; bf16_t* rowp = XB + (size_t)row * DM + col0; float ss = 0.f;
#pragma unroll
                for (int bj = 0; bj < 2; ++bj) { const f32x4 v0 = acc[ai][bj][m][0], v1 = acc[ai][bj][m][1];
                    *(u32x4*)(rowp + bj * HALF) = pack8(v0, v1);
                    ss += ((v0[0] * v0[0] + v0[1] * v0[1]) + (v0[2] * v0[2] + v0[3] * v0[3])) + ((v1[0] * v1[0] + v1[1] * v1[1]) + (v1[2] * v1[2] + v1[3] * v1[3])); }
                ss += __shfl_xor(ss, 16); ss += __shfl_xor(ss, 32);
                if (fq == 0) part[(size_t)row * 32 + u.pn * 4 + wc] = ss; }
    }
};
struct EpiMoe1 {
    static constexpr bool PERM = true, AFTER_DRAIN = false, RESK = false;
    const float* RS; bf16_t* ACT;
    __device__ __forceinline__ void operator()(const f32x4 (&acc)[2][2][4][2], const Unit& u, int wr, int wc, int fr, int fq) const {
        const int col0 = u.pn * 128 + wc * 32 + 8 * fq;
#pragma unroll
        for (int ai = 0; ai < 2; ++ai) {
            float sv[4];
#pragma unroll
            for (int m = 0; m < 4; ++m) sv[m] = RS[u.a0 + ai * HALF + wr * 64 + m * 16 + fr];
#pragma unroll
            for (int m = 0; m < 4; ++m) { const int r = ai * HALF + wr * 64 + m * 16 + fr; const float s = sv[m]; f32x4 o[2];
#pragma unroll
                for (int n = 0; n < 2; ++n)
#pragma unroll
                    for (int j = 0; j < 4; ++j) { const float gg = acc[ai][0][m][n][j] * s, up = acc[ai][1][m][n][j] * s; o[n][j] = gg * fast_sigmoid(gg) * up; }
                *(u32x4*)(ACT + (size_t)(u.prow0 + r) * DEXP + col0) = pack8(o[0], o[1]); } }
    }
};
struct EpiMoe2 {
    static constexpr bool PERM = true, AFTER_DRAIN = false, RESK = false;
    bf16_t* Y;
    __device__ __forceinline__ void operator()(const f32x4 (&acc)[2][2][4][2], const Unit& u, int wr, int wc, int fr, int fq) const {
        const int col0 = u.pn * BM + wc * 32 + 8 * fq;
#pragma unroll
        for (int ai = 0; ai < 2; ++ai)
#pragma unroll
            for (int m = 0; m < 4; ++m) { const int r = ai * HALF + wr * 64 + m * 16 + fr; bf16_t* rowp = Y + (size_t)(u.prow0 + r) * DM + col0;
#pragma unroll
                for (int bj = 0; bj < 2; ++bj) *(u32x4*)(rowp + bj * HALF) = pack8(acc[ai][bj][m][0], acc[ai][bj][m][1]); }
    }
};
struct EpiKVQG {
    static constexpr bool PERM = true, AFTER_DRAIN = false, RESK = false;
    bf16_t* Kb; bf16_t* Vb; bf16_t* Qb; bf16_t* SG; float* FLOG; const float* fbias; const float* RS;
    __device__ __forceinline__ void operator()(const f32x4 (&acc)[2][2][4][2], const Unit& u, int wr, int wc, int fr, int fq) const {
        const int pn = u.pn;
        float rs[2][4];
#pragma unroll
        for (int ai = 0; ai < 2; ++ai)
#pragma unroll
            for (int m = 0; m < 4; ++m) rs[ai][m] = RS[u.pm * BM + ai * HALF + wr * 64 + m * 16 + fr];
        if (pn == 16) {
            if (wc == 0 && fq < 2) { const f32x4 fb0 = *(const f32x4*)(fbias + 8 * fq), fb1 = *(const f32x4*)(fbias + 8 * fq + 4);
#pragma unroll
                for (int ai = 0; ai < 2; ++ai)
#pragma unroll
                    for (int m = 0; m < 4; ++m) { const int row = u.pm * BM + ai * HALF + wr * 64 + m * 16 + fr; f32x4 o[2];
#pragma unroll
                        for (int n = 0; n < 2; ++n)
#pragma unroll
                            for (int j = 0; j < 4; ++j) { const float z = acc[ai][0][m][n][j] * rs[ai][m] + (n ? fb1[j] : fb0[j]); o[n][j] = fminf(z, 0.f) - 0.6931471805599453f * __builtin_amdgcn_logf(1.0f + __builtin_amdgcn_exp2f(-1.4426950408889634f * fabsf(z))); }
                        *(f32x4*)(FLOG + (size_t)row * 16 + 8 * fq) = o[0]; *(f32x4*)(FLOG + (size_t)row * 16 + 8 * fq + 4) = o[1]; } }
            return; }
        if (pn >= 25) {
            const int col0 = (pn - 25) * BM + wc * 32 + 8 * fq;
#pragma unroll
            for (int ai = 0; ai < 2; ++ai)
#pragma unroll
                for (int m = 0; m < 4; ++m) { bf16_t* rowp = SG + (size_t)(u.pm * BM + ai * HALF + wr * 64 + m * 16 + fr) * DM + col0;
#pragma unroll
                    for (int bj = 0; bj < 2; ++bj) { f32x4 v0 = acc[ai][bj][m][0], v1 = acc[ai][bj][m][1];
#pragma unroll
                        for (int j = 0; j < 4; ++j) { v0[j] = fast_sigmoid(v0[j] * rs[ai][m]); v1[j] = fast_sigmoid(v1[j] * rs[ai][m]); }
                        *(u32x4*)(rowp + bj * HALF) = pack8(v0, v1); } }
            return; }
        bf16_t* base; int ct; float sc = 1.f;
        if (pn < 8) { base = Kb; ct = pn; } else if (pn < 16) { base = Vb; ct = pn - 8; } else { base = Qb; ct = pn - 17; sc = 0.08838834764831845f; }
        const int bidx = (u.pm * BM) / SEQ, s0 = (u.pm * BM) % SEQ;
#pragma unroll
        for (int ai = 0; ai < 2; ++ai)
#pragma unroll
            for (int m = 0; m < 4; ++m) { const int s = s0 + ai * HALF + wr * 64 + m * 16 + fr;
#pragma unroll
                for (int bj = 0; bj < 2; ++bj) { const int h = ct * 2 + bj;
                    *(u32x4*)(base + ((size_t)(bidx * NHEAD + h) * SEQ + s) * HDIM + wc * 32 + 8 * fq) = pack8(acc[ai][bj][m][0] * (sc * rs[ai][m]), acc[ai][bj][m][1] * (sc * rs[ai][m])); } }
    }
};
struct EpiRouter {
    static constexpr bool PERM = false, AFTER_DRAIN = true, RESK = false;
    const float* PR; const float* bgroup; const float* brouter; int* TH;
    int* asg_e; int* asg_r; float* asg_w; float* rstd_tok;
    __device__ __forceinline__ void fused(const f32x4 (&acc)[2][2][4][2], const Unit& u, int wr, int wc, int fr, int fq, LAS unsigned char* lds, int wid, int lane) const {
        LAS float* Lg = (LAS float*)lds;
        LAS int* cntw = (LAS int*)(lds + 256 * 73 * 4);
        LAS int* offw = cntw + 512;
        const int tid = wid * 64 + lane;
        if (wc < 3) {
#pragma unroll
            for (int ai = 0; ai < 2; ++ai)
#pragma unroll
                for (int m = 0; m < 4; ++m) { const int row = ai * HALF + wr * 64 + m * 16 + fr;
#pragma unroll
                    for (int n = 0; n < 2; ++n) { const int col = wc * 32 + 16 * n + 4 * fq;
                        if (col < 72) {
#pragma unroll
                            for (int j = 0; j < 4; ++j) Lg[row * 73 + col + j] = acc[ai][0][m][n][j]; } } } }
        LDS_WAIT(); __builtin_amdgcn_s_barrier(); asm volatile("" ::: "memory");
        int e0 = 0, e1 = 0, l0 = 0, l1 = 0; float w0 = 0.f, w1 = 0.f, rstd = 0.f; const int t = u.pm * BM + tid;
        if (wid < 4) {
            LAS float* ssq = (LAS float*)(offw + 512);
            const f32x4* pp = (const f32x4*)(PR + (size_t)(u.pm * BM + tid) * 32); float s = 0.f;
#pragma unroll
            for (int i = 0; i < 8; ++i) { const f32x4 w = pp[i]; s += (w[0] + w[1]) + (w[2] + w[3]); }
            ssq[tid] = s;
        }
        LDS_WAIT(); __builtin_amdgcn_s_barrier(); asm volatile("" ::: "memory");
        if (wid < 4) {
            rstd = 1.0f / sqrtf(((LAS float*)(offw + 512))[tid] * (1.0f / DM) + RMS_EPS);
            float gm = -3.0e38f; int g = 0; float gl[8];
#pragma unroll
            for (int j = 0; j < 8; ++j) { gl[j] = Lg[tid * 73 + j] * rstd + bgroup[j]; if (gl[j] > gm) { gm = gl[j]; g = j; } }
            float gs = 0.f;
#pragma unroll
            for (int j = 0; j < 8; ++j) gs += expf(gl[j] - gm);
            const float gp = 1.0f / gs;
            float m1 = -3.0e38f, m2 = -3.0e38f; int i1 = 0, i2 = 0;
#pragma unroll
            for (int j = 0; j < 8; ++j) { const float v = Lg[tid * 73 + 8 + g * 8 + j] * rstd + brouter[g * 8 + j];
                if (v > m1) { m2 = m1; i2 = i1; m1 = v; i1 = j; } else if (v > m2) { m2 = v; i2 = j; } }
            const float ex = expf(m2 - m1); w0 = gp / (1.0f + ex); w1 = gp * ex / (1.0f + ex);
            e0 = g * 8 + i1; e1 = g * 8 + i2;
            const unsigned long long ltm = (1ull << lane) - 1ull; int c0 = 0, c1 = 0;
            for (int e = 0; e < 64; ++e) {
                const unsigned long long m0 = __ballot(e0 == e), mm1 = __ballot(e1 == e);
                if (e0 == e) l0 = __builtin_popcountll(m0 & ltm);
                if (e1 == e) l1 = __builtin_popcountll(mm1 & ltm);
                if (lane == e) { c0 = __builtin_popcountll(m0); c1 = __builtin_popcountll(mm1); } }
            cntw[(0 * 4 + wid) * 64 + lane] = c0; cntw[(1 * 4 + wid) * 64 + lane] = c1;
        }
        LDS_WAIT(); __builtin_amdgcn_s_barrier(); asm volatile("" ::: "memory");
        if (tid < 64) { int run = 0;
#pragma unroll
            for (int kw = 0; kw < 8; ++kw) { offw[kw * 64 + tid] = run; run += cntw[kw * 64 + tid]; }
            TH[u.pm * 64 + tid] = run; }
        LDS_WAIT(); __builtin_amdgcn_s_barrier(); asm volatile("" ::: "memory");
        if (wid < 4) {
            const int r0 = offw[(0 * 4 + wid) * 64 + e0] + l0, r1 = offw[(1 * 4 + wid) * 64 + e1] + l1;
            asg_e[2 * t] = e0; asg_e[2 * t + 1] = e1; asg_r[2 * t] = r0; asg_r[2 * t + 1] = r1; asg_w[2 * t] = w0; asg_w[2 * t + 1] = w1; rstd_tok[t] = rstd;
        }
    }
};
}

namespace att {
constexpr int NW = 8, QBLK = 32, KVBLK = 64, QB = NW * QBLK, D = 128;
constexpr int SHM_V = KVBLK * D * 2, SHM_K = KVBLK * D * 2;
constexpr int CK_OFF = 2 * SHM_V + 2 * SHM_K + NW * 64 * 4;
constexpr int LDS_ATT = CK_OFF + 512;
constexpr int TBL_OFF = LDS_ATT + 64, TBL_BYTES = 272 * 4, TBLM_OFF = TBL_OFF + 2 * TBL_BYTES, ORD_OFF = TBLM_OFF + 64, CAP_OFF = ORD_OFF + 2048 * 2;
constexpr int OT_RS = 288, OT_WAVE = 32 * OT_RS, OT_OFF = (CAP_OFF + 128 + 127) & ~127;
static_assert(OT_OFF + (NW - 1) * OT_WAVE <= 139264, "attention LDS: waves 0..6 below the kernel's MISC words (barrier state), wave 7 in K buffer 1");
static_assert(OT_WAVE <= SHM_K, "attention LDS");
constexpr float THR = 8.f;
constexpr int OROW = DM;
enum { ORDER_PAIRED = 2, ORDER_XCD = 4 };

#define KSWZ(row, colB) ((row) * 256 + ((colB) ^ (((row) & 7) << 4)))
#define SBAR() __builtin_amdgcn_sched_barrier(0)
__device__ __forceinline__ int v_st(int k, int c) { const int kk = (k & ~0xC) | ((k & 4) << 1) | ((k & 8) >> 1); return ((kk >> 3) * 4 + (c >> 5)) * 512 + ((kk & 7) * 32 + (c & 31)) * 2; }
__device__ __forceinline__ int v_rd_base(int lane) { return ((lane & 3) << 3) | (((lane >> 2) & 3) << 6) | (((lane >> 4) & 1) << 5) | (((lane >> 5) & 1) << 8); }
constexpr int v_rd_off(int d0, int ks, int half) { return d0 * 512 + ks * 4096 + half * 2048; }
__device__ __forceinline__ int crow(int r, int hi) { return (r & 3) + 8 * (r >> 2) + 4 * hi; }
__device__ __forceinline__ bf16x8 load8(const bf16_t* p) { return *reinterpret_cast<const bf16x8*>(p); }

__device__ __forceinline__ void mask_tile(f32x16& p0, f32x16& p1, int dq, unsigned W) {
    const float NEG = -__builtin_inff();
#pragma unroll
    for (int r = 0; r < 16; ++r) {
        const int c = (r & 3) + 8 * (r >> 2);
        if ((unsigned)(dq - c) >= W) p0[r] = NEG;
        if ((unsigned)(dq - c - 32) >= W) p1[r] = NEG;
    }
}
__device__ __forceinline__ void partialSM(f32x16& p0, f32x16& p1, float& m_reg, float& mn, float& alpha, float thr = THR) {
    float pmax = p0[0];
#pragma unroll
    for (int r = 1; r < 16; ++r) pmax = fmaxf(pmax, p0[r]);
#pragma unroll
    for (int r = 0; r < 16; ++r) pmax = fmaxf(pmax, p1[r]);
    { auto rr = __builtin_amdgcn_permlane32_swap(__float_as_uint(pmax), __float_as_uint(pmax), false, false);
      pmax = fmaxf(__uint_as_float(rr[0]), __uint_as_float(rr[1])); }
    constexpr float C2 = 1.4426950408889634f;
    if (__builtin_expect(__all((pmax - m_reg) <= thr), 1)) { mn = m_reg; alpha = 1.f; }
    else { mn = fmaxf(m_reg, pmax); alpha = __builtin_amdgcn_exp2f((m_reg - mn) * C2); m_reg = mn; }
    const float mnL = -mn * C2;
#pragma unroll
    for (int r = 0; r < 16; ++r) p0[r] = fmaf(p0[r], C2, mnL);
#pragma unroll
    for (int r = 0; r < 16; ++r) p1[r] = fmaf(p1[r], C2, mnL);
#pragma unroll
    for (int r = 0; r < 16; ++r) p0[r] = __builtin_amdgcn_exp2f(p0[r]);
}
__device__ __forceinline__ void finishSM(f32x16& p0, f32x16& p1, float alpha, float& l_reg, bf16x8& pa0, bf16x8& pa1, bf16x8& pa2, bf16x8& pa3) {
#pragma unroll
    for (int r = 0; r < 16; ++r) p1[r] = __builtin_amdgcn_exp2f(p1[r]);
    float ps = 0;
#pragma unroll
    for (int r = 0; r < 16; ++r) ps += p0[r];
#pragma unroll
    for (int r = 0; r < 16; ++r) ps += p1[r];
    { auto rr = __builtin_amdgcn_permlane32_swap(__float_as_uint(ps), __float_as_uint(ps), false, false);
      ps = __uint_as_float(rr[0]) + __uint_as_float(rr[1]); }
    l_reg = l_reg * alpha + ps;
#define PK4(P, B_, OUT) do { unsigned a0 = cvt_pk_bf16(P[B_+0], P[B_+1]), a1 = cvt_pk_bf16(P[B_+2], P[B_+3]);                          \
        unsigned b0 = cvt_pk_bf16(P[B_+4], P[B_+5]), b1 = cvt_pk_bf16(P[B_+6], P[B_+7]);                                             \
        auto r0 = __builtin_amdgcn_permlane32_swap(a0, b0, false, false); auto r1 = __builtin_amdgcn_permlane32_swap(a1, b1, false, false); \
        u32x4 w = {r0[0], r1[0], r0[1], r1[1]}; OUT = *reinterpret_cast<bf16x8*>(&w); } while (0)
    PK4(p0, 0, pa0); PK4(p0, 8, pa1); PK4(p1, 0, pa2); PK4(p1, 8, pa3);
#undef PK4
}
template <int KB>
__device__ __forceinline__ void qkt(f32x16& p0, f32x16& p1, const char* K_lds, const char* ck_lds, int r32, int hi, const bf16x8* qr) {
    const float* ckb = (const float*)(ck_lds + KB * 256) + 4 * hi;
#pragma unroll
    for (int g = 0; g < 4; ++g) { const f32x4 c0 = *(const f32x4*)(ckb + 8 * g), c1 = *(const f32x4*)(ckb + 32 + 8 * g);
#pragma unroll
        for (int j = 0; j < 4; ++j) { p0[4 * g + j] = c0[j]; p1[4 * g + j] = c1[j]; } }
    const char* kb[4];
#pragma unroll
    for (int dd = 0; dd < 4; ++dd) kb[dd] = K_lds + KB * SHM_K + KSWZ(r32, (dd * 16 + hi * 8) * 2);
#pragma unroll
    for (int d0 = 0; d0 < 8; ++d0) { const char* a = kb[d0 & 3] + (d0 >> 2) * 128;
        bf16x8 b0 = *reinterpret_cast<const bf16x8*>(a);
        bf16x8 b1 = *reinterpret_cast<const bf16x8*>(a + 32 * 256);
        p0 = __builtin_amdgcn_mfma_f32_32x32x16_bf16(b0, qr[d0], p0, 0, 0, 0);
        p1 = __builtin_amdgcn_mfma_f32_32x32x16_bf16(b1, qr[d0], p1, 0, 0, 0); }
}
template <int VB>
__device__ __forceinline__ void pv_tile(f32x16* o, int vb0, bf16x8 pa0, bf16x8 pa1, bf16x8 pa2, bf16x8 pa3) {
#define TRRD(dst, off) asm volatile("ds_read_b64_tr_b16 %0, %1 offset:%2" : "=&v"(dst) : "v"(vb0), "i"(off) : "memory")
#define PV_D0(d0) do { s16x4 l0, l1, l2, l3, h0, h1, h2, h3; constexpr int b_ = VB * SHM_V + v_rd_off(d0, 0, 0); \
        TRRD(l0, b_); TRRD(h0, b_ + 2048); TRRD(l1, b_ + 4096); TRRD(h1, b_ + 6144); TRRD(l2, b_ + 8192); TRRD(h2, b_ + 10240); TRRD(l3, b_ + 12288); TRRD(h3, b_ + 14336); \
        asm volatile("s_waitcnt lgkmcnt(0)" ::: "memory"); SBAR();   \
        o[d0] = __builtin_amdgcn_mfma_f32_32x32x16_bf16(pa0, (bf16x8){l0[0], l0[1], l0[2], l0[3], h0[0], h0[1], h0[2], h0[3]}, o[d0], 0, 0, 0);   \
        o[d0] = __builtin_amdgcn_mfma_f32_32x32x16_bf16(pa1, (bf16x8){l1[0], l1[1], l1[2], l1[3], h1[0], h1[1], h1[2], h1[3]}, o[d0], 0, 0, 0);   \
        o[d0] = __builtin_amdgcn_mfma_f32_32x32x16_bf16(pa2, (bf16x8){l2[0], l2[1], l2[2], l2[3], h2[0], h2[1], h2[2], h2[3]}, o[d0], 0, 0, 0);   \
        o[d0] = __builtin_amdgcn_mfma_f32_32x32x16_bf16(pa3, (bf16x8){l3[0], l3[1], l3[2], l3[3], h3[0], h3[1], h3[2], h3[3]}, o[d0], 0, 0, 0); } while (0)
    PV_D0(0); PV_D0(1); PV_D0(2); PV_D0(3);
#undef PV_D0
#undef TRRD
}

struct Tensors { const bf16_t* Q; const bf16_t* K; const bf16_t* V; const float* C; const bf16_t* G; bf16_t* O; const float* nrm; unsigned* queue; };
constexpr float SKIP_EPS = 0.99f * 5.9604645e-8f / 64.f;
struct Blk { int L; int jlo; int tb; };
constexpr int NBH = NB * NHEAD, NQB = SEQ / (NW * QBLK);
__device__ __forceinline__ int blk_bh(int L) { return L >> 6; }
__device__ __forceinline__ int blk_qb(int L) { return L & 63; }
struct Seam { bf16x8 qr[8]; bf16x8 st_v0, st_v1, st_k0, st_k1; float st_c; };
#define VMW() asm volatile("s_waitcnt vmcnt(0)" ::: "memory")
#define VMWN(n) asm volatile("s_waitcnt vmcnt(%0)" :: "i"(n) : "memory")
#define LD16(base, off) (*(const bf16x8*)((const char*)(base) + (off)))
#define SLOAD_H(Kp, Vp, Cp, k0, cbf) do { const bf16_t* kt_ = (Kp) + (size_t)(k0) * D; const bf16_t* vt_ = (Vp) + (size_t)(k0) * D;              \
                         S.st_v0 = LD16(vt_, so0); S.st_v1 = LD16(vt_, so1); S.st_k0 = LD16(kt_, so0); S.st_k1 = LD16(kt_, so1);            \
                         S.st_c = *(const float*)((const char*)((Cp) + (k0)) + co); } while (0)
#define SWRITE_HK(bf) do { *(bf16x8*)(K_lds + (bf) * SHM_K + kws) = S.st_k0; *(bf16x8*)(K_lds + (bf) * SHM_K + kws + 32 * 256) = S.st_k1; \
                         if (wid == 0) *(float*)(ck_lds + (bf) * 256 + co) = -S.st_c; } while (0)
#define SWRITE_HV(bf) do { *(bf16x8*)(V_lds + (bf) * SHM_V + vst0) = S.st_v0; *(bf16x8*)(V_lds + (bf) * SHM_V + vst1) = S.st_v1; } while (0)
#define SWRITE_H(bf) do { SWRITE_HV(bf); SWRITE_HK(bf); } while (0)
__device__ __forceinline__ void attn_prime(const Tensors& T, const Blk cb, char* lds, Seam& S) {
    const int tid = threadIdx.x, wid = __builtin_amdgcn_readfirstlane(tid >> 6), lane = tid & 63, r32 = lane & 31, hi = lane >> 5;
    const int sr = tid >> 4, sc = (tid & 15) * 8, kws = KSWZ(sr, sc * 2); char* K_lds = lds + 2 * SHM_V; char* ck_lds = lds + CK_OFF;
    const unsigned so0 = (unsigned)((sr * D + sc) * 2), so1 = so0 + 32 * D * 2, co = (unsigned)(lane * 4), qo = (unsigned)((r32 * D + hi * 8) * 2);
    const int bh = blk_bh(cb.L), P0 = blk_qb(cb.L) * QB;
    const bf16_t* Kh = T.K + (size_t)bh * SEQ * D; const bf16_t* Vh = T.V + (size_t)bh * SEQ * D; const float* Ch = T.C + (size_t)bh * SEQ;
    { const bf16_t* qb_ = T.Q + ((size_t)bh * SEQ + P0 + wid * QBLK) * D;
#pragma unroll
      for (int d0 = 0; d0 < 8; ++d0) S.qr[d0] = LD16(qb_, qo + d0 * 32);
    }
    SLOAD_H(Kh, Vh, Ch, ((P0 + QB - 1) / KVBLK) * KVBLK, 0); VMW(); SWRITE_HK(0);
    __syncthreads();
}
__device__ __forceinline__ void attn_block(const Tensors& T, const Blk cb, const Blk nb, char* lds, Seam& S) {
    const int tid = threadIdx.x, wid = __builtin_amdgcn_readfirstlane(tid >> 6), lane = tid & 63, r32 = lane & 31, hi = lane >> 5;
    constexpr int W = SEQ;
    const int cbh = blk_bh(cb.L), cP0 = blk_qb(cb.L) * QB;
    const int jhi = (cP0 + QB - 1) / KVBLK; int NT = jhi + 1 - cb.jlo;
    const int qlo = cP0 + wid * QBLK;
    char* V_lds = lds; char* K_lds = lds + 2 * SHM_V; char* ck_lds = lds + CK_OFF;
    float* ws = (float*)(lds + 2 * SHM_V + 2 * SHM_K) + wid * 64; float* li_l = ws, * al_l = ws + 32;
    float m_reg = -1e30f, l_reg = 0; f32x16 o[4] = {};
    const int sr = tid >> 4, sc = (tid & 15) * 8, vst0 = v_st(sr, sc), vst1 = v_st(32 + sr, sc), kws = KSWZ(sr, sc * 2);
    const unsigned so0 = (unsigned)((sr * D + sc) * 2), so1 = so0 + 32 * D * 2, co = (unsigned)(lane * 4), qo = (unsigned)((r32 * D + hi * 8) * 2);
    const int vb0 = (int)(uintptr_t)V_lds + v_rd_base(lane);
    const bf16_t* Kh = T.K + (size_t)cbh * SEQ * D; const bf16_t* Vh = T.V + (size_t)cbh * SEQ * D; const float* Ch = T.C + (size_t)cbh * SEQ;
#define RESC(a) do { if (__any((a) < 1.f)) { if (hi == 0) al_l[r32] = (a); asm volatile("s_waitcnt lgkmcnt(0)" ::: "memory");              \
                     for (int d_ = 0; d_ < 4; ++d_) for (int r = 0; r < 16; ++r) o[d_][r] *= al_l[crow(r, hi)]; } } while (0)
#define KBASE(t) ((jhi - (t)) * KVBLK)
#define MASKT(P0_, P1_, t) do { const int kb_ = KBASE(t); if (kb_ + KVBLK - 1 > qlo) { int l_ = threadIdx.x; asm volatile("" : "+v"(l_)); const int lq_ = (l_ & 31) - 4 * ((l_ >> 5) & 1); mask_tile(P0_, P1_, (qlo - kb_) + lq_, (unsigned)W); } } while (0)
    constexpr int NQL = 8;
#define SEAM_K0() do { VMWN(NQL); SWRITE_HK(0); SBAR(); } while (0)
    f32x16 pA0, pA1, pB0, pB1; float mnA, mnB, alA, alB; bf16x8 pa0, pa1, pa2, pa3;
    SWRITE_HV(0); SBAR();
    if (NT > 1) { SLOAD_H(Kh, Vh, Ch, KBASE(1), 1); }
    SBAR(); qkt<0>(pA0, pA1, K_lds, ck_lds, r32, hi, S.qr);
    MASKT(pA0, pA1, 0); partialSM(pA0, pA1, m_reg, mnA, alA, 0.f);
    if (NT > 1) { VMW(); SWRITE_H(1); }
    __syncthreads();
#define HALF_STEP(PX0, PX1, mnX, alX, PY0, PY1, alY, t, KB, VB, SB) do {                                                      \
        SBAR(); qkt<KB>(PX0, PX1, K_lds, ck_lds, r32, hi, S.qr);                                                          \
        finishSM(PY0, PY1, alY, l_reg, pa0, pa1, pa2, pa3); SBAR();                                                           \
        if ((t) + 1 < NT) { SLOAD_H(Kh, Vh, Ch, KBASE((t) + 1), SB); SBAR(); }                                                    \
        pv_tile<VB>(o, vb0, pa0, pa1, pa2, pa3); MASKT(PX0, PX1, (t)); partialSM(PX0, PX1, m_reg, mnX, alX, (t) <= 4 ? 0.f : THR);     \
        __syncthreads();                                                                                                      \
        if ((t) + 1 < NT) { VMW(); SWRITE_H(SB); }                                                                            \
        RESC(alX); __syncthreads(); } while (0)
    for (int t = 1; t + 1 < NT; t += 2) {
        HALF_STEP(pB0, pB1, mnB, alB, pA0, pA1, alA, t, 1, 0, 0);
        HALF_STEP(pA0, pA1, mnA, alA, pB0, pB1, alB, t + 1, 0, 1, 1);
        if (t == 3 && NT > 6) {
            const float* tab = (const float*)(lds + TBL_OFF + cb.tb * TBL_BYTES); float* tbm = (float*)(lds + TBLM_OFF);
            int mb = (int)__float_as_uint(m_reg);
#define DPP_MIN(ctrl, rmask) mb = (int)__float_as_uint(fminf(__uint_as_float((unsigned)mb), __uint_as_float((unsigned)__builtin_amdgcn_update_dpp(mb, mb, ctrl, rmask, 0xf, false))))
            DPP_MIN(0x111, 0xf); DPP_MIN(0x112, 0xf); DPP_MIN(0x114, 0xf); DPP_MIN(0x118, 0xf); DPP_MIN(0x142, 0xa); DPP_MIN(0x143, 0xc);
#undef DPP_MIN
            const float mwave = __uint_as_float((unsigned)__builtin_amdgcn_readlane(mb, 63));
            if (lane == 0) tbm[wid] = mwave;
            asm volatile("s_waitcnt lgkmcnt(0)" ::: "memory"); __syncthreads();
            const f32x4 t0 = *(const f32x4*)tbm, t1 = *(const f32x4*)(tbm + 4);
            const float mm = fminf(fminf(fminf(t0[0], t0[1]), fminf(t0[2], t0[3])), fminf(fminf(t1[0], t1[1]), fminf(t1[2], t1[3])));
            const float thr = SKIP_EPS * __builtin_amdgcn_exp2f((mm + tab[256] - 0.05f) * 1.4426950408889634f);
            int lane_ = lane; asm volatile("" : "+v"(lane_));
            int jl = jhi - 5;
#pragma unroll
            for (int g = 3; g >= 0; --g) { const int j = g * 64 + lane_; const bool skip = (j <= jhi - 6) && (tab[j] <= thr) && (thr < 1e30f);
                const unsigned long long keep = ~__ballot(skip);
                if (keep) jl = g * 64 + (int)__builtin_ctzll(keep); }
            const int NTr = jhi + 1 - jl;
            NT = NTr < NT ? NTr : NT;
            __syncthreads();
        }
    }
    const bool even = (NT & 1) == 0;
    if (even) { SBAR(); qkt<1>(pB0, pB1, K_lds, ck_lds, r32, hi, S.qr); SBAR(); }
    { const int nbh_ = blk_bh(nb.L), nP0 = blk_qb(nb.L) * QB; const float* nC = T.C + (size_t)nbh_ * SEQ;
      SLOAD_H(T.K + (size_t)nbh_ * SEQ * D, T.V + (size_t)nbh_ * SEQ * D, nC, ((nP0 + QB - 1) / KVBLK) * KVBLK, 0); SBAR();
      const bf16_t* qb_ = T.Q + ((size_t)nbh_ * SEQ + nP0 + wid * QBLK) * D;
#pragma unroll
      for (int d0 = 0; d0 < 8; ++d0) S.qr[d0] = LD16(qb_, qo + d0 * 32);
    }
    SBAR();
    finishSM(pA0, pA1, alA, l_reg, pa0, pa1, pa2, pa3); SBAR();
    pv_tile<0>(o, vb0, pa0, pa1, pa2, pa3);
    if (even) { MASKT(pB0, pB1, NT - 1); partialSM(pB0, pB1, m_reg, mnB, alB); __syncthreads(); RESC(alB);
        finishSM(pB0, pB1, alB, l_reg, pa0, pa1, pa2, pa3); SBAR(); pv_tile<1>(o, vb0, pa0, pa1, pa2, pa3); }
    SBAR(); SEAM_K0();
    if (hi == 0) li_l[r32] = l_reg; asm volatile("s_waitcnt lgkmcnt(0)" ::: "memory");
    float rli[16];
#pragma unroll
    for (int r = 0; r < 16; ++r) rli[r] = __builtin_amdgcn_rcpf(li_l[crow(r, hi)]);
    int el = threadIdx.x; asm volatile("" : "+v"(el));
    const int elane = el & 63, er32 = elane & 31, ehi = elane >> 5, odd = er32 & 1;
    char* ot = lds + (wid < NW - 1 ? OT_OFF + wid * OT_WAVE : 2 * SHM_V + SHM_K);
    const size_t go = ((size_t)(cbh / NHEAD) * SEQ + cP0 + wid * QBLK) * OROW + (size_t)(cbh % NHEAD) * D;
    char* Ob = (char*)(T.O + go); const char* Gb = (const char*)(T.G + go);
    const unsigned rdo = (unsigned)((elane >> 4) * OROW * 2 + (elane & 15) * 16);
    u32x4 gv[8];
#pragma unroll
    for (int it = 0; it < 8; ++it) gv[it] = *(const u32x4*)(Gb + (size_t)it * 4 * OROW * 2 + rdo);
    const unsigned wbase = (unsigned)((4 * ehi + 2 * odd) * OT_RS + (er32 & ~1) * 2);
#pragma unroll
    for (int d0 = 0; d0 < 4; ++d0)
#pragma unroll
        for (int q = 0; q < 8; ++q) { const int r = (q >> 1) * 4 + (q & 1);
            const float X = o[d0][r] * rli[r], Y = o[d0][r + 2] * rli[r + 2];
            const float snd = odd ? X : Y;
            const float rcv = __uint_as_float((unsigned)__builtin_amdgcn_update_dpp((int)__float_as_uint(snd), (int)__float_as_uint(snd), 0xB1, 0xf, 0xf, false));
            const unsigned pk = cvt_pk_bf16(odd ? rcv : X, odd ? Y : rcv);
            *(unsigned*)(ot + wbase + ((r & 3) + 8 * (r >> 2)) * OT_RS + d0 * 64) = pk; }
    asm volatile("s_waitcnt lgkmcnt(0)" ::: "memory");
    const unsigned rbase = (unsigned)((elane >> 4) * OT_RS + (elane & 15) * 16);
#pragma unroll
    for (int it = 0; it < 8; ++it) { const u32x4 ov = *(const u32x4*)(ot + rbase + it * 4 * OT_RS), g = gv[it]; u32x4 w;
        w.x = cvt_pk_bf16(bflo(ov.x) * bflo(g.x), bfhi(ov.x) * bfhi(g.x)); w.y = cvt_pk_bf16(bflo(ov.y) * bflo(g.y), bfhi(ov.y) * bfhi(g.y));
        w.z = cvt_pk_bf16(bflo(ov.z) * bflo(g.z), bfhi(ov.z) * bfhi(g.z)); w.w = cvt_pk_bf16(bflo(ov.w) * bflo(g.w), bfhi(ov.w) * bfhi(g.w));
        *(u32x4*)(Ob + (size_t)it * 4 * OROW * 2 + rdo) = w; }
    __syncthreads();
#undef RESC
#undef KBASE
#undef MASKT
#undef SEAM_K0
#undef HALF_STEP
}
#undef LD16
#undef VMW
#undef VMWN
#undef SLOAD_H
#undef SWRITE_HK
#undef SWRITE_HV
#undef SWRITE_H

__device__ __forceinline__ int find_jlo(const float* Ch, const float* kn2, int P0, float rho, float bnd, float* tab) {
    int lane = threadIdx.x & 63; asm volatile("" : "+v"(lane));
    const int nd = P0 / KVBLK; const float c0 = Ch[P0];
    const float thr0 = SKIP_EPS * __builtin_amdgcn_exp2f(-bnd * 1.4426950408889634f);
    float e[4];
#pragma unroll
    for (int g = 0; g < 4; ++g) { const int j = g * 64 + lane; e[g] = 0.f;
        if (j < nd) e[g] = __builtin_amdgcn_exp2f((fmaf(rho, __builtin_sqrtf(kn2[j]), c0) - Ch[j * KVBLK + KVBLK - 1]) * 1.4426950408889634f); }
    int jlo = 4 * 64; float carry = 0.f;
#pragma unroll
    for (int g = 0; g < 4; ++g) { float p = e[g];
#define DPP_ADD(ctrl, rmask) p += __uint_as_float((unsigned)__builtin_amdgcn_update_dpp(0, (int)__float_as_uint(p), ctrl, rmask, 0xf, true))
        DPP_ADD(0x111, 0xf); DPP_ADD(0x112, 0xf); DPP_ADD(0x114, 0xf); DPP_ADD(0x118, 0xf);
        DPP_ADD(0x142, 0xa); DPP_ADD(0x143, 0xc);
#undef DPP_ADD
        p += carry;
        if (tab && threadIdx.x < 64) tab[g * 64 + lane] = p;
        const bool skip = (g * 64 + lane < nd) && (p <= thr0);
        const unsigned long long keep = ~__ballot(skip);
        if (keep && jlo == 4 * 64) jlo = g * 64 + (int)__builtin_ctzll(keep);
        carry = __uint_as_float((unsigned)__builtin_amdgcn_readlane((int)__float_as_uint(p), 63)); }
    if (tab && threadIdx.x == 0) tab[256] = c0;
    return jlo;
}
__device__ __forceinline__ Blk mkblk(int L, const Tensors& T, char* lds, int tb) {
    const int bh = blk_bh(L), P0 = blk_qb(L) * QB;
    const float qn2 = T.nrm[bh * 64 + blk_qb(L)], dneg = T.nrm[NBH * 64 + bh * 64 + blk_qb(L)];
    const float rho = 1.001f * __builtin_sqrtf(qn2), bnd = 1.001f * dneg + 0.05f;
    Blk r; r.L = L; r.tb = tb; r.jlo = __builtin_amdgcn_readfirstlane(find_jlo(T.C + (size_t)bh * SEQ, T.nrm + 2 * NBH * 64 + bh * 256, P0, rho, bnd, (float*)(lds + TBL_OFF + tb * TBL_BYTES)));
    return r;
}
__device__ __forceinline__ void attn_order(char* lds, const Tensors& T) {
    unsigned short* ord = (unsigned short*)(lds + ORD_OFF); int* cap = (int*)(lds + CAP_OFF);
    int tid = threadIdx.x; asm volatile("" : "+v"(tid));
    const int wid = __builtin_amdgcn_readfirstlane(tid >> 6);
#pragma unroll
    for (int k = 0; k < 4; ++k) { const int bh = wid * 4 + k;
        const float qn2 = T.nrm[bh * 64 + 63], dneg = T.nrm[NBH * 64 + bh * 64 + 63];
        const int jl = find_jlo(T.C + (size_t)bh * SEQ, T.nrm + 2 * NBH * 64 + bh * 256, 63 * QB, 1.001f * __builtin_sqrtf(qn2), 1.001f * dneg + 0.05f, nullptr);
        int c = (63 * 4 - jl + 3) >> 2; c = c > 63 ? 63 : c;
        if ((tid & 63) == 0) cap[bh] = c; }
    asm volatile("s_waitcnt lgkmcnt(0)" ::: "memory"); __syncthreads();
    for (int i = tid; i < NBH * NQB; i += NW * 64) { const int bh = i >> 6, qb = i & 63, capb = cap[bh], lev = qb < capb ? qb : capb;
        int pos = lev == capb ? qb - capb : 0;
        for (int h = 0; h < NBH; ++h) { const int c = cap[h];
            if (lev + 1 <= c) pos += 63 - lev;
            if (h < bh) pos += lev < c ? 1 : (lev == c ? 64 - c : 0); }
        ord[pos] = (unsigned short)i; }
    asm volatile("s_waitcnt lgkmcnt(0)" ::: "memory"); __syncthreads();
}
__device__ __forceinline__ void attn_phase(char* lds, const Tensors& T) {
    constexpr int total = NBH * NQB;
    attn_order(lds, T);
    const unsigned short* ord = (const unsigned short*)(lds + ORD_OFF);
    volatile int* qslot = (volatile int*)(lds + LDS_ATT);
    if (threadIdx.x == 0) *qslot = (int)atomicAdd(T.queue, 1u);
    __syncthreads();
    const int L0 = __builtin_amdgcn_readfirstlane(*qslot);
    __syncthreads();
    if (L0 >= total) return;
    Blk cur = mkblk(__builtin_amdgcn_readfirstlane((int)ord[L0]), T, lds, 0);
    Seam S;
    attn_prime(T, cur, lds, S);
    for (;;) {
        if (threadIdx.x == 0) *qslot = (int)atomicAdd(T.queue, 1u);
        __syncthreads();
        const int Ln = __builtin_amdgcn_readfirstlane(*qslot);
        const bool last = Ln >= total;
        Blk nxt = cur; if (!last) nxt = mkblk(__builtin_amdgcn_readfirstlane((int)ord[Ln]), T, lds, cur.tb ^ 1);
        attn_block(T, cur, nxt, lds, S);
        if (last) break;
        cur = nxt;
    }
}
}

struct Args {
    const float* in[25]; float* out; unsigned char* ws; int ph_lo, ph_hi; int alt, pad;
};
enum { I_X = 0, I_ANORM, I_AWIN, I_ACONVW, I_ACONVB, I_AWREC, I_ABREC, I_AWINP, I_ABINP, I_ALAMBDA, I_AWOUT, I_KVNORM, I_KVW, I_KVBF, I_BNORM, I_BWQG, I_BWO,
       I_MNORM, I_MWGROUP, I_MBGROUP, I_MWROUTER, I_MBROUTER, I_MWIN, I_MWOUT, I_FNORM };
constexpr int NPHASES = 21;

__device__ __forceinline__ void cvt_item(const float* src, int ld, const float* gain, bf16_t* dst, int ldd, LAS float* scr, int lane) {
    const int q = lane & 15, kr = lane >> 4;
#pragma unroll
    for (int hb = 0; hb < 2; ++hb) {
        f32x4 v[8];
#pragma unroll
        for (int it = 0; it < 8; ++it) { const int kk = (hb * 8 + it) * 4 + kr; v[it] = *(const f32x4*)(src + (size_t)kk * ld + q * 4); }
#pragma unroll
        for (int it = 0; it < 8; ++it) { const int kk = (hb * 8 + it) * 4 + kr; const float gk = gain ? gain[kk] : 1.0f;
            *(LAS f32x4*)(scr + kk * 64 + ((4 * q) ^ (4 * (kk >> 3)))) = v[it] * gk; }
    }
    LDS_WAIT(); asm volatile("" ::: "memory");
    const int c = lane & 7;
#pragma unroll
    for (int j = 0; j < 8; ++j) { const int n = (lane >> 3) + 8 * j; const LAS float* s = scr + (8 * c) * 64 + (n ^ (4 * c));
        u32x4 o; o.x = cvt_pk_bf16(s[0 * 64], s[1 * 64]); o.y = cvt_pk_bf16(s[2 * 64], s[3 * 64]); o.z = cvt_pk_bf16(s[4 * 64], s[5 * 64]); o.w = cvt_pk_bf16(s[6 * 64], s[7 * 64]);
        *(u32x4*)(dst + (size_t)n * ldd + 8 * c) = o; }
    LDS_WAIT(); asm volatile("" ::: "memory");
}

constexpr int DEFER_ITEMS = 64 * 256, DEFER_ROUTER = 7168, DEFER_SCATTER = 1024;
static_assert(2 * (DEFER_ROUTER + DEFER_SCATTER) == DEFER_ITEMS, "deferred weight items");
__device__ __forceinline__ void cvt_wout_deferred(const float* mwout, bf16_t* WmoT, int first, int count, int w, int nw, LAS float* scr, int wave, int lane) {
    for (int d = first + w * NWAVES + wave; d < first + count; d += nw * NWAVES) {
        const int le = 64 + (d >> 8), rr = d & 255, kb = rr >> 5, nb = rr & 31;
        cvt_item(mwout + (size_t)le * 512 * DM + (size_t)kb * 64 * DM + nb * 64, DM, nullptr, WmoT + (size_t)le * DM * 512 + (size_t)nb * 64 * 512 + kb * 64, 512, scr, lane); }
}
struct MoeCtx {
    LAS unsigned char* lds; volatile LAS unsigned* MISC; unsigned char* ws; int G, bx, vcu, wave, lo, hi;
    const float* bgroup; const float* brouter; const float* fnorm; float* out; const float* mwout;
};
#ifndef PHASE_MASK
#define PHASE_MASK 0x1fffff
#endif
#define PH_ON(k) (((PHASE_MASK) >> (k)) & 1)
#define IN(k) (PH_ON(k) && lo <= (k) && (k) < hi)
#if !MK_PER_PHASE
#define GRID_BAR() xcd_barrier(bar)
#else
#define GRID_BAR() do { } while (0)
#endif
#define SEAM(k) do { if (IN(k) && IN((k) + 1)) GRID_BAR(); } while (0)
template <int layer>
__device__ __forceinline__ void moe_block(const MoeCtx& C, const XcdBarrier& bar) {
    LAS unsigned char* lds = C.lds; volatile LAS unsigned* MISC = C.MISC; const int G = C.G, bx = C.bx, vcu = C.vcu, wave = C.wave, lo = C.lo, hi = C.hi;
    int tid = threadIdx.x; asm volatile("" : "+v"(tid));
    const int lane = tid & 63;
    constexpr int pb = 7 + 9 * layer;
    unsigned char* ws = C.ws; unsigned* ctl = (unsigned*)(ws + WS_CTL);
    const bf16_t* XRB = (const bf16_t*)(ws + (layer ? WS_X3B : WS_X1B));
    unsigned* gcnt = ctl + CW_GCNT + 64 * layer;
    unsigned char* mb = ws + WS_ASG + (size_t)layer * MOE_LAYER_STRIDE;
    int* asg_e = (int*)mb; int* asg_r = asg_e + 2 * NTOK; float* asg_w = (float*)(asg_r + 2 * NTOK); float* rstd_tok = asg_w + 2 * NTOK; int* TH = (int*)(rstd_tok + NTOK); int* asg_g = TH + 128 * 64;
    int* tokl = (int*)(mb + (WS_TOKL - WS_ASG)); float* rsl = (float*)(mb + (WS_RSL - WS_ASG)); bf16_t* ACT = (bf16_t*)(mb + (WS_ACT - WS_ASG)); bf16_t* YB = (bf16_t*)(mb + (WS_YB - WS_ASG));
    float* X2 = (float*)(ws + WS_X2); bf16_t* XN2 = (bf16_t*)(ws + WS_XN2);
    const bf16_t* WrT = (const bf16_t*)(ws + WS_WR); const bf16_t* WmiT = (const bf16_t*)(ws + WS_WMI); const bf16_t* WmoT = (const bf16_t*)(ws + WS_WMO);
    if (IN(pb)) {
        pg8::Gemm g{XRB, WrT + (size_t)layer * 256 * DM, DM, DM, DM, nullptr, nullptr, nullptr}; pg8::DenseSched S; S.o.init(NTOK / 256, 1, G, bx);
        pg8::EpiRouter E{(const float*)(ws + (layer ? WS_PART3 : WS_PART)), C.bgroup + 8 * layer, C.brouter + 64 * layer, TH, asg_e, asg_r, asg_w, rstd_tok};
        pg8::gemm_phase<pg8::EpiRouter, pg8::DenseSched, false, false>(lds, g, S, E);
        if (G >= 256 && bx >= NTOK / 256) {
            int dl = threadIdx.x; asm volatile("" : "+v"(dl));
            cvt_wout_deferred(C.mwout, (bf16_t*)(ws + WS_WMO), layer * (DEFER_ROUTER + DEFER_SCATTER), DEFER_ROUTER, bx - NTOK / 256, G - NTOK / 256, (LAS float*)(lds + wave * 16384), wave, dl & 63); }
    }
    SEAM(pb);
    if (IN(pb + 1)) {
        LAS int* bs = (LAS int*)lds;
        for (int tile = vcu; tile < NTOK / 256; tile += G) {
            if (tid < 64) { int base = 0;
#pragma unroll 16
                for (int tt = 0; tt < tile; ++tt) base += TH[tt * 64 + tid];
                bs[tid] = base; if (tile == NTOK / 256 - 1) gcnt[tid] = (unsigned)(base + TH[tile * 64 + tid]); }
            LDS_WAIT(); __syncthreads();
            if (tid < 256) { const int t = tile * 256 + tid; const float rs = rstd_tok[t];
#pragma unroll
                for (int k = 0; k < 2; ++k) { const int e = asg_e[2 * t + k], r = bs[e] + asg_r[2 * t + k]; asg_g[2 * t + k] = r; __hip_atomic_store(tokl + (size_t)e * LCAP + r, t, __ATOMIC_RELAXED, __HIP_MEMORY_SCOPE_AGENT); __hip_atomic_store(rsl + (size_t)e * LCAP + r, rs, __ATOMIC_RELAXED, __HIP_MEMORY_SCOPE_AGENT); } }
            __syncthreads();
        }
        if (G >= 256 && vcu >= NTOK / 256) {
            int dl = threadIdx.x; asm volatile("" : "+v"(dl));
            cvt_wout_deferred(C.mwout, (bf16_t*)(ws + WS_WMO), layer * (DEFER_ROUTER + DEFER_SCATTER) + DEFER_ROUTER, DEFER_SCATTER, vcu - NTOK / 256, G - NTOK / 256, (LAS float*)(lds + wave * 16384), wave, dl & 63); }
    }
    SEAM(pb + 1);
    if (IN(pb + 2) || IN(pb + 3) || IN(pb + 4)) {
        __syncthreads();
        if (tid < 64) { const int c = (int)__hip_atomic_load(gcnt + tid, __ATOMIC_RELAXED, __HIP_MEMORY_SCOPE_AGENT); const int ntile = (c + 255) >> 8; int incl = ntile;
#pragma unroll
            for (int o = 1; o < 64; o <<= 1) { const int nb = __shfl_up(incl, o); if (lane >= o) incl += nb; }
            MISC[MI_CNT + tid] = (unsigned)c; MISC[MI_TSTART + tid + 1] = (unsigned)incl; if (tid == 0) MISC[MI_TSTART] = 0u; }
        LDS_WAIT(); __syncthreads();
    }
    const LAS int* tstart = (const LAS int*)(lds + MISC_OFF) + MI_TSTART; const LAS int* ecnt = (const LAS int*)(lds + MISC_OFF) + MI_CNT;
    if (IN(pb + 2)) {
        pg8::Gemm g{XRB, WmiT + (size_t)layer * 64 * 1024 * DM, DM, DM, DM, tokl, nullptr, nullptr};
        pg8::MoeSched<true> S{tstart, ecnt, 4, G, bx, tstart[64] * 4, 1024};
        pg8::EpiMoe1 E{rsl, ACT};
        pg8::gemm_phase<pg8::EpiMoe1, pg8::MoeSched<true>, true, true>(lds, g, S, E);
    }
    SEAM(pb + 2);
    if (IN(pb + 3)) {
        pg8::Gemm g{ACT, WmoT + (size_t)layer * 64 * DM * 512, DEXP, DEXP, DEXP, nullptr, nullptr, nullptr};
        pg8::MoeSched<false> S{tstart, ecnt, 8, G, bx, tstart[64] * 8, 2048};
        pg8::EpiMoe2 E{YB};
        pg8::gemm_phase<pg8::EpiMoe2, pg8::MoeSched<false>, false, true>(lds, g, S, E);
    }
    SEAM(pb + 3);
    if (IN(pb + 4)) {
        const int gw = vcu * NWAVES + wave, NGW = G * NWAVES;
        const float* fn = C.fnorm;
        struct Asg { int e0, e1, r0, r1; float w0, w1; };
#define CB_LD_ASG(A_, t_) do { (A_).e0 = asg_e[2 * (t_)]; (A_).e1 = asg_e[2 * (t_) + 1]; (A_).r0 = asg_g[2 * (t_)]; (A_).r1 = asg_g[2 * (t_) + 1]; (A_).w0 = asg_w[2 * (t_)]; (A_).w1 = asg_w[2 * (t_) + 1]; } while (0)
#define CB_LD_ROW(X_, A0_, B0_, A_, t_) do { const size_t p0_ = (size_t)(tstart[(A_).e0] * 256 + (A_).r0), p1_ = (size_t)(tstart[(A_).e1] * 256 + (A_).r1);               \
            const u32x2* xr_ = (const u32x2*)(XRB + (size_t)(t_) * DM) + lane; const u32x2* y0_ = (const u32x2*)(YB + p0_ * DM) + lane; const u32x2* y1_ = (const u32x2*)(YB + p1_ * DM) + lane; \
            _Pragma("unroll") for (int j = 0; j < 8; ++j) { (X_)[j] = __builtin_nontemporal_load(xr_ + 64 * j); (A0_)[j] = __builtin_nontemporal_load(y0_ + 64 * j); (B0_)[j] = __builtin_nontemporal_load(y1_ + 64 * j); } } while (0)
        Asg ac, an; u32x2 xw[8], aw[8], bw[8];
        { const int t0 = gw; ac.e0 = ac.e1 = ac.r0 = ac.r1 = 0; ac.w0 = ac.w1 = 0.f; an = ac;
          if (t0 < NTOK) { CB_LD_ASG(ac, t0); CB_LD_ROW(xw, aw, bw, ac, t0); }
          if (t0 + NGW < NTOK) CB_LD_ASG(an, t0 + NGW); }
        for (int t = gw; t < NTOK; t += NGW) {
            const int tn = t + NGW;
            Asg a2 = an; if (tn + NGW < NTOK) CB_LD_ASG(a2, tn + NGW);
            u32x2 xn[8], yn0[8], yn1[8];
            if (tn < NTOK) CB_LD_ROW(xn, yn0, yn1, an, tn);
            else {
#pragma unroll
                for (int j = 0; j < 8; ++j) { xn[j] = xw[j]; yn0[j] = aw[j]; yn1[j] = bw[j]; } }
            float w0 = ac.w0, w1 = ac.w1;
#ifdef DBG_ZERO_MOE1
                if (layer == 1) { w0 = 0.f; w1 = 0.f; }
#endif
            f32x4 v[8]; float s = 0.f;
#pragma unroll
            for (int j = 0; j < 8; ++j) { const u32x2 xv = xw[j]; v[j] = (f32x4){bflo(xv.x), bfhi(xv.x), bflo(xv.y), bfhi(xv.y)}; const u32x2 a = aw[j], b = bw[j];
                v[j][0] += w0 * bflo(a.x) + w1 * bflo(b.x); v[j][1] += w0 * bfhi(a.x) + w1 * bfhi(b.x); v[j][2] += w0 * bflo(a.y) + w1 * bflo(b.y); v[j][3] += w0 * bfhi(a.y) + w1 * bfhi(b.y);
                s += (v[j][0] * v[j][0] + v[j][1] * v[j][1]) + (v[j][2] * v[j][2] + v[j][3] * v[j][3]); }
            const float rstd = 1.0f / sqrtf(wave_sum(s) * (1.0f / DM) + RMS_EPS);
            if (layer == 0) {
                u32x2* o8 = (u32x2*)(XN2 + (size_t)t * DM) + lane;
#pragma unroll
                for (int j = 0; j < 8; ++j) { u32x2 w; w.x = cvt_pk_bf16(v[j][0], v[j][1]); w.y = cvt_pk_bf16(v[j][2], v[j][3]); __builtin_nontemporal_store(w, o8 + 64 * j); }
                if (lane == 0) X2[t] = rstd;
            } else {
                f32x4* oo = (f32x4*)(C.out + (size_t)t * DM) + lane; const f32x4* fg = (const f32x4*)fn + lane;
#pragma unroll
                for (int j = 0; j < 8; ++j) __builtin_nontemporal_store(v[j] * rstd * fg[64 * j], oo + 64 * j);
            }
            ac = an; an = a2;
#pragma unroll
            for (int j = 0; j < 8; ++j) { xw[j] = xn[j]; aw[j] = yn0[j]; bw[j] = yn1[j]; }
        }
#undef CB_LD_ASG
#undef CB_LD_ROW
    }
    if (layer == 0) SEAM(pb + 4);
}

__global__ void __launch_bounds__(NTHREADS, 2) fwd_kernel(Args args) {
    extern __shared__ __attribute__((aligned(16))) unsigned char lds_raw[];
    LAS unsigned char* lds = (LAS unsigned char*)lds_raw;
    volatile LAS unsigned* MISC = (volatile LAS unsigned*)(lds + MISC_OFF);
    const int tid = threadIdx.x, lane = tid & 63, wave = __builtin_amdgcn_readfirstlane(tid >> 6);
    const int G = gridDim.x; const int bx = blockIdx.x; const int vcu = (G % 8 == 0) ? (bx % 8) * (G / 8) + bx / 8 : bx;
    unsigned char* ws = args.ws;
    unsigned* ctl = (unsigned*)(ws + WS_CTL);
    for (int u = tid; u < (LDS_BYTES - MISC_OFF) / 4; u += NTHREADS) MISC[u] = 0u;
    __syncthreads();
#if !MK_PER_PHASE
    XcdBarrier bar = xcd_barrier_post(ctl + CW_BAR, MISC + MI_BAR);
#else
    XcdBarrier bar; bar.bar = nullptr; bar.x = 0; bar.st = nullptr;
#endif
    const int lo = args.ph_lo, hi = args.ph_hi;

    bf16_t* WinT = (bf16_t*)(ws + WS_WIN); bf16_t* WgT = (bf16_t*)(ws + WS_WG); bf16_t* WoutT = (bf16_t*)(ws + WS_WOUT); bf16_t* WkvqgT = (bf16_t*)(ws + WS_WKVQG);
    bf16_t* WoT = (bf16_t*)(ws + WS_WO); bf16_t* WrT = (bf16_t*)(ws + WS_WR); bf16_t* WmiT = (bf16_t*)(ws + WS_WMI); bf16_t* WmoT = (bf16_t*)(ws + WS_WMO);
    float* Lvec = (float*)(ws + WS_LVEC);
    bf16_t* H0 = (bf16_t*)(ws + WS_H0); bf16_t* Ub = (bf16_t*)(ws + WS_U); bf16_t* GY = (bf16_t*)(ws + WS_GY); bf16_t* UC = (bf16_t*)(ws + WS_UC);
    bf16_t* LAb = (bf16_t*)(ws + WS_LA); bf16_t* BBb = (bf16_t*)(ws + WS_BB); bf16_t* HS = (bf16_t*)(ws + WS_HS);
    bf16_t* X1B = (bf16_t*)(ws + WS_X1B); float* PART = (float*)(ws + WS_PART);
    bf16_t* IDN = (bf16_t*)(ws + WS_X2 + 4 * MiB);
    float* cLA = (float*)(ws + WS_CARRY); float* cH = cLA + 256 * DM;
    int* asg_e = (int*)(ws + WS_ASG); int* asg_r = asg_e + 2 * NTOK; float* asg_w = (float*)(asg_r + 2 * NTOK); float* rstd_tok = asg_w + 2 * NTOK; int* TH = (int*)(rstd_tok + NTOK);
    int* tokl = (int*)(ws + WS_TOKL); float* rsl = (float*)(ws + WS_RSL);
    bf16_t* ACT = (bf16_t*)(ws + (args.alt ? (size_t)3400 * MiB : WS_ACT)); bf16_t* YB = (bf16_t*)(ws + WS_YB);
    float* X2 = (float*)(ws + WS_X2); bf16_t* XN2 = (bf16_t*)(ws + WS_XN2);
    bf16_t* Kb = (bf16_t*)(ws + WS_KB); bf16_t* Vb = (bf16_t*)(ws + WS_VB); bf16_t* Qb = (bf16_t*)(ws + WS_QB); bf16_t* SG = (bf16_t*)(ws + WS_SG);
    float* FLOG = (float*)(ws + WS_FLOG); float* CUM = (float*)(ws + WS_CUM); bf16_t* OG = (bf16_t*)(ws + WS_OG);
    float* RS0 = (float*)(ws + WS_X2 + 2 * MiB);
    float* NRMF = (float*)(ws + WS_X2 + 1 * MiB);
    bf16_t* X3B = (bf16_t*)(ws + WS_X3B); float* PART3 = (float*)(ws + WS_PART3);
    const float* x_in = args.in[I_X];

    if (IN(0)) {
        LAS float* scr = (LAS float*)(lds + wave * 16384);
        const int gw = vcu * NWAVES + wave, NGW = G * NWAVES;
        constexpr int I1 = 32 * 64, I2 = 256, I3 = 32 * 32, I4 = 32 * 64, I5 = 32 * 64, I6 = 32 * 32, I8 = 2 * 64 * 512, I9 = 2 * 64 * 256;
        const int NITEMS = I1 + I2 + I3 + I4 + I5 + I6 + I8 + (G >= 256 ? I9 - DEFER_ITEMS : I9);
        for (int it = gw; it < NITEMS; it += NGW) {
            int r = it; const float* src; const float* gain = nullptr; bf16_t* dst; int ld, ldd;
            if (r < I1) { const int kb = r >> 6, nb = r & 63;
                src = args.in[I_AWIN] + (size_t)kb * 64 * 4096 + nb * 64; ld = 4096; gain = args.in[I_ANORM] + kb * 64; dst = WinT + (size_t)nb * 64 * DM + kb * 64; ldd = DM; }
            else if ((r -= I1) < I2) { const int which = r & 1, kb = (r >> 1) & 3, nh = (r >> 3) & 1, q = (r >> 4) & 1, nblk = r >> 5;
                src = args.in[which ? I_AWINP : I_AWREC] + (size_t)nblk * 65536 + (size_t)kb * 64 * 256 + q * 128 + nh * 64; ld = 256;
                dst = WgT + (size_t)(nblk * 512 + q * 256 + which * 128 + nh * 64) * 256 + kb * 64; ldd = 256; }
            else if ((r -= I2) < I3) { const int kb = r >> 5, nb = r & 31;
                src = args.in[I_AWOUT] + (size_t)kb * 64 * DM + nb * 64; ld = DM; dst = WoutT + (size_t)nb * 64 * DM + kb * 64; ldd = DM; }
            else if ((r -= I3) < I4) { const int kb = r >> 6, nb = r & 63;
                src = args.in[I_KVW] + (size_t)kb * 64 * 4112 + nb * 64; ld = 4112; gain = args.in[I_KVNORM] + kb * 64; dst = WkvqgT + (size_t)nb * 64 * DM + kb * 64; ldd = DM; }
            else if ((r -= I4) < I5) { const int kb = r >> 6, nb = r & 63;
                src = args.in[I_BWQG] + (size_t)kb * 64 * 4096 + nb * 64; ld = 4096; gain = args.in[I_BNORM] + kb * 64; dst = WkvqgT + (size_t)(4352 + nb * 64) * DM + kb * 64; ldd = DM; }
            else if ((r -= I5) < I6) { const int kb = r >> 5, nb = r & 31;
                src = args.in[I_BWO] + (size_t)kb * 64 * DM + nb * 64; ld = DM; dst = WoT + (size_t)nb * 64 * DM + kb * 64; ldd = DM; }
            else if ((r -= I6) < I8) { const int le = r >> 9, rr = r & 511, kb = rr >> 4, nb = rr & 15;
                const int pn = nb >> 2, half = (nb >> 1) & 1, sub = nb & 1; const int scol = half * 512 + pn * 128 + sub * 64, layer = le >> 6;
                src = args.in[I_MWIN] + (size_t)le * 2048 * 1024 + (size_t)kb * 64 * 1024 + scol; ld = 1024; gain = args.in[I_MNORM] + layer * DM + kb * 64;
                dst = WmiT + (size_t)le * 1024 * DM + (size_t)nb * 64 * DM + kb * 64; ldd = DM; }
            else { r -= I8; const int le = r >> 8, rr = r & 255, kb = rr >> 5, nb = rr & 31;
                src = args.in[I_MWOUT] + (size_t)le * 512 * DM + (size_t)kb * 64 * DM + nb * 64; ld = DM; dst = WmoT + (size_t)le * DM * 512 + (size_t)nb * 64 * 512 + kb * 64; ldd = 512; }
            cvt_item(src, ld, gain, dst, ldd, scr, lane);
        }
        const int gt = vcu * NTHREADS + tid, NGT = G * NTHREADS;
        for (int i = gt; i < 256 * DM; i += NGT) {
            const int n = i / DM, k = i % DM; float v = 0.f; if (n < 16) v = args.in[I_KVW][(size_t)k * 4112 + 4096 + n] * args.in[I_KVNORM][k];
            WkvqgT[(size_t)(4096 + n) * DM + k] = (bf16_t)(cvt_pk_bf16(v, 0.f) & 0xffffu); }
        for (int i = gt; i < 2 * 256 * DM; i += NGT) {
            const int layer = i / (256 * DM), n = (i / DM) % 256, k = i % DM; float v = 0.f;
            if (n < 8) v = args.in[I_MWGROUP][(size_t)layer * DM * 8 + (size_t)k * 8 + n]; else if (n < 72) v = args.in[I_MWROUTER][(size_t)layer * DM * 64 + (size_t)k * 64 + (n - 8)];
            v *= args.in[I_MNORM][layer * DM + k];
            WrT[i] = (bf16_t)(cvt_pk_bf16(v, 0.f) & 0xffffu); }
        for (int i = gt; i < 256 * 256; i += NGT) IDN[(size_t)(i >> 8) * DM + (i & 255)] = (bf16_t)((i >> 8) == (i & 255) ? 0x3F80 : 0);
        for (int i = gt; i < DM; i += NGT) { const float lam = args.in[I_ALAMBDA][i]; const float sp = fmaxf(-lam, 0.f) + log1pf(expf(-fabsf(lam))); Lvec[i] = -8.0f * sp; }
        for (int m = gw; m < NTOK; m += NGW) {
            const f32x4* xr = (const f32x4*)(x_in + (size_t)m * DM) + lane; f32x4 v[8]; float s = 0.f;
#pragma unroll
            for (int j = 0; j < 8; ++j) { v[j] = xr[64 * j]; s += (v[j][0] * v[j][0] + v[j][1] * v[j][1]) + (v[j][2] * v[j][2] + v[j][3] * v[j][3]); }
            const float rstd = 1.0f / sqrtf(wave_sum(s) * (1.0f / DM) + RMS_EPS);
            u32x2* o8 = (u32x2*)(H0 + (size_t)m * DM) + lane;
#pragma unroll
            for (int j = 0; j < 8; ++j) { u32x2 w; w.x = cvt_pk_bf16(v[j][0], v[j][1]); w.y = cvt_pk_bf16(v[j][2], v[j][3]); o8[64 * j] = w; }
            if (lane == 0) RS0[m] = rstd;
        }
    }
    SEAM(0);

    if (IN(1)) {
        pg8::Gemm g{H0, WinT, DM, DM, DM, nullptr, nullptr, nullptr}; pg8::DenseSched S; S.o.init(NTOK / 256, 4096 / 256, G, bx);
        pg8::EpiInProj E{Ub, GY, RS0};
        pg8::gemm_phase<pg8::EpiInProj, pg8::DenseSched, false, true>(lds, g, S, E);
    }
    SEAM(1);

    if (IN(2)) {
        const int tc = tid & 255, c0 = tc * 8; const float* cw = args.in[I_ACONVW]; const float* cbp = args.in[I_ACONVB];
        float w[4][8], cb[8];
#pragma unroll
        for (int j = 0; j < 4; ++j) { const f32x4 a = *(const f32x4*)(cw + j * DM + c0), b = *(const f32x4*)(cw + j * DM + c0 + 4);
#pragma unroll
            for (int e = 0; e < 4; ++e) { w[j][e] = a[e]; w[j][4 + e] = b[e]; } }
        { const f32x4 a = *(const f32x4*)(cbp + c0), b = *(const f32x4*)(cbp + c0 + 4);
#pragma unroll
          for (int e = 0; e < 4; ++e) { cb[e] = a[e]; cb[4 + e] = b[e]; } }
        for (int grp = vcu * 2 + (tid >> 8); grp < NTOK / 64; grp += G * 2) {
            const int row0 = grp * 64; float p1[8], p2[8], p3[8];
#pragma unroll
            for (int e = 0; e < 8; ++e) { p1[e] = 0.f; p2[e] = 0.f; p3[e] = 0.f; }
            if ((row0 % SEQ) != 0) {
                const u32x4 a = *(const u32x4*)(Ub + (size_t)(row0 - 1) * DM + c0), b = *(const u32x4*)(Ub + (size_t)(row0 - 2) * DM + c0), c = *(const u32x4*)(Ub + (size_t)(row0 - 3) * DM + c0);
                p1[0] = bflo(a.x); p1[1] = bfhi(a.x); p1[2] = bflo(a.y); p1[3] = bfhi(a.y); p1[4] = bflo(a.z); p1[5] = bfhi(a.z); p1[6] = bflo(a.w); p1[7] = bfhi(a.w);
                p2[0] = bflo(b.x); p2[1] = bfhi(b.x); p2[2] = bflo(b.y); p2[3] = bfhi(b.y); p2[4] = bflo(b.z); p2[5] = bfhi(b.z); p2[6] = bflo(b.w); p2[7] = bfhi(b.w);
                p3[0] = bflo(c.x); p3[1] = bfhi(c.x); p3[2] = bflo(c.y); p3[3] = bfhi(c.y); p3[4] = bflo(c.z); p3[5] = bfhi(c.z); p3[6] = bflo(c.w); p3[7] = bfhi(c.w);
            }
#pragma unroll 4
            for (int i = 0; i < 64; ++i) {
                const u32x4 a = __builtin_nontemporal_load((const u32x4*)(Ub + (size_t)(row0 + i) * DM + c0));
                const float cu[8] = {bflo(a.x), bfhi(a.x), bflo(a.y), bfhi(a.y), bflo(a.z), bfhi(a.z), bflo(a.w), bfhi(a.w)};
                float o[8];
#pragma unroll
                for (int e = 0; e < 8; ++e) { o[e] = cb[e] + w[3][e] * cu[e] + w[2][e] * p1[e] + w[1][e] * p2[e] + w[0][e] * p3[e]; p3[e] = p2[e]; p2[e] = p1[e]; p1[e] = cu[e]; }
                u32x4 ow; ow.x = cvt_pk_bf16(o[0], o[1]); ow.y = cvt_pk_bf16(o[2], o[3]); ow.z = cvt_pk_bf16(o[4], o[5]); ow.w = cvt_pk_bf16(o[6], o[7]);
                __builtin_nontemporal_store(ow, (u32x4*)(UC + (size_t)(row0 + i) * DM + c0));
            }
        }
    }
    SEAM(2);

    if (IN(3)) {
        pg8::Gemm g{UC, WgT, DM, 256, 256, nullptr, nullptr, nullptr}; pg8::GateSched S; S.o.init(NTOK / 256, 16, G, bx);
        pg8::EpiGates E{UC, LAb, BBb, Lvec, args.in[I_ABREC], args.in[I_ABINP]};
        pg8::gemm_phase<pg8::EpiGates, pg8::GateSched, false, true>(lds, g, S, E);
    }
    SEAM(3);

    if (IN(4)) {
        for (int it = vcu; it < 256; it += G) {
            const size_t base = (size_t)it * 128 * DM + 4 * tid;
            float h[4] = {0.f, 0.f, 0.f, 0.f}, sl[4] = {0.f, 0.f, 0.f, 0.f};
#pragma unroll 8
            for (int i = 0; i < 128; ++i) { const u32x2 lw = *(const u32x2*)(LAb + base + (size_t)i * DM), bw = *(const u32x2*)(BBb + base + (size_t)i * DM);
                const float l[4] = {bflo(lw.x), bfhi(lw.x), bflo(lw.y), bfhi(lw.y)}, b[4] = {bflo(bw.x), bfhi(bw.x), bflo(bw.y), bfhi(bw.y)};
#pragma unroll
                for (int e = 0; e < 4; ++e) { h[e] = fast_exp(l[e]) * h[e] + b[e]; sl[e] += l[e]; } }
            *(f32x4*)(cLA + (size_t)it * DM + 4 * tid) = (f32x4){sl[0], sl[1], sl[2], sl[3]}; *(f32x4*)(cH + (size_t)it * DM + 4 * tid) = (f32x4){h[0], h[1], h[2], h[3]};
        }
    }
    SEAM(4);

    if (IN(5)) {
        for (int it = vcu; it < 256; it += G) {
            const int chunk = it & 127, it0 = it - chunk;
            float h[4] = {0.f, 0.f, 0.f, 0.f};
#pragma unroll 4
            for (int j = 0; j < chunk; ++j) { const f32x4 a = *(const f32x4*)(cLA + (size_t)(it0 + j) * DM + 4 * tid), hh = *(const f32x4*)(cH + (size_t)(it0 + j) * DM + 4 * tid);
#pragma unroll
                for (int e = 0; e < 4; ++e) h[e] = fast_exp(a[e]) * h[e] + hh[e]; }
            const size_t base = (size_t)it * 128 * DM + 4 * tid;
#pragma unroll 16
            for (int i = 0; i < 128; ++i) { const u32x2 lw = __builtin_nontemporal_load((const u32x2*)(LAb + base + (size_t)i * DM)), bw = __builtin_nontemporal_load((const u32x2*)(BBb + base + (size_t)i * DM)), gw2 = __builtin_nontemporal_load((const u32x2*)(GY + base + (size_t)i * DM));
                const float l[4] = {bflo(lw.x), bfhi(lw.x), bflo(lw.y), bfhi(lw.y)}, b[4] = {bflo(bw.x), bfhi(bw.x), bflo(bw.y), bfhi(bw.y)}, gy[4] = {bflo(gw2.x), bfhi(gw2.x), bflo(gw2.y), bfhi(gw2.y)};
                float o[4];
#pragma unroll
                for (int e = 0; e < 4; ++e) { h[e] = fast_exp(l[e]) * h[e] + b[e]; o[e] = h[e] * gy[e]; }
                u32x2 ow; ow.x = cvt_pk_bf16(o[0], o[1]); ow.y = cvt_pk_bf16(o[2], o[3]); __builtin_nontemporal_store(ow, (u32x2*)(HS + base + (size_t)i * DM)); }
        }
    }
    SEAM(5);

    if (IN(6)) {
        pg8::Gemm g{HS, WoutT, DM, DM, DM, nullptr, H0, IDN}; pg8::DenseSched S; S.o.init(NTOK / 256, DM / 256, G, bx);
        pg8::EpiStoreRes E{X1B, PART};
        pg8::gemm_phase<pg8::EpiStoreRes, pg8::DenseSched, false, true>(lds, g, S, E);
    }
    SEAM(6);

    { MoeCtx MC{lds, MISC, ws, G, bx, vcu, wave, lo, hi, args.in[I_MBGROUP], args.in[I_MBROUTER], args.in[I_FNORM], args.out, args.in[I_MWOUT]};
      moe_block<0>(MC, bar); }

    if (IN(12)) {
        pg8::Gemm g{XN2, WkvqgT, DM, DM, DM, nullptr, nullptr, nullptr}; pg8::DenseSched S; S.o.init(NTOK / 256, NKVQG / 256, G, bx);
        pg8::EpiKVQG E{Kb, Vb, Qb, SG, FLOG, args.in[I_KVBF], X2};
        pg8::gemm_phase<pg8::EpiKVQG, pg8::DenseSched, false, true>(lds, g, S, E);
    }
    SEAM(12);
    if (IN(13)) {
        LAS float* wt = (LAS float*)lds;
        for (int it = vcu; it < NB * NHEAD; it += G) {
            const int b = it / NHEAD, h = it % NHEAD; float v[32]; float tot = 0.f;
#pragma unroll
            for (int i = 0; i < 32; ++i) { v[i] = FLOG[((size_t)b * SEQ + 32 * tid + i) * 16 + h]; tot += v[i]; v[i] = tot; }
            float incl = tot;
#pragma unroll
            for (int o = 1; o < 64; o <<= 1) { const float nb = __shfl_up(incl, o); if (lane >= o) incl += nb; }
            if (lane == 63) wt[wave] = incl;
            LDS_WAIT(); __syncthreads();
            float off = incl - tot;
            for (int w = 0; w < wave; ++w) off += wt[w];
            float* dst = CUM + (size_t)it * SEQ + 32 * tid;
#pragma unroll
            for (int i = 0; i < 8; ++i) *(f32x4*)(dst + 4 * i) = (f32x4){v[4 * i] + off, v[4 * i + 1] + off, v[4 * i + 2] + off, v[4 * i + 3] + off};
            __syncthreads();
        }
        const int nW = G > 64 ? G - 32 : G, w0 = G > 64 ? vcu - 32 : vcu;
        if (w0 >= 0) {
            LAS float* red = (LAS float*)(lds + 1024);
            float* QN2 = NRMF; float* DNG = NRMF + NB * NHEAD * 64; float* KN2 = NRMF + 2 * NB * NHEAD * 64;
            for (int u = w0; u < NB * NHEAD * 32; u += nW) {
                const int bh = u >> 5, ch = u & 31;
                const size_t base = (((size_t)bh * SEQ + ch * 512 + wave * 64 + (lane >> 4)) * HDIM + (lane & 15) * 8) * 2;
                const char* qp = (const char*)Qb + base; const char* kp = (const char*)Kb + base;
                float mq = 0.f, mk = 0.f, md = 0.f;
#pragma unroll 4
                for (int st = 0; st < 16; ++st) {
                    const u32x4 q = *(const u32x4*)(qp + st * 1024), k = *(const u32x4*)(kp + st * 1024);
                    float qq = 0.f, kk = 0.f, qk = 0.f;
#pragma unroll
                    for (int c = 0; c < 4; ++c) { const float ql = __uint_as_float(q[c] << 16), qh = __uint_as_float(q[c] & 0xffff0000u), kl = __uint_as_float(k[c] << 16), kh = __uint_as_float(k[c] & 0xffff0000u);
                        qq = fmaf(ql, ql, fmaf(qh, qh, qq)); kk = fmaf(kl, kl, fmaf(kh, kh, kk)); qk = fmaf(ql, kl, fmaf(qh, kh, qk)); }
#pragma unroll
                    for (int o = 1; o < 16; o <<= 1) { qq += __shfl_xor(qq, o); kk += __shfl_xor(kk, o); qk += __shfl_xor(qk, o); }
                    mq = fmaxf(mq, qq); mk = fmaxf(mk, kk); md = fmaxf(md, -qk);
                }
#pragma unroll
                for (int o = 16; o < 64; o <<= 1) { mq = fmaxf(mq, __shfl_xor(mq, o)); mk = fmaxf(mk, __shfl_xor(mk, o)); md = fmaxf(md, __shfl_xor(md, o)); }
                if (lane == 0) { KN2[bh * 256 + ch * 8 + wave] = mk; red[wave * 2 + 0] = mq; red[wave * 2 + 1] = md; }
                LDS_WAIT(); __syncthreads();
                if (tid < 4) { const int bq = tid >> 1, wq = tid & 1;
                    const float m = fmaxf(fmaxf(red[(bq * 4 + 0) * 2 + wq], red[(bq * 4 + 1) * 2 + wq]), fmaxf(red[(bq * 4 + 2) * 2 + wq], red[(bq * 4 + 3) * 2 + wq]));
                    (wq ? DNG : QN2)[bh * 64 + ch * 2 + bq] = m; }
                __syncthreads();
            }
        }
    }
    SEAM(13);
    if (IN(14)) {
        att::Tensors T{Qb, Kb, Vb, CUM, SG, OG, NRMF, ctl + CW_AQ};
        att::attn_phase((char*)lds_raw, T);
    }
    SEAM(14);
    if (IN(15)) {
        pg8::Gemm g{OG, WoT, DM, DM, DM, nullptr, XN2, IDN}; pg8::DenseSched S; S.o.init(NTOK / 256, DM / 256, G, bx);
        pg8::EpiStoreRes E{X3B, PART3};
        pg8::gemm_phase<pg8::EpiStoreRes, pg8::DenseSched, false, true>(lds, g, S, E);
    }
    SEAM(15);

    { MoeCtx MC{lds, MISC, ws, G, bx, vcu, wave, lo, hi, args.in[I_MBGROUP], args.in[I_MBROUTER], args.in[I_FNORM], args.out, args.in[I_MWOUT]};
      moe_block<1>(MC, bar); }

#ifdef DBG_CHECK_ATTN
    GRID_BAR();
    if (bx == 0 && threadIdx.x == 0) args.out[0] = 0.f;
    GRID_BAR();
    if (bx < 64) {
        int ctid = threadIdx.x; asm volatile("" : "+v"(ctid));
        LAS float* red = (LAS float*)lds; LAS float* qv = red + 512; LAS float* sc = qv + 128;
        const int smp = bx; const int bh = (smp * 7) % 32;
        const int tlist[16] = {0, 1, 31, 32, 63, 64, 255, 256, 257, 511, 4095, 4096, 8191, 12345, 15000, 16383};
        const int t = tlist[smp % 16]; const int b = bh / 16, h = bh % 16;
        if (ctid < 128) qv[ctid] = bf2f(Qb[((size_t)bh * SEQ + t) * 128 + ctid]);
        LDS_WAIT(); __syncthreads();
        const float ct = CUM[(size_t)bh * SEQ + t];
        float mx = -1e30f;
        for (int s0 = ctid; s0 <= t; s0 += NTHREADS) { float d = 0.f; for (int k = 0; k < 128; ++k) d += qv[k] * bf2f(Kb[((size_t)bh * SEQ + s0) * 128 + k]); d += ct - CUM[(size_t)bh * SEQ + s0]; sc[s0] = d; mx = fmaxf(mx, d); }
        red[ctid] = mx; LDS_WAIT(); __syncthreads(); for (int o = 256; o > 0; o >>= 1) { if (ctid < o) red[ctid] = fmaxf(red[ctid], red[ctid + o]); LDS_WAIT(); __syncthreads(); }
        const float m = red[0]; __syncthreads();
        float ls = 0.f;
        for (int s0 = ctid; s0 <= t; s0 += NTHREADS) { const float p = expf(sc[s0] - m); sc[s0] = p; ls += p; }
        red[ctid] = ls; LDS_WAIT(); __syncthreads(); for (int o = 256; o > 0; o >>= 1) { if (ctid < o) red[ctid] += red[ctid + o]; LDS_WAIT(); __syncthreads(); }
        const float l = red[0]; __syncthreads();
        float err = 0.f;
        if (ctid < 128) { float o = 0.f; for (int s0 = 0; s0 <= t; ++s0) o += sc[s0] * bf2f(Vb[((size_t)bh * SEQ + s0) * 128 + ctid]);
            const size_t gi = ((size_t)b * SEQ + t) * DM + h * 128 + ctid; const float ref = o / l * bf2f(SG[gi]); err = fabsf(ref - bf2f(OG[gi])); }
        red[ctid] = err; LDS_WAIT(); __syncthreads(); for (int o = 256; o > 0; o >>= 1) { if (ctid < o) red[ctid] = fmaxf(red[ctid], red[ctid + o]); LDS_WAIT(); __syncthreads(); }
        if (ctid == 0) atomicMax((int*)args.out, __float_as_int(red[0] * 1000.f));
    }
#endif

#ifdef DBG_CHECK_RGLRU
    GRID_BAR();
    if (bx == 0 && threadIdx.x == 0) args.out[0] = 0.f;
    GRID_BAR();
    if (bx < 16) {
        int ctid = threadIdx.x; asm volatile("" : "+v"(ctid));
        LAS float* lav = (LAS float*)lds; LAS float* bbv = lav + 16384;
        const int clist[8] = {0, 5, 255, 256, 1000, 1029, 1800, 2047};
        const int b = bx >> 3, c = clist[bx & 7], nb = c >> 8, cc = c & 255;
        const float* wr_ = args.in[I_AWREC] + (size_t)nb * 65536 + cc; const float* wi_ = args.in[I_AWINP] + (size_t)nb * 65536 + cc;
        const float brc = args.in[I_ABREC][c], bic = args.in[I_ABINP][c], lam = args.in[I_ALAMBDA][c];
        const float sp = fmaxf(-lam, 0.f) + log1pf(expf(-fabsf(lam)));
        for (int s0 = ctid; s0 < SEQ; s0 += NTHREADS) { const bf16_t* ur = UC + ((size_t)b * SEQ + s0) * DM + nb * 256; float rl = brc, il = bic;
            for (int k = 0; k < 256; ++k) { const float uk = bf2f(ur[k]); rl += uk * wr_[(size_t)k * 256]; il += uk * wi_[(size_t)k * 256]; }
            const float r = 1.f / (1.f + expf(-rl)), ig = 1.f / (1.f + expf(-il)); const float la = -8.f * r * sp; const float a2 = expf(2.f * la);
            lav[s0] = la; bbv[s0] = sqrtf(fmaxf(1.f - a2, 0.f)) * ig * bf2f(ur[cc]); }
        LDS_WAIT(); __syncthreads();
        if (ctid == 0) { float h = 0.f, err = 0.f;
            for (int s0 = 0; s0 < SEQ; ++s0) { h = expf(lav[s0]) * h + bbv[s0];
                if ((s0 & 127) == 127 || (s0 & 127) == 0 || s0 < 8) { const size_t gi = ((size_t)b * SEQ + s0) * DM + c; err = fmaxf(err, fabsf(h * bf2f(GY[gi]) - bf2f(HS[gi]))); } }
            atomicMax((int*)args.out, __float_as_int(err * 1000.f)); }
    }
#endif
#undef IN
#undef SEAM
}


#ifdef DBG_CMP
__global__ void dbg_cmp_kernel(const unsigned* a, const unsigned* b, const unsigned* gcnt, float* out, size_t nout) {
    unsigned long long bad = 0; size_t rows = 0;
    for (int e = 0; e < 64; ++e) rows += ((gcnt[e] + 255u) >> 8) << 8;
    const size_t n = rows * 512 / 2;
    for (size_t i = (size_t)blockIdx.x * blockDim.x + threadIdx.x; i < n; i += (size_t)gridDim.x * blockDim.x) if (a[i] != b[i]) ++bad;
    for (size_t i = (size_t)blockIdx.x * blockDim.x + threadIdx.x; i < nout; i += (size_t)gridDim.x * blockDim.x) out[i] = 0.f;
    if (bad) atomicAdd(out, (float)bad);
}
#endif

#ifdef DBG_VALID
__global__ void dbg_valid_kernel(const unsigned* buf, int nwords, const unsigned* gcnt, unsigned* out, size_t nout) {
    __shared__ int ts[65]; __shared__ int cn[64];
    if (threadIdx.x == 0) { int t = 0; for (int e = 0; e < 64; ++e) { ts[e] = t; cn[e] = (int)gcnt[e]; t += ((int)gcnt[e] + 255) >> 8; } ts[64] = t; }
    __syncthreads();
    for (size_t i = (size_t)blockIdx.x * blockDim.x + threadIdx.x; i < nout; i += (size_t)gridDim.x * blockDim.x) {
        const size_t row = i / nwords; unsigned v = 0u;
        if (row < (size_t)ts[64] * 256) { const int tile = (int)(row >> 8); int e = 0; while (e < 63 && ts[e + 1] <= tile) ++e;
            const int r = (int)(row - (size_t)ts[e] * 256); if (r < cn[e]) v = buf[i]; }
        out[i] = v; }
}
#endif

extern "C" void kernel_launch(void* const* d_in, const int* in_sizes, int n_in, void* d_out, int out_size, void* d_ws, size_t ws_size, hipStream_t stream) {
    static int grid = 0;
    if (grid == 0) {
        if (n_in != 25 || in_sizes[0] != NTOK * DM || out_size != NTOK * DM || ws_size < WS_END) {
            fprintf(stderr, "kernel_launch: unexpected shapes (n_in %d, in0 %d, out %d, ws %zu < %zu); nothing launched\n", n_in, n_in > 0 ? in_sizes[0] : -1, out_size, ws_size, (size_t)WS_END); grid = -1; return; }
        int dev = 0, cus = 0, per_cu = 0;
        if (hipGetDevice(&dev) != hipSuccess || hipDeviceGetAttribute(&cus, hipDeviceAttributeMultiprocessorCount, dev) != hipSuccess) { fprintf(stderr, "kernel_launch: device query failed\n"); grid = -1; return; }
        if (hipFuncSetAttribute((const void*)fwd_kernel, hipFuncAttributeMaxDynamicSharedMemorySize, LDS_BYTES) != hipSuccess) { fprintf(stderr, "kernel_launch: hipFuncSetAttribute failed\n"); grid = -1; return; }
        if (hipOccupancyMaxActiveBlocksPerMultiprocessor(&per_cu, (const void*)fwd_kernel, NTHREADS, LDS_BYTES) != hipSuccess || per_cu < 1)
            fprintf(stderr, "kernel_launch: note: occupancy query reports %d workgroups per CU\n", per_cu);
        (void)hipGetLastError();
        grid = cus;
    }
    if (grid < 0) return;
    if (hipMemsetAsync((char*)d_ws + WS_CTL, 0, CTL_ZERO_BYTES, stream) != hipSuccess) { fprintf(stderr, "kernel_launch: memset failed\n"); return; }
    Args a{};
    for (int i = 0; i < 25; ++i) a.in[i] = (const float*)d_in[i];
    a.out = (float*)d_out; a.ws = (unsigned char*)d_ws;
#if MK_PER_PHASE
#ifndef DBG_LAST
#define DBG_LAST (NPHASES - 1)
#endif
    for (int p = 0; p <= DBG_LAST; ++p) { a.ph_lo = p; a.ph_hi = p + 1; hipLaunchKernelGGL(fwd_kernel, dim3(grid), dim3(NTHREADS), LDS_BYTES, stream, a); }
#ifdef DBG_OUT
    hipMemcpyAsync(d_out, (char*)d_ws + DBG_OUT, (size_t)NTOK * DM * 4, hipMemcpyDeviceToDevice, stream);
#endif
#ifdef DBG_VALID
    hipLaunchKernelGGL(dbg_valid_kernel, dim3(2048), dim3(256), 0, stream, (const unsigned*)((char*)d_ws + DBG_VALID), DBG_VALID_WORDS, (const unsigned*)d_ws + CW_GCNT + 64 * DBG_VALID_LAYER, (unsigned*)d_out, (size_t)NTOK * DM);
#endif
#ifdef DBG_CMP
    a.alt = 1; a.ph_lo = DBG_LAST; a.ph_hi = DBG_LAST + 1; hipLaunchKernelGGL(fwd_kernel, dim3(grid), dim3(NTHREADS), LDS_BYTES, stream, a); a.alt = 0;
    hipLaunchKernelGGL(dbg_cmp_kernel, dim3(1024), dim3(256), 0, stream, (const unsigned*)((char*)d_ws + WS_ACT), (const unsigned*)((char*)d_ws + (size_t)3400 * MiB), (const unsigned*)d_ws + CW_GCNT + 64, (float*)d_out, (size_t)NTOK * DM);
#endif
#else
    a.ph_lo = 0; a.ph_hi = NPHASES;
    hipLaunchKernelGGL(fwd_kernel, dim3(grid), dim3(NTHREADS), LDS_BYTES, stream, a);
#ifdef PROBE_EXTRA
    { const int plist[] = {PROBE_EXTRA}; for (int r = 0; r < PROBE_REPS; ++r) for (int p : plist) { if (p == 14) hipMemsetAsync((char*)d_ws + WS_CTL + CW_AQ * 4, 0, 4, stream); a.ph_lo = p; a.ph_hi = p + 1; hipLaunchKernelGGL(fwd_kernel, dim3(grid), dim3(NTHREADS), LDS_BYTES, stream, a); } }
#endif
#endif
    const hipError_t le = hipPeekAtLastError();
    if (le != hipSuccess) fprintf(stderr, "kernel_launch: launch failed: %s\n", hipGetErrorName(le));
}
```

```cpp
#include <hip/hip_runtime.h>
#include <cstdio>
#include <cstdint>


#ifndef MK_PER_PHASE
#define MK_PER_PHASE 0
#endif

#define LAS __attribute__((address_space(3)))
#define GAS __attribute__((address_space(1)))
typedef unsigned short bf16_t;
typedef short bf16x8 __attribute__((ext_vector_type(8)));
typedef short s16x4 __attribute__((ext_vector_type(4)));
typedef float f32x4 __attribute__((ext_vector_type(4)));
typedef float f32x2 __attribute__((ext_vector_type(2)));
typedef float f32x16 __attribute__((ext_vector_type(16)));
typedef unsigned u32x4 __attribute__((ext_vector_type(4)));
typedef unsigned u32x2 __attribute__((ext_vector_type(2)));

constexpr int NB = 2, SEQ = 16384, DM = 2048, NTOK = NB * SEQ;
constexpr int NHEAD = 16, HDIM = 128;
constexpr int NEXP = 64, DEXP = 512, LCAP = 65536;
constexpr int NKVQG = 8448;
constexpr float RMS_EPS = 1e-6f;
constexpr int NWAVES = 8, NTHREADS = 512;

constexpr size_t MiB = (size_t)1 << 20;
constexpr size_t WS_CTL = 0, CTL_ZERO_BYTES = 1 * MiB;
constexpr size_t WS_WIN = 1 * MiB, WS_WG = 17 * MiB, WS_WOUT = 19 * MiB, WS_WKVQG = 27 * MiB, WS_WO = 60 * MiB, WS_WR = 68 * MiB;
constexpr size_t WS_WMI = 70 * MiB, WS_WMO = 582 * MiB, WS_LVEC = 838 * MiB;
constexpr size_t WS_H0 = 839 * MiB, WS_U = 967 * MiB, WS_GY = 1095 * MiB, WS_UC = 1223 * MiB, WS_LA = 1351 * MiB, WS_BB = 1479 * MiB, WS_HS = 1607 * MiB;
constexpr size_t WS_X1B = 1735 * MiB, WS_PART = 1863 * MiB, WS_CARRY = 1867 * MiB;
constexpr size_t WS_ASG = 1871 * MiB, WS_TOKL = 1873 * MiB, WS_RSL = 1889 * MiB, WS_ACT = 1905 * MiB, WS_YB = 1985 * MiB;
constexpr size_t WS_X2 = 2305 * MiB, WS_XN2 = 2561 * MiB;
constexpr size_t WS_KB = 2689 * MiB, WS_VB = 2817 * MiB, WS_QB = 2945 * MiB, WS_SG = 3073 * MiB, WS_OG = 3201 * MiB;
constexpr size_t WS_FLOG = 3329 * MiB, WS_CUM = 3331 * MiB;
constexpr size_t WS_X3B = 3333 * MiB, WS_PART3 = 3461 * MiB;
constexpr size_t WS_MOE1 = 3465 * MiB, MOE_LAYER_STRIDE = WS_MOE1 - WS_ASG;
constexpr size_t WS_END = WS_MOE1 + 434 * MiB;
constexpr int CW_BAR = 4096;
constexpr int CW_GCNT = 8192;
constexpr int CW_NRM = 12288;
constexpr int CW_AQ = 13440;

constexpr int RING_BYTES = 131072;
constexpr int MISC_OFF = 139264;
constexpr int LDS_BYTES = 147456;
constexpr int MI_BAR = 0, MI_TSTART = 16, MI_CNT = 96;

__device__ __forceinline__ unsigned cvt_pk_bf16(float lo, float hi) { unsigned r; asm volatile("s_nop 0\n\tv_cvt_pk_bf16_f32 %0, %1, %2" : "=v"(r) : "v"(lo), "v"(hi)); return r; }
__device__ __forceinline__ float bflo(unsigned w) { return __uint_as_float(w << 16); }
__device__ __forceinline__ float bfhi(unsigned w) { return __uint_as_float(w & 0xffff0000u); }
__device__ __forceinline__ float bf2f(bf16_t h) { return __uint_as_float(((unsigned)h) << 16); }
__device__ __forceinline__ float fast_exp(float x) { return __builtin_amdgcn_exp2f(x * 1.4426950408889634f); }
__device__ __forceinline__ float fast_sigmoid(float x) { return __builtin_amdgcn_rcpf(1.0f + fast_exp(-x)); }
__device__ __forceinline__ float wave_sum(float v) {
#pragma unroll
    for (int o = 1; o < 64; o <<= 1) v += __shfl_xor(v, o);
    return v;
}
#define LDS_WAIT() asm volatile("s_waitcnt lgkmcnt(0)" ::: "memory")
#define VM_WAIT() asm volatile("s_waitcnt vmcnt(0)" ::: "memory")

#define XB_TMO      128
#define XB_XCNT(j)  (256  + 64 * (j))
#define XB_XSUB(j)  (1280 + 64 * (j))
#define XB_XGEN(j)  (2304 + 64 * (j))
#define XB_TOP      3328
#define XB_TOPGEN   3392
#define XCD_BAR_WORDS 3456
#define XB_SPIN_CAP (1u << 18)

__device__ __forceinline__ unsigned xb_ld(unsigned* p)              { return __hip_atomic_load(p, __ATOMIC_RELAXED, __HIP_MEMORY_SCOPE_AGENT); }
__device__ __forceinline__ unsigned xb_add(unsigned* p, unsigned v) { return __hip_atomic_fetch_add(p, v, __ATOMIC_RELAXED, __HIP_MEMORY_SCOPE_AGENT); }
__device__ __forceinline__ unsigned xb_xcc_id() { return (unsigned)__builtin_amdgcn_s_getreg((3 << 11) | 20) & 0xFu; }
#define XB_SPIN(cond, bar) do { unsigned _sp = 0; while (cond) { __builtin_amdgcn_s_sleep(1); \
    if ((++_sp & 255u) == 0u) { if (xb_ld(&(bar)[XB_TMO])) break; if (_sp > XB_SPIN_CAP) { atomicAdd(&(bar)[XB_TMO], 1u); break; } } } } while (0)

struct XcdBarrier { unsigned* bar; unsigned x; volatile LAS unsigned* st; };

__device__ __forceinline__ XcdBarrier xcd_barrier_post(unsigned* bar, volatile LAS unsigned* st) {
    XcdBarrier b; b.bar = bar; b.x = xb_xcc_id(); b.st = st;
    if (threadIdx.x == 0) (void)xb_add(&bar[XB_XCNT(b.x)], 1u);
    return b;
}
__device__ __forceinline__ void xcd_barrier_complete(unsigned* bar, unsigned x, unsigned& nloc, unsigned& nx) {
    const unsigned G = gridDim.x * gridDim.y * gridDim.z;
    unsigned sum, cnt, mine, sp = 0u;
    for (;;) {
        sum = 0u; cnt = 0u; mine = 0u;
#pragma unroll
        for (unsigned j = 0; j < 16; ++j) { const unsigned c = xb_ld(&bar[XB_XCNT(j)]); sum += c; cnt += (c > 0u) ? 1u : 0u; mine = (j == x) ? c : mine; }
        if (sum == G) break;
        __builtin_amdgcn_s_sleep(1);
        if ((++sp & 255u) == 0u) { if (xb_ld(&bar[XB_TMO])) break; if (sp > XB_SPIN_CAP) { atomicAdd(&bar[XB_TMO], 1u); break; } }
    }
    nloc = mine > 0u ? mine : 1u; nx = cnt > 0u ? cnt : 1u;
}
__device__ __forceinline__ void xcd_barrier(const XcdBarrier& b) {
    asm volatile("s_waitcnt vmcnt(0)" ::: "memory");
    __syncthreads();
    if (threadIdx.x == 0) {
        unsigned* bar = b.bar;
        __builtin_amdgcn_s_waitcnt(0);
        unsigned nloc = b.st[0], nx = b.st[1];
        if (nloc == 0u) { xcd_barrier_complete(bar, b.x, nloc, nx); b.st[0] = nloc; b.st[1] = nx; }
        const unsigned old = xb_add(&bar[XB_XSUB(b.x)], 1u);
        const unsigned gen = old / nloc;
        if (old + 1u == (gen + 1u) * nloc) {
            __builtin_amdgcn_fence(__ATOMIC_RELEASE, "agent");
            asm volatile("s_waitcnt vmcnt(0)" ::: "memory");
            const unsigned og = xb_add(&bar[XB_TOP], 1u);
            const unsigned tg = og / nx;
            if (og + 1u == (tg + 1u) * nx) xb_add(&bar[XB_TOPGEN], 1u);
            else XB_SPIN(xb_ld(&bar[XB_TOPGEN]) == tg, bar);
            __builtin_amdgcn_fence(__ATOMIC_ACQUIRE, "agent");
            xb_add(&bar[XB_XGEN(b.x)], 1u);
            asm volatile("s_waitcnt vmcnt(0)" ::: "memory");
        } else {
            XB_SPIN(xb_ld(&bar[XB_XGEN(b.x)]) == gen, bar);
            __builtin_amdgcn_fence(__ATOMIC_ACQUIRE, "agent");
            asm volatile("s_waitcnt vmcnt(0)" ::: "memory");
        }
    }
    __syncthreads();
}

namespace pg8 {
constexpr int BM = 256, BK = 64, HALF = 128, HTB = HALF * BK * 2, STAGE_BYTES = 8 * HTB, NXCD = 8, WGM = 4;
__host__ __device__ __forceinline__ int lds_byte(int r, int c) { const int st = (r >> 4) * 2 + (c >> 5), rr = r & 15, cc = c & 31, ob = rr * 64 + cc * 2; return st * 1024 + (ob ^ (((ob >> 9) & 1) << 5)); }
__host__ __device__ __forceinline__ void stage_rc(int b, int& R, int& C) { const int st = b / 1024, sb = b % 1024, swz = sb ^ (((sb >> 9) & 1) << 5); R = (st >> 1) * 16 + swz / 64; C = (st & 1) * 32 + (swz % 64) / 2; }
__host__ __device__ __forceinline__ int perm32(int rho) { const int n = rho >> 4, i = rho & 15; return 8 * (i >> 2) + 4 * n + (i & 3); }

struct Unit { int a0, acol, b0, pm, pn, e, nv, prow0; };
struct Gemm { const bf16_t* A; const bf16_t* Bt; int lda, ldb, K; const int* glist; const bf16_t* R; const bf16_t* I; };

__device__ __forceinline__ int xcd_remap(int L, int nwg) { const int q = nwg / NXCD, r = nwg % NXCD, xcd = L % NXCD, off = L / NXCD; return (xcd < r ? xcd * (q + 1) : r * (q + 1) + (xcd - r) * q) + off; }
struct GridOrder {
    int nM, nN, nwg, G, c;
    __device__ __forceinline__ void init(int nM_, int nN_, int G_, int c_) { nM = nM_; nN = nN_; nwg = nM * nN; G = G_; c = c_; }
    __device__ __forceinline__ bool tile(int i, int& pm, int& pn) const {
        const long L = (long)i * G + c; if (L >= nwg) return false;
        const int wgid = xcd_remap((int)L, nwg);
        const int nig = WGM * nN, gid = wgid / nig, fm = gid * WGM, gsz = (nM - fm) < WGM ? (nM - fm) : WGM;
        pm = fm + ((wgid % nig) % gsz); pn = (wgid % nig) / gsz; return true;
    }
};
struct DenseSched { GridOrder o;
    __device__ __forceinline__ bool next(int i, Unit& u) const { int pm, pn; if (!o.tile(i, pm, pn)) return false; u.pm = pm; u.pn = pn; u.a0 = pm * BM; u.acol = 0; u.b0 = pn * BM; u.e = 0; u.nv = BM; u.prow0 = pm * BM; return true; } };
struct GateSched { GridOrder o;
    __device__ __forceinline__ bool next(int i, Unit& u) const { int pm, pn; if (!o.tile(i, pm, pn)) return false; u.pm = pm; u.pn = pn; u.a0 = pm * BM; u.acol = (pn >> 1) * 256; u.b0 = pn * BM; u.e = 0; u.nv = BM; u.prow0 = pm * BM; return true; } };
template <bool GATHER> struct MoeSched {
    const LAS int* tstart; const LAS int* cnt; int NTN, G, c, nunits, brows;
    __device__ __forceinline__ bool next(int i, Unit& u) const {
        const long L = (long)i * G + c; if (L >= nunits) return false;
        const int wgid = xcd_remap((int)L, nunits);
        int lane = threadIdx.x & 63; asm volatile("" : "+v"(lane));
        const int uend = tstart[lane + 1] * NTN;
        const int e = __builtin_popcountll(__ballot(uend <= wgid));
        const int ts = tstart[e], nte = tstart[e + 1] - ts, idx = wgid - ts * NTN;
        const int mt = idx % nte, nt = idx / nte;
        const int ce = cnt[e];
        u.e = e; u.pm = mt; u.pn = nt; u.prow0 = (ts + mt) * BM; u.nv = (ce - mt * BM) < BM ? (ce - mt * BM) : BM;
        u.a0 = GATHER ? (e * LCAP + mt * BM) : u.prow0; u.acol = 0; u.b0 = e * brows + nt * BM;
        return true;
    }
};

template <class Epi, class Sched, bool GATHER, bool ALIGN_EPI>
__device__ __forceinline__ void gemm_phase(LAS unsigned char* lds, const Gemm g, const Sched& S, const Epi& E) {
    int tid = threadIdx.x; asm volatile("" : "+v"(tid));
    const int wid = __builtin_amdgcn_readfirstlane(tid >> 6), lane = tid & 63, wr = wid >> 2, wc = wid & 3, fr = lane & 15, fq = lane >> 4;
    const int K = g.K, nt = K / BK, ntot = nt + (Epi::RESK ? BM / BK : 0);
    int Rr[2], Cc[2];
    unsigned voffB[2];
#pragma unroll
    for (int i = 0; i < 2; ++i) { int R, C; stage_rc(tid * 16 + i * 8192, R, C); Rr[i] = R; Cc[i] = C; const int Rb = Epi::PERM ? ((R & ~31) + perm32(R & 31)) : R;
        voffB[i] = (unsigned)(Rb * g.ldb + C) * 2u; }
    const size_t kstep = (size_t)(BK * 2);
    const size_t hstepB = (size_t)HALF * g.ldb * 2;
    const unsigned ldsw = (unsigned)wid * 1024u;
    const int aoff = lds_byte(wr * 64 + fr, fq * 8), boff = lds_byte(wc * 32 + fr, fq * 8);
#define PG8_SA(b, h) (((b) * 2 + (h)) * HTB)
#define PG8_SB(b, h) ((4 + (b) * 2 + (h)) * HTB)
#define PG8_STAGE_B(bufoff, gbase) do { _Pragma("unroll") for (int _i = 0; _i < 2; ++_i) \
        __builtin_amdgcn_global_load_lds((const unsigned*)((const char*)(gbase) + voffB[_i]), (LAS unsigned*)(lds + (bufoff) + ldsw + _i * 8192), 16, 0, 0); } while (0)
#define PG8_STAGE_A(bufoff, gbase, vo, h) do { _Pragma("unroll") for (int _i = 0; _i < 2; ++_i) \
        __builtin_amdgcn_global_load_lds((const unsigned*)((const char*)(gbase) + (vo)[h][_i]), (LAS unsigned*)(lds + (bufoff) + ldsw + _i * 8192), 16, 0, 0); } while (0)
#define PG8_LDA(dst, b, h) do { _Pragma("unroll") for (int m = 0; m < 4; ++m) _Pragma("unroll") for (int k = 0; k < 2; ++k) dst[m][k] = *(const LAS bf16x8*)(lds + PG8_SA(b, h) + aoff + m * 2048 + k * 1024); } while (0)
#define PG8_LDB(dst, b, h) do { _Pragma("unroll") for (int n = 0; n < 2; ++n) _Pragma("unroll") for (int k = 0; k < 2; ++k) dst[n][k] = *(const LAS bf16x8*)(lds + PG8_SB(b, h) + boff + n * 2048 + k * 1024); } while (0)
#define PG8_MMA(ai, bj, At, Bt) do { __builtin_amdgcn_s_setprio(1); _Pragma("unroll") for (int m = 0; m < 4; ++m) _Pragma("unroll") for (int n = 0; n < 2; ++n) _Pragma("unroll") for (int k = 0; k < 2; ++k) \
        acc[ai][bj][m][n] = __builtin_amdgcn_mfma_f32_16x16x32_bf16(Bt[n][k], At[m][k], acc[ai][bj][m][n], 0, 0, 0); __builtin_amdgcn_s_setprio(0); } while (0)
#define PG8_WAIT_V(n) asm volatile("s_waitcnt vmcnt(" #n ")" ::: "memory")
#define PG8_WAIT_L(n) asm volatile("s_waitcnt lgkmcnt(" #n ")" ::: "memory")
#define PG8_BAR __builtin_amdgcn_s_barrier()
#define PG8_SCHED __builtin_amdgcn_sched_barrier(0)
#define PG8_AOFFS(vo, u) do { _Pragma("unroll") for (int _h = 0; _h < 2; ++_h) _Pragma("unroll") for (int _i = 0; _i < 2; ++_i) { const int _r = _h * HALF + Rr[_i]; \
        if (GATHER) { int _t = g.glist[(u).a0 + _r]; _t = (_r < (u).nv) ? _t : 0; (vo)[_h][_i] = (unsigned)(_t * g.lda + Cc[_i]) * 2u; } \
        else (vo)[_h][_i] = (unsigned)(_r * g.lda + Cc[_i]) * 2u; } } while (0)
#define PG8_ABASE(u) ((const char*)g.A + (GATHER ? (size_t)(u).acol * 2 : ((size_t)(u).a0 * g.lda + (u).acol) * 2))
    Unit cur, nxt; int ui = 0;
    if (!S.next(0, cur)) return;
    f32x4 acc[2][2][4][2];
#pragma unroll
    for (int a = 0; a < 2; ++a)
#pragma unroll
        for (int b = 0; b < 2; ++b)
#pragma unroll
            for (int m = 0; m < 4; ++m)
#pragma unroll
                for (int n = 0; n < 2; ++n) acc[a][b][m][n] = (f32x4){0.f, 0.f, 0.f, 0.f};
    bf16x8 At[4][2], B0[2][2], B1[2][2];
    unsigned vA[2][2], vN[2][2];
    PG8_AOFFS(vA, cur);
    const char* cA = PG8_ABASE(cur); const char* cB = (const char*)g.Bt + (size_t)cur.b0 * g.ldb * 2;
    PG8_STAGE_B(PG8_SB(0, 0), cB); PG8_STAGE_B(PG8_SB(0, 1), cB + hstepB); PG8_STAGE_A(PG8_SA(0, 0), cA, vA, 0); PG8_STAGE_A(PG8_SA(0, 1), cA, vA, 1);
    if (wr == 1) PG8_BAR;
    PG8_WAIT_V(2); PG8_BAR;
    PG8_STAGE_B(PG8_SB(1, 0), cB + kstep); PG8_STAGE_A(PG8_SA(1, 0), cA + kstep, vA, 0); PG8_STAGE_B(PG8_SB(1, 1), cB + hstepB + kstep);
    PG8_WAIT_V(6); PG8_BAR;
    for (;;) {
        const bool has_next = S.next(ui + 1, nxt);
        const char* nA = cA; const char* nB = cB;
        if (has_next) { nA = PG8_ABASE(nxt); nB = (const char*)g.Bt + (size_t)nxt.b0 * g.ldb * 2; }
        if (GATHER) { if (has_next) { PG8_AOFFS(vN, nxt); } else {
#pragma unroll
            for (int _h = 0; _h < 2; ++_h)
#pragma unroll
                for (int _i = 0; _i < 2; ++_i) vN[_h][_i] = vA[_h][_i]; } }
#pragma nounroll
        for (int t = 0; t < ntot; t += 2) {
            const bool last = (t == ntot - 2);
            const char* a1; const char* a2; const char* b2;
            if constexpr (Epi::RESK) {
                const char* rA = (const char*)g.R + ((size_t)cur.prow0 * g.lda + (size_t)cur.pn * BM) * 2;
                a1 = (t < nt ? cA + (size_t)t * kstep : rA + (size_t)(t - nt) * kstep) + kstep;
                a2 = last ? nA : (t + 2 < nt ? cA + (size_t)(t + 2) * kstep : rA + (size_t)(t + 2 - nt) * kstep);
                b2 = last ? nB : (t + 2 < nt ? cB + (size_t)(t + 2) * kstep : (const char*)g.I + (size_t)(t + 2 - nt) * kstep);
            } else {
                a1 = cA + (size_t)(t + 1) * kstep;
                a2 = last ? nA : cA + (size_t)(t + 2) * kstep; b2 = last ? nB : cB + (size_t)(t + 2) * kstep; }
            const char* a3 = a2 + kstep; const char* b3 = b2 + kstep;
            unsigned v2[2][2];
#pragma unroll
            for (int _h = 0; _h < 2; ++_h)
#pragma unroll
                for (int _i = 0; _i < 2; ++_i) v2[_h][_i] = (GATHER && last) ? vN[_h][_i] : vA[_h][_i];
            PG8_LDB(B0, 0, 0); PG8_LDB(B1, 0, 1); PG8_SCHED; PG8_LDA(At, 0, 0); PG8_STAGE_A(PG8_SA(1, 1), a1, vA, 1);
            PG8_WAIT_V(8); PG8_WAIT_L(0); PG8_BAR; PG8_MMA(0, 0, At, B0); PG8_MMA(0, 1, At, B1); PG8_BAR; PG8_SCHED;
            PG8_LDA(At, 0, 1); PG8_STAGE_B(PG8_SB(0, 0), b2); PG8_STAGE_B(PG8_SB(0, 1), b2 + hstepB); PG8_STAGE_A(PG8_SA(0, 0), a2, v2, 0);
            PG8_WAIT_V(8); PG8_WAIT_L(0); PG8_BAR; PG8_MMA(1, 0, At, B0); PG8_MMA(1, 1, At, B1); PG8_BAR; PG8_SCHED;
            PG8_LDB(B0, 1, 0); PG8_LDB(B1, 1, 1); PG8_SCHED; PG8_LDA(At, 1, 0); PG8_STAGE_A(PG8_SA(0, 1), a2, v2, 1);
            PG8_WAIT_V(8); PG8_WAIT_L(0); PG8_BAR; PG8_MMA(0, 0, At, B0); PG8_MMA(0, 1, At, B1); PG8_BAR; PG8_SCHED;
            PG8_LDA(At, 1, 1); PG8_STAGE_B(PG8_SB(1, 0), b3); PG8_STAGE_B(PG8_SB(1, 1), b3 + hstepB); PG8_STAGE_A(PG8_SA(1, 0), a3, v2, 0);
            PG8_WAIT_V(8); PG8_WAIT_L(0); PG8_BAR; PG8_MMA(1, 0, At, B0); PG8_MMA(1, 1, At, B1); PG8_BAR; PG8_SCHED;
        }
        if constexpr (ALIGN_EPI) { if (wr == 0) PG8_BAR; }
        if constexpr (!Epi::AFTER_DRAIN) { E(acc, cur, wr, wc, fr, fq); }
        if (!has_next) break;
#pragma unroll
        for (int a = 0; a < 2; ++a)
#pragma unroll
            for (int b = 0; b < 2; ++b)
#pragma unroll
                for (int m = 0; m < 4; ++m)
#pragma unroll
                    for (int n = 0; n < 2; ++n) acc[a][b][m][n] = (f32x4){0.f, 0.f, 0.f, 0.f};
        cur = nxt; cA = nA; cB = nB; ++ui;
        if (GATHER) {
#pragma unroll
            for (int _h = 0; _h < 2; ++_h)
#pragma unroll
                for (int _i = 0; _i < 2; ++_i) vA[_h][_i] = vN[_h][_i]; }
        if constexpr (ALIGN_EPI) { if (wr == 1) PG8_BAR; }
    }
    PG8_WAIT_V(0);
    if constexpr (!ALIGN_EPI) { if (wr == 0) PG8_BAR; }
    PG8_BAR;
    if constexpr (Epi::AFTER_DRAIN) { E.fused(acc, cur, wr, wc, fr, fq, lds, wid, lane); }
#undef PG8_SA
#undef PG8_SB
#undef PG8_STAGE_A
#undef PG8_STAGE_B
#undef PG8_LDA
#undef PG8_LDB
#undef PG8_MMA
#undef PG8_WAIT_V
#undef PG8_WAIT_L
#undef PG8_BAR
#undef PG8_SCHED
#undef PG8_AOFFS
#undef PG8_ABASE
}

__device__ __forceinline__ u32x4 pack8(const f32x4& a, const f32x4& b) { u32x4 w; w.x = cvt_pk_bf16(a[0], a[1]); w.y = cvt_pk_bf16(a[2], a[3]); w.z = cvt_pk_bf16(b[0], b[1]); w.w = cvt_pk_bf16(b[2], b[3]); return w; }
__device__ __forceinline__ float gelu_tanh(float y) {
    const float t = y * (1.0f + 0.044715f * y * y);
    return y * __builtin_amdgcn_rcpf(1.0f + __builtin_amdgcn_exp2f(t * (-2.0f * 0.7978845608028654f * 1.4426950408889634f)));
}

struct EpiInProj {
    static constexpr bool PERM = true, AFTER_DRAIN = false, RESK = false;
    bf16_t* U; bf16_t* GY; const float* RS;
    __device__ __forceinline__ void operator()(const f32x4 (&acc)[2][2][4][2], const Unit& u, int wr, int wc, int fr, int fq) const {
        const bool isy = u.pn >= 8; bf16_t* base = isy ? GY : U; const int colt = (isy ? u.pn - 8 : u.pn) * BM + wc * 32 + 8 * fq;
        float rs[2][4];
#pragma unroll
        for (int ai = 0; ai < 2; ++ai)
#pragma unroll
            for (int m = 0; m < 4; ++m) rs[ai][m] = RS[u.pm * BM + ai * HALF + wr * 64 + m * 16 + fr];
#pragma unroll
        for (int ai = 0; ai < 2; ++ai)
#pragma unroll
            for (int m = 0; m < 4; ++m) { bf16_t* rowp = base + (size_t)(u.pm * BM + ai * HALF + wr * 64 + m * 16 + fr) * DM + colt;
#pragma unroll
                for (int bj = 0; bj < 2; ++bj) { f32x4 v0 = acc[ai][bj][m][0] * rs[ai][m], v1 = acc[ai][bj][m][1] * rs[ai][m];
                    if (isy) {
#pragma unroll
                        for (int j = 0; j < 4; ++j) { v0[j] = gelu_tanh(v0[j]); v1[j] = gelu_tanh(v1[j]); } }
                    *(u32x4*)(rowp + bj * HALF) = pack8(v0, v1); } }
    }
};
struct EpiGates {
    static constexpr bool PERM = true, AFTER_DRAIN = false, RESK = false;
    const bf16_t* UC; bf16_t* LA; bf16_t* BB; const float* Lv; const float* brec; const float* binp;
    __device__ __forceinline__ void operator()(const f32x4 (&acc)[2][2][4][2], const Unit& u, int wr, int wc, int fr, int fq) const {
        const int cb = (u.pn >> 1) * 256 + (u.pn & 1) * 128 + wc * 32 + 8 * fq;
        u32x4 uw[2][4];
#pragma unroll
        for (int ai = 0; ai < 2; ++ai)
#pragma unroll
            for (int m = 0; m < 4; ++m) uw[ai][m] = *(const u32x4*)(UC + (size_t)(u.pm * BM + ai * HALF + wr * 64 + m * 16 + fr) * DM + cb);
#pragma unroll
        for (int ai = 0; ai < 2; ++ai)
#pragma unroll
            for (int m = 0; m < 4; ++m) { const size_t off = (size_t)(u.pm * BM + ai * HALF + wr * 64 + m * 16 + fr) * DM + cb;
                u32x4 lw, bw;
#pragma unroll
                for (int n = 0; n < 2; ++n) {
                    const f32x4 Lc = *(const f32x4*)(Lv + cb + 4 * n), rb = *(const f32x4*)(brec + cb + 4 * n), ib = *(const f32x4*)(binp + cb + 4 * n);
                    const unsigned ux = n ? uw[ai][m].z : uw[ai][m].x, uy = n ? uw[ai][m].w : uw[ai][m].y;
                    const float uu[4] = {bflo(ux), bfhi(ux), bflo(uy), bfhi(uy)};
                    float la[4], bb[4];
#pragma unroll
                    for (int j = 0; j < 4; ++j) {
                        const float r = fast_sigmoid(acc[ai][0][m][n][j] + rb[j]), ig = fast_sigmoid(acc[ai][1][m][n][j] + ib[j]);
                        const float l = r * Lc[j];
                        const float a2 = fast_exp(2.0f * l);
                        la[j] = l; bb[j] = __builtin_amdgcn_sqrtf(fmaxf(1.0f - a2, 0.0f)) * ig * uu[j]; }
                    if (n == 0) { lw.x = cvt_pk_bf16(la[0], la[1]); lw.y = cvt_pk_bf16(la[2], la[3]); bw.x = cvt_pk_bf16(bb[0], bb[1]); bw.y = cvt_pk_bf16(bb[2], bb[3]); }
                    else        { lw.z = cvt_pk_bf16(la[0], la[1]); lw.w = cvt_pk_bf16(la[2], la[3]); bw.z = cvt_pk_bf16(bb[0], bb[1]); bw.w = cvt_pk_bf16(bb[2], bb[3]); } }
                *(u32x4*)(LA + off) = lw; *(u32x4*)(BB + off) = bw; }
    }
};
struct EpiResid {
    static constexpr bool PERM = true, AFTER_DRAIN = false, RESK = false;
    const float* base; bf16_t* XB;
    __device__ __forceinline__ void operator()(const f32x4 (&acc)[2][2][4][2], const Unit& u, int wr, int wc, int fr, int fq) const {
        const int col0 = u.pn * BM + wc * 32 + 8 * fq;
#pragma unroll
        for (int ai = 0; ai < 2; ++ai)
#pragma unroll
            for (int m = 0; m < 4; ++m) { const int row = u.pm * BM + ai * HALF + wr * 64 + m * 16 + fr; const size_t off = (size_t)row * DM + col0;
#pragma unroll
                for (int bj = 0; bj < 2; ++bj) { const f32x4 b0 = *(const f32x4*)(base + off + bj * HALF), b1 = *(const f32x4*)(base + off + bj * HALF + 4);
                    *(u32x4*)(XB + off + bj * HALF) = pack8(acc[ai][bj][m][0] + b0, acc[ai][bj][m][1] + b1); } }
    }
};
struct EpiResidB {
    static constexpr bool PERM = true, AFTER_DRAIN = false, RESK = false;
    const bf16_t* base; bf16_t* XB;
    __device__ __forceinline__ void operator()(const f32x4 (&acc)[2][2][4][2], const Unit& u, int wr, int wc, int fr, int fq) const {
        const int col0 = u.pn * BM + wc * 32 + 8 * fq;
        u32x4 bw[2][4][2];
#pragma unroll
        for (int ai = 0; ai < 2; ++ai)
#pragma unroll
            for (int m = 0; m < 4; ++m)
#pragma unroll
                for (int bj = 0; bj < 2; ++bj) bw[ai][m][bj] = *(const u32x4*)(base + (size_t)(u.pm * BM + ai * HALF + wr * 64 + m * 16 + fr) * DM + col0 + bj * HALF);
#pragma unroll
        for (int ai = 0; ai < 2; ++ai)
#pragma unroll
            for (int m = 0; m < 4; ++m) { const int row = u.pm * BM + ai * HALF + wr * 64 + m * 16 + fr; const size_t off = (size_t)row * DM + col0;
#pragma unroll
                for (int bj = 0; bj < 2; ++bj) { const u32x4 b = bw[ai][m][bj];
                    const f32x4 b0 = {bflo(b.x), bfhi(b.x), bflo(b.y), bfhi(b.y)}, b1 = {bflo(b.z), bfhi(b.z), bflo(b.w), bfhi(b.w)};
                    *(u32x4*)(XB + off + bj * HALF) = pack8(acc[ai][bj][m][0] + b0, acc[ai][bj][m][1] + b1); } }
    }
};
struct EpiStoreRes {
    static constexpr bool PERM = true, AFTER_DRAIN = false, RESK = true;
    bf16_t* XB; float* part;
    __device__ __forceinline__ void operator()(const f32x4 (&acc)[2][2][4][2], const Unit& u, int wr, int wc, int fr, int fq) const {
        const int col0 = u.pn * BM + wc * 32 + 8 * fq;
#pragma unroll
        for (int ai = 0; ai < 2; ++ai)
#pragma unroll
            for (int m = 0; m < 4; ++m) { const int row = u.pm * BM + ai * HALF + wr * 64 + m * 16 + fr; bf16_t* rowp = XB + (size_t)row * DM + col0; float ss = 0.f;
#pragma unroll
                for (int bj = 0; bj < 2; ++bj) { const f32x4 v0 = acc[ai][bj][m][0], v1 = acc[ai][bj][m][1];
                    *(u32x4*)(rowp + bj * HALF) = pack8(v0, v1);
                    ss += ((v0[0] * v0[0] + v0[1] * v0[1]) + (v0[2] * v0[2] + v0[3] * v0[3])) + ((v1[0] * v1[0] + v1[1] * v1[1]) + (v1[2] * v1[2] + v1[3] * v1[3])); }
                ss += __shfl_xor(ss, 16); ss += __shfl_xor(ss, 32);
                if (fq == 0) part[(size_t)row * 32 + u.pn * 4 + wc] = ss; }
    }
};
struct EpiMoe1 {
    static constexpr bool PERM = true, AFTER_DRAIN = false, RESK = false;
    const float* RS; bf16_t* ACT;
    __device__ __forceinline__ void operator()(const f32x4 (&acc)[2][2][4][2], const Unit& u, int wr, int wc, int fr, int fq) const {
        const int col0 = u.pn * 128 + wc * 32 + 8 * fq;
#pragma unroll
        for (int ai = 0; ai < 2; ++ai) {
            float sv[4];
#pragma unroll
            for (int m = 0; m < 4; ++m) sv[m] = RS[u.a0 + ai * HALF + wr * 64 + m * 16 + fr];
#pragma unroll
            for (int m = 0; m < 4; ++m) { const int r = ai * HALF + wr * 64 + m * 16 + fr; const float s = sv[m]; f32x4 o[2];
#pragma unroll
                for (int n = 0; n < 2; ++n)
#pragma unroll
                    for (int j = 0; j < 4; ++j) { const float gg = acc[ai][0][m][n][j] * s, up = acc[ai][1][m][n][j] * s; o[n][j] = gg * fast_sigmoid(gg) * up; }
                *(u32x4*)(ACT + (size_t)(u.prow0 + r) * DEXP + col0) = pack8(o[0], o[1]); } }
    }
};
struct EpiMoe2 {
    static constexpr bool PERM = true, AFTER_DRAIN = false, RESK = false;
    bf16_t* Y;
    __device__ __forceinline__ void operator()(const f32x4 (&acc)[2][2][4][2], const Unit& u, int wr, int wc, int fr, int fq) const {
        const int col0 = u.pn * BM + wc * 32 + 8 * fq;
#pragma unroll
        for (int ai = 0; ai < 2; ++ai)
#pragma unroll
            for (int m = 0; m < 4; ++m) { const int r = ai * HALF + wr * 64 + m * 16 + fr; bf16_t* rowp = Y + (size_t)(u.prow0 + r) * DM + col0;
#pragma unroll
                for (int bj = 0; bj < 2; ++bj) *(u32x4*)(rowp + bj * HALF) = pack8(acc[ai][bj][m][0], acc[ai][bj][m][1]); }
    }
};
struct EpiKVQG {
    static constexpr bool PERM = true, AFTER_DRAIN = false, RESK = false;
    bf16_t* Kb; bf16_t* Vb; bf16_t* Qb; bf16_t* SG; float* FLOG; const float* fbias; const float* RS;
    __device__ __forceinline__ void operator()(const f32x4 (&acc)[2][2][4][2], const Unit& u, int wr, int wc, int fr, int fq) const {
        const int pn = u.pn;
        float rs[2][4];
#pragma unroll
        for (int ai = 0; ai < 2; ++ai)
#pragma unroll
            for (int m = 0; m < 4; ++m) rs[ai][m] = RS[u.pm * BM + ai * HALF + wr * 64 + m * 16 + fr];
        if (pn == 16) {
            if (wc == 0 && fq < 2) { const f32x4 fb0 = *(const f32x4*)(fbias + 8 * fq), fb1 = *(const f32x4*)(fbias + 8 * fq + 4);
#pragma unroll
                for (int ai = 0; ai < 2; ++ai)
#pragma unroll
                    for (int m = 0; m < 4; ++m) { const int row = u.pm * BM + ai * HALF + wr * 64 + m * 16 + fr; f32x4 o[2];
#pragma unroll
                        for (int n = 0; n < 2; ++n)
#pragma unroll
                            for (int j = 0; j < 4; ++j) { const float z = acc[ai][0][m][n][j] * rs[ai][m] + (n ? fb1[j] : fb0[j]); o[n][j] = fminf(z, 0.f) - 0.6931471805599453f * __builtin_amdgcn_logf(1.0f + __builtin_amdgcn_exp2f(-1.4426950408889634f * fabsf(z))); }
                        *(f32x4*)(FLOG + (size_t)row * 16 + 8 * fq) = o[0]; *(f32x4*)(FLOG + (size_t)row * 16 + 8 * fq + 4) = o[1]; } }
            return; }
        if (pn >= 25) {
            const int col0 = (pn - 25) * BM + wc * 32 + 8 * fq;
#pragma unroll
            for (int ai = 0; ai < 2; ++ai)
#pragma unroll
                for (int m = 0; m < 4; ++m) { bf16_t* rowp = SG + (size_t)(u.pm * BM + ai * HALF + wr * 64 + m * 16 + fr) * DM + col0;
#pragma unroll
                    for (int bj = 0; bj < 2; ++bj) { f32x4 v0 = acc[ai][bj][m][0], v1 = acc[ai][bj][m][1];
#pragma unroll
                        for (int j = 0; j < 4; ++j) { v0[j] = fast_sigmoid(v0[j] * rs[ai][m]); v1[j] = fast_sigmoid(v1[j] * rs[ai][m]); }
                        *(u32x4*)(rowp + bj * HALF) = pack8(v0, v1); } }
            return; }
        bf16_t* base; int ct; float sc = 1.f;
        if (pn < 8) { base = Kb; ct = pn; } else if (pn < 16) { base = Vb; ct = pn - 8; } else { base = Qb; ct = pn - 17; sc = 0.08838834764831845f; }
        const int bidx = (u.pm * BM) / SEQ, s0 = (u.pm * BM) % SEQ;
#pragma unroll
        for (int ai = 0; ai < 2; ++ai)
#pragma unroll
            for (int m = 0; m < 4; ++m) { const int s = s0 + ai * HALF + wr * 64 + m * 16 + fr;
#pragma unroll
                for (int bj = 0; bj < 2; ++bj) { const int h = ct * 2 + bj;
                    *(u32x4*)(base + ((size_t)(bidx * NHEAD + h) * SEQ + s) * HDIM + wc * 32 + 8 * fq) = pack8(acc[ai][bj][m][0] * (sc * rs[ai][m]), acc[ai][bj][m][1] * (sc * rs[ai][m])); } }
    }
};
struct EpiRouter {
    static constexpr bool PERM = false, AFTER_DRAIN = true, RESK = false;
    const float* PR; const float* bgroup; const float* brouter; int* TH;
    int* asg_e; int* asg_r; float* asg_w; float* rstd_tok;
    __device__ __forceinline__ void fused(const f32x4 (&acc)[2][2][4][2], const Unit& u, int wr, int wc, int fr, int fq, LAS unsigned char* lds, int wid, int lane) const {
        LAS float* Lg = (LAS float*)lds;
        LAS int* cntw = (LAS int*)(lds + 256 * 73 * 4);
        LAS int* offw = cntw + 512;
        const int tid = wid * 64 + lane;
        if (wc < 3) {
#pragma unroll
            for (int ai = 0; ai < 2; ++ai)
#pragma unroll
                for (int m = 0; m < 4; ++m) { const int row = ai * HALF + wr * 64 + m * 16 + fr;
#pragma unroll
                    for (int n = 0; n < 2; ++n) { const int col = wc * 32 + 16 * n + 4 * fq;
                        if (col < 72) {
#pragma unroll
                            for (int j = 0; j < 4; ++j) Lg[row * 73 + col + j] = acc[ai][0][m][n][j]; } } } }
        LDS_WAIT(); __builtin_amdgcn_s_barrier(); asm volatile("" ::: "memory");
        int e0 = 0, e1 = 0, l0 = 0, l1 = 0; float w0 = 0.f, w1 = 0.f, rstd = 0.f; const int t = u.pm * BM + tid;
        if (wid < 4) {
            LAS float* ssq = (LAS float*)(offw + 512);
            const f32x4* pp = (const f32x4*)(PR + (size_t)(u.pm * BM + tid) * 32); float s = 0.f;
#pragma unroll
            for (int i = 0; i < 8; ++i) { const f32x4 w = pp[i]; s += (w[0] + w[1]) + (w[2] + w[3]); }
            ssq[tid] = s;
        }
        LDS_WAIT(); __builtin_amdgcn_s_barrier(); asm volatile("" ::: "memory");
        if (wid < 4) {
            rstd = 1.0f / sqrtf(((LAS float*)(offw + 512))[tid] * (1.0f / DM) + RMS_EPS);
            float gm = -3.0e38f; int g = 0; float gl[8];
#pragma unroll
            for (int j = 0; j < 8; ++j) { gl[j] = Lg[tid * 73 + j] * rstd + bgroup[j]; if (gl[j] > gm) { gm = gl[j]; g = j; } }
            float gs = 0.f;
#pragma unroll
            for (int j = 0; j < 8; ++j) gs += expf(gl[j] - gm);
            const float gp = 1.0f / gs;
            float m1 = -3.0e38f, m2 = -3.0e38f; int i1 = 0, i2 = 0;
#pragma unroll
            for (int j = 0; j < 8; ++j) { const float v = Lg[tid * 73 + 8 + g * 8 + j] * rstd + brouter[g * 8 + j];
                if (v > m1) { m2 = m1; i2 = i1; m1 = v; i1 = j; } else if (v > m2) { m2 = v; i2 = j; } }
            const float ex = expf(m2 - m1); w0 = gp / (1.0f + ex); w1 = gp * ex / (1.0f + ex);
            e0 = g * 8 + i1; e1 = g * 8 + i2;
            const unsigned long long ltm = (1ull << lane) - 1ull; int c0 = 0, c1 = 0;
            for (int e = 0; e < 64; ++e) {
                const unsigned long long m0 = __ballot(e0 == e), mm1 = __ballot(e1 == e);
                if (e0 == e) l0 = __builtin_popcountll(m0 & ltm);
                if (e1 == e) l1 = __builtin_popcountll(mm1 & ltm);
                if (lane == e) { c0 = __builtin_popcountll(m0); c1 = __builtin_popcountll(mm1); } }
            cntw[(0 * 4 + wid) * 64 + lane] = c0; cntw[(1 * 4 + wid) * 64 + lane] = c1;
        }
        LDS_WAIT(); __builtin_amdgcn_s_barrier(); asm volatile("" ::: "memory");
        if (tid < 64) { int run = 0;
#pragma unroll
            for (int kw = 0; kw < 8; ++kw) { offw[kw * 64 + tid] = run; run += cntw[kw * 64 + tid]; }
            TH[u.pm * 64 + tid] = run; }
        LDS_WAIT(); __builtin_amdgcn_s_barrier(); asm volatile("" ::: "memory");
        if (wid < 4) {
            const int r0 = offw[(0 * 4 + wid) * 64 + e0] + l0, r1 = offw[(1 * 4 + wid) * 64 + e1] + l1;
            asg_e[2 * t] = e0; asg_e[2 * t + 1] = e1; asg_r[2 * t] = r0; asg_r[2 * t + 1] = r1; asg_w[2 * t] = w0; asg_w[2 * t + 1] = w1; rstd_tok[t] = rstd;
        }
    }
};
}

namespace att {
constexpr int NW = 8, QBLK = 32, KVBLK = 64, QB = NW * QBLK, D = 128;
constexpr int SHM_V = KVBLK * D * 2, SHM_K = KVBLK * D * 2;
constexpr int CK_OFF = 2 * SHM_V + 2 * SHM_K + NW * 64 * 4;
constexpr int LDS_ATT = CK_OFF + 512;
constexpr int TBL_OFF = LDS_ATT + 64, TBL_BYTES = 272 * 4, TBLM_OFF = TBL_OFF + 2 * TBL_BYTES, ORD_OFF = TBLM_OFF + 64, CAP_OFF = ORD_OFF + 2048 * 2;
constexpr int OT_RS = 288, OT_WAVE = 32 * OT_RS, OT_OFF = (CAP_OFF + 128 + 127) & ~127;
static_assert(OT_OFF + (NW - 1) * OT_WAVE <= 139264, "attention LDS: waves 0..6 below the kernel's MISC words (barrier state), wave 7 in K buffer 1");
static_assert(OT_WAVE <= SHM_K, "attention LDS");
constexpr float THR = 8.f;
constexpr int OROW = DM;
enum { ORDER_PAIRED = 2, ORDER_XCD = 4 };

#define KSWZ(row, colB) ((row) * 256 + ((colB) ^ (((row) & 7) << 4)))
#define SBAR() __builtin_amdgcn_sched_barrier(0)
__device__ __forceinline__ int v_st(int k, int c) { const int kk = (k & ~0xC) | ((k & 4) << 1) | ((k & 8) >> 1); return ((kk >> 3) * 4 + (c >> 5)) * 512 + ((kk & 7) * 32 + (c & 31)) * 2; }
__device__ __forceinline__ int v_rd_base(int lane) { return ((lane & 3) << 3) | (((lane >> 2) & 3) << 6) | (((lane >> 4) & 1) << 5) | (((lane >> 5) & 1) << 8); }
constexpr int v_rd_off(int d0, int ks, int half) { return d0 * 512 + ks * 4096 + half * 2048; }
__device__ __forceinline__ int crow(int r, int hi) { return (r & 3) + 8 * (r >> 2) + 4 * hi; }
__device__ __forceinline__ bf16x8 load8(const bf16_t* p) { return *reinterpret_cast<const bf16x8*>(p); }

__device__ __forceinline__ void mask_tile(f32x16& p0, f32x16& p1, int dq, unsigned W) {
    const float NEG = -__builtin_inff();
#pragma unroll
    for (int r = 0; r < 16; ++r) {
        const int c = (r & 3) + 8 * (r >> 2);
        if ((unsigned)(dq - c) >= W) p0[r] = NEG;
        if ((unsigned)(dq - c - 32) >= W) p1[r] = NEG;
    }
}
__device__ __forceinline__ void partialSM(f32x16& p0, f32x16& p1, float& m_reg, float& mn, float& alpha, float thr = THR) {
    float pmax = p0[0];
#pragma unroll
    for (int r = 1; r < 16; ++r) pmax = fmaxf(pmax, p0[r]);
#pragma unroll
    for (int r = 0; r < 16; ++r) pmax = fmaxf(pmax, p1[r]);
    { auto rr = __builtin_amdgcn_permlane32_swap(__float_as_uint(pmax), __float_as_uint(pmax), false, false);
      pmax = fmaxf(__uint_as_float(rr[0]), __uint_as_float(rr[1])); }
    constexpr float C2 = 1.4426950408889634f;
    if (__builtin_expect(__all((pmax - m_reg) <= thr), 1)) { mn = m_reg; alpha = 1.f; }
    else { mn = fmaxf(m_reg, pmax); alpha = __builtin_amdgcn_exp2f((m_reg - mn) * C2); m_reg = mn; }
    const float mnL = -mn * C2;
#pragma unroll
    for (int r = 0; r < 16; ++r) p0[r] = fmaf(p0[r], C2, mnL);
#pragma unroll
    for (int r = 0; r < 16; ++r) p1[r] = fmaf(p1[r], C2, mnL);
#pragma unroll
    for (int r = 0; r < 16; ++r) p0[r] = __builtin_amdgcn_exp2f(p0[r]);
}
__device__ __forceinline__ void finishSM(f32x16& p0, f32x16& p1, float alpha, float& l_reg, bf16x8& pa0, bf16x8& pa1, bf16x8& pa2, bf16x8& pa3) {
#pragma unroll
    for (int r = 0; r < 16; ++r) p1[r] = __builtin_amdgcn_exp2f(p1[r]);
    float ps = 0;
#pragma unroll
    for (int r = 0; r < 16; ++r) ps += p0[r];
#pragma unroll
    for (int r = 0; r < 16; ++r) ps += p1[r];
    { auto rr = __builtin_amdgcn_permlane32_swap(__float_as_uint(ps), __float_as_uint(ps), false, false);
      ps = __uint_as_float(rr[0]) + __uint_as_float(rr[1]); }
    l_reg = l_reg * alpha + ps;
#define PK4(P, B_, OUT) do { unsigned a0 = cvt_pk_bf16(P[B_+0], P[B_+1]), a1 = cvt_pk_bf16(P[B_+2], P[B_+3]);                          \
        unsigned b0 = cvt_pk_bf16(P[B_+4], P[B_+5]), b1 = cvt_pk_bf16(P[B_+6], P[B_+7]);                                             \
        auto r0 = __builtin_amdgcn_permlane32_swap(a0, b0, false, false); auto r1 = __builtin_amdgcn_permlane32_swap(a1, b1, false, false); \
        u32x4 w = {r0[0], r1[0], r0[1], r1[1]}; OUT = *reinterpret_cast<bf16x8*>(&w); } while (0)
    PK4(p0, 0, pa0); PK4(p0, 8, pa1); PK4(p1, 0, pa2); PK4(p1, 8, pa3);
#undef PK4
}
template <int KB>
__device__ __forceinline__ void qkt(f32x16& p0, f32x16& p1, const char* K_lds, const char* ck_lds, int r32, int hi, const bf16x8* qr) {
    const float* ckb = (const float*)(ck_lds + KB * 256) + 4 * hi;
#pragma unroll
    for (int g = 0; g < 4; ++g) { const f32x4 c0 = *(const f32x4*)(ckb + 8 * g), c1 = *(const f32x4*)(ckb + 32 + 8 * g);
#pragma unroll
        for (int j = 0; j < 4; ++j) { p0[4 * g + j] = c0[j]; p1[4 * g + j] = c1[j]; } }
    const char* kb[4];
#pragma unroll
    for (int dd = 0; dd < 4; ++dd) kb[dd] = K_lds + KB * SHM_K + KSWZ(r32, (dd * 16 + hi * 8) * 2);
#pragma unroll
    for (int d0 = 0; d0 < 8; ++d0) { const char* a = kb[d0 & 3] + (d0 >> 2) * 128;
        bf16x8 b0 = *reinterpret_cast<const bf16x8*>(a);
        bf16x8 b1 = *reinterpret_cast<const bf16x8*>(a + 32 * 256);
        p0 = __builtin_amdgcn_mfma_f32_32x32x16_bf16(b0, qr[d0], p0, 0, 0, 0);
        p1 = __builtin_amdgcn_mfma_f32_32x32x16_bf16(b1, qr[d0], p1, 0, 0, 0); }
}
template <int VB>
__device__ __forceinline__ void pv_tile(f32x16* o, int vb0, bf16x8 pa0, bf16x8 pa1, bf16x8 pa2, bf16x8 pa3) {
#define TRRD(dst, off) asm volatile("ds_read_b64_tr_b16 %0, %1 offset:%2" : "=&v"(dst) : "v"(vb0), "i"(off) : "memory")
#define PV_D0(d0) do { s16x4 l0, l1, l2, l3, h0, h1, h2, h3; constexpr int b_ = VB * SHM_V + v_rd_off(d0, 0, 0); \
        TRRD(l0, b_); TRRD(h0, b_ + 2048); TRRD(l1, b_ + 4096); TRRD(h1, b_ + 6144); TRRD(l2, b_ + 8192); TRRD(h2, b_ + 10240); TRRD(l3, b_ + 12288); TRRD(h3, b_ + 14336); \
        asm volatile("s_waitcnt lgkmcnt(0)" ::: "memory"); SBAR();   \
        o[d0] = __builtin_amdgcn_mfma_f32_32x32x16_bf16(pa0, (bf16x8){l0[0], l0[1], l0[2], l0[3], h0[0], h0[1], h0[2], h0[3]}, o[d0], 0, 0, 0);   \
        o[d0] = __builtin_amdgcn_mfma_f32_32x32x16_bf16(pa1, (bf16x8){l1[0], l1[1], l1[2], l1[3], h1[0], h1[1], h1[2], h1[3]}, o[d0], 0, 0, 0);   \
        o[d0] = __builtin_amdgcn_mfma_f32_32x32x16_bf16(pa2, (bf16x8){l2[0], l2[1], l2[2], l2[3], h2[0], h2[1], h2[2], h2[3]}, o[d0], 0, 0, 0);   \
        o[d0] = __builtin_amdgcn_mfma_f32_32x32x16_bf16(pa3, (bf16x8){l3[0], l3[1], l3[2], l3[3], h3[0], h3[1], h3[2], h3[3]}, o[d0], 0, 0, 0); } while (0)
    PV_D0(0); PV_D0(1); PV_D0(2); PV_D0(3);
#undef PV_D0
#undef TRRD
}

struct Tensors { const bf16_t* Q; const bf16_t* K; const bf16_t* V; const float* C; const bf16_t* G; bf16_t* O; const float* nrm; unsigned* queue; };
constexpr float SKIP_EPS = 0.99f * 5.9604645e-8f / 64.f;
struct Blk { int L; int jlo; int tb; };
constexpr int NBH = NB * NHEAD, NQB = SEQ / (NW * QBLK);
__device__ __forceinline__ int blk_bh(int L) { return L >> 6; }
__device__ __forceinline__ int blk_qb(int L) { return L & 63; }
struct Seam { bf16x8 qr[8]; bf16x8 st_v0, st_v1, st_k0, st_k1; float st_c; };
#define VMW() asm volatile("s_waitcnt vmcnt(0)" ::: "memory")
#define VMWN(n) asm volatile("s_waitcnt vmcnt(%0)" :: "i"(n) : "memory")
#define LD16(base, off) (*(const bf16x8*)((const char*)(base) + (off)))
#define SLOAD_H(Kp, Vp, Cp, k0, cbf) do { const bf16_t* kt_ = (Kp) + (size_t)(k0) * D; const bf16_t* vt_ = (Vp) + (size_t)(k0) * D;              \
                         S.st_v0 = LD16(vt_, so0); S.st_v1 = LD16(vt_, so1); S.st_k0 = LD16(kt_, so0); S.st_k1 = LD16(kt_, so1);            \
                         S.st_c = *(const float*)((const char*)((Cp) + (k0)) + co); } while (0)
#define SWRITE_HK(bf) do { *(bf16x8*)(K_lds + (bf) * SHM_K + kws) = S.st_k0; *(bf16x8*)(K_lds + (bf) * SHM_K + kws + 32 * 256) = S.st_k1; \
                         if (wid == 0) *(float*)(ck_lds + (bf) * 256 + co) = -S.st_c; } while (0)
#define SWRITE_HV(bf) do { *(bf16x8*)(V_lds + (bf) * SHM_V + vst0) = S.st_v0; *(bf16x8*)(V_lds + (bf) * SHM_V + vst1) = S.st_v1; } while (0)
#define SWRITE_H(bf) do { SWRITE_HV(bf); SWRITE_HK(bf); } while (0)
__device__ __forceinline__ void attn_prime(const Tensors& T, const Blk cb, char* lds, Seam& S) {
    const int tid = threadIdx.x, wid = __builtin_amdgcn_readfirstlane(tid >> 6), lane = tid & 63, r32 = lane & 31, hi = lane >> 5;
    const int sr = tid >> 4, sc = (tid & 15) * 8, kws = KSWZ(sr, sc * 2); char* K_lds = lds + 2 * SHM_V; char* ck_lds = lds + CK_OFF;
    const unsigned so0 = (unsigned)((sr * D + sc) * 2), so1 = so0 + 32 * D * 2, co = (unsigned)(lane * 4), qo = (unsigned)((r32 * D + hi * 8) * 2);
    const int bh = blk_bh(cb.L), P0 = blk_qb(cb.L) * QB;
    const bf16_t* Kh = T.K + (size_t)bh * SEQ * D; const bf16_t* Vh = T.V + (size_t)bh * SEQ * D; const float* Ch = T.C + (size_t)bh * SEQ;
    { const bf16_t* qb_ = T.Q + ((size_t)bh * SEQ + P0 + wid * QBLK) * D;
#pragma unroll
      for (int d0 = 0; d0 < 8; ++d0) S.qr[d0] = LD16(qb_, qo + d0 * 32);
    }
    SLOAD_H(Kh, Vh, Ch, ((P0 + QB - 1) / KVBLK) * KVBLK, 0); VMW(); SWRITE_HK(0);
    __syncthreads();
}
__device__ __forceinline__ void attn_block(const Tensors& T, const Blk cb, const Blk nb, char* lds, Seam& S) {
    const int tid = threadIdx.x, wid = __builtin_amdgcn_readfirstlane(tid >> 6), lane = tid & 63, r32 = lane & 31, hi = lane >> 5;
    constexpr int W = SEQ;
    const int cbh = blk_bh(cb.L), cP0 = blk_qb(cb.L) * QB;
    const int jhi = (cP0 + QB - 1) / KVBLK; int NT = jhi + 1 - cb.jlo;
    const int qlo = cP0 + wid * QBLK;
    char* V_lds = lds; char* K_lds = lds + 2 * SHM_V; char* ck_lds = lds + CK_OFF;
    float* ws = (float*)(lds + 2 * SHM_V + 2 * SHM_K) + wid * 64; float* li_l = ws, * al_l = ws + 32;
    float m_reg = -1e30f, l_reg = 0; f32x16 o[4] = {};
    const int sr = tid >> 4, sc = (tid & 15) * 8, vst0 = v_st(sr, sc), vst1 = v_st(32 + sr, sc), kws = KSWZ(sr, sc * 2);
    const unsigned so0 = (unsigned)((sr * D + sc) * 2), so1 = so0 + 32 * D * 2, co = (unsigned)(lane * 4), qo = (unsigned)((r32 * D + hi * 8) * 2);
    const int vb0 = (int)(uintptr_t)V_lds + v_rd_base(lane);
    const bf16_t* Kh = T.K + (size_t)cbh * SEQ * D; const bf16_t* Vh = T.V + (size_t)cbh * SEQ * D; const float* Ch = T.C + (size_t)cbh * SEQ;
#define RESC(a) do { if (__any((a) < 1.f)) { if (hi == 0) al_l[r32] = (a); asm volatile("s_waitcnt lgkmcnt(0)" ::: "memory");              \
                     for (int d_ = 0; d_ < 4; ++d_) for (int r = 0; r < 16; ++r) o[d_][r] *= al_l[crow(r, hi)]; } } while (0)
#define KBASE(t) ((jhi - (t)) * KVBLK)
#define MASKT(P0_, P1_, t) do { const int kb_ = KBASE(t); if (kb_ + KVBLK - 1 > qlo) { int l_ = threadIdx.x; asm volatile("" : "+v"(l_)); const int lq_ = (l_ & 31) - 4 * ((l_ >> 5) & 1); mask_tile(P0_, P1_, (qlo - kb_) + lq_, (unsigned)W); } } while (0)
    constexpr int NQL = 8;
#define SEAM_K0() do { VMWN(NQL); SWRITE_HK(0); SBAR(); } while (0)
    f32x16 pA0, pA1, pB0, pB1; float mnA, mnB, alA, alB; bf16x8 pa0, pa1, pa2, pa3;
    SWRITE_HV(0); SBAR();
    if (NT > 1) { SLOAD_H(Kh, Vh, Ch, KBASE(1), 1); }
    SBAR(); qkt<0>(pA0, pA1, K_lds, ck_lds, r32, hi, S.qr);
    MASKT(pA0, pA1, 0); partialSM(pA0, pA1, m_reg, mnA, alA, 0.f);
    if (NT > 1) { VMW(); SWRITE_H(1); }
    __syncthreads();
#define HALF_STEP(PX0, PX1, mnX, alX, PY0, PY1, alY, t, KB, VB, SB) do {                                                      \
        SBAR(); qkt<KB>(PX0, PX1, K_lds, ck_lds, r32, hi, S.qr);                                                          \
        finishSM(PY0, PY1, alY, l_reg, pa0, pa1, pa2, pa3); SBAR();                                                           \
        if ((t) + 1 < NT) { SLOAD_H(Kh, Vh, Ch, KBASE((t) + 1), SB); SBAR(); }                                                    \
        pv_tile<VB>(o, vb0, pa0, pa1, pa2, pa3); MASKT(PX0, PX1, (t)); partialSM(PX0, PX1, m_reg, mnX, alX, (t) <= 4 ? 0.f : THR);     \
        __syncthreads();                                                                                                      \
        if ((t) + 1 < NT) { VMW(); SWRITE_H(SB); }                                                                            \
        RESC(alX); __syncthreads(); } while (0)
    for (int t = 1; t + 1 < NT; t += 2) {
        HALF_STEP(pB0, pB1, mnB, alB, pA0, pA1, alA, t, 1, 0, 0);
        HALF_STEP(pA0, pA1, mnA, alA, pB0, pB1, alB, t + 1, 0, 1, 1);
        if (t == 3 && NT > 6) {
            const float* tab = (const float*)(lds + TBL_OFF + cb.tb * TBL_BYTES); float* tbm = (float*)(lds + TBLM_OFF);
            int mb = (int)__float_as_uint(m_reg);
#define DPP_MIN(ctrl, rmask) mb = (int)__float_as_uint(fminf(__uint_as_float((unsigned)mb), __uint_as_float((unsigned)__builtin_amdgcn_update_dpp(mb, mb, ctrl, rmask, 0xf, false))))
            DPP_MIN(0x111, 0xf); DPP_MIN(0x112, 0xf); DPP_MIN(0x114, 0xf); DPP_MIN(0x118, 0xf); DPP_MIN(0x142, 0xa); DPP_MIN(0x143, 0xc);
#undef DPP_MIN
            const float mwave = __uint_as_float((unsigned)__builtin_amdgcn_readlane(mb, 63));
            if (lane == 0) tbm[wid] = mwave;
            asm volatile("s_waitcnt lgkmcnt(0)" ::: "memory"); __syncthreads();
            const f32x4 t0 = *(const f32x4*)tbm, t1 = *(const f32x4*)(tbm + 4);
            const float mm = fminf(fminf(fminf(t0[0], t0[1]), fminf(t0[2], t0[3])), fminf(fminf(t1[0], t1[1]), fminf(t1[2], t1[3])));
            const float thr = SKIP_EPS * __builtin_amdgcn_exp2f((mm + tab[256] - 0.05f) * 1.4426950408889634f);
            int lane_ = lane; asm volatile("" : "+v"(lane_));
            int jl = jhi - 5;
#pragma unroll
            for (int g = 3; g >= 0; --g) { const int j = g * 64 + lane_; const bool skip = (j <= jhi - 6) && (tab[j] <= thr) && (thr < 1e30f);
                const unsigned long long keep = ~__ballot(skip);
                if (keep) jl = g * 64 + (int)__builtin_ctzll(keep); }
            const int NTr = jhi + 1 - jl;
            NT = NTr < NT ? NTr : NT;
            __syncthreads();
        }
    }
    const bool even = (NT & 1) == 0;
    if (even) { SBAR(); qkt<1>(pB0, pB1, K_lds, ck_lds, r32, hi, S.qr); SBAR(); }
    { const int nbh_ = blk_bh(nb.L), nP0 = blk_qb(nb.L) * QB; const float* nC = T.C + (size_t)nbh_ * SEQ;
      SLOAD_H(T.K + (size_t)nbh_ * SEQ * D, T.V + (size_t)nbh_ * SEQ * D, nC, ((nP0 + QB - 1) / KVBLK) * KVBLK, 0); SBAR();
      const bf16_t* qb_ = T.Q + ((size_t)nbh_ * SEQ + nP0 + wid * QBLK) * D;
#pragma unroll
      for (int d0 = 0; d0 < 8; ++d0) S.qr[d0] = LD16(qb_, qo + d0 * 32);
    }
    SBAR();
    finishSM(pA0, pA1, alA, l_reg, pa0, pa1, pa2, pa3); SBAR();
    pv_tile<0>(o, vb0, pa0, pa1, pa2, pa3);
    if (even) { MASKT(pB0, pB1, NT - 1); partialSM(pB0, pB1, m_reg, mnB, alB); __syncthreads(); RESC(alB);
        finishSM(pB0, pB1, alB, l_reg, pa0, pa1, pa2, pa3); SBAR(); pv_tile<1>(o, vb0, pa0, pa1, pa2, pa3); }
    SBAR(); SEAM_K0();
    if (hi == 0) li_l[r32] = l_reg; asm volatile("s_waitcnt lgkmcnt(0)" ::: "memory");
    float rli[16];
#pragma unroll
    for (int r = 0; r < 16; ++r) rli[r] = __builtin_amdgcn_rcpf(li_l[crow(r, hi)]);
    int el = threadIdx.x; asm volatile("" : "+v"(el));
    const int elane = el & 63, er32 = elane & 31, ehi = elane >> 5, odd = er32 & 1;
    char* ot = lds + (wid < NW - 1 ? OT_OFF + wid * OT_WAVE : 2 * SHM_V + SHM_K);
    const size_t go = ((size_t)(cbh / NHEAD) * SEQ + cP0 + wid * QBLK) * OROW + (size_t)(cbh % NHEAD) * D;
    char* Ob = (char*)(T.O + go); const char* Gb = (const char*)(T.G + go);
    const unsigned rdo = (unsigned)((elane >> 4) * OROW * 2 + (elane & 15) * 16);
    u32x4 gv[8];
#pragma unroll
    for (int it = 0; it < 8; ++it) gv[it] = *(const u32x4*)(Gb + (size_t)it * 4 * OROW * 2 + rdo);
    const unsigned wbase = (unsigned)((4 * ehi + 2 * odd) * OT_RS + (er32 & ~1) * 2);
#pragma unroll
    for (int d0 = 0; d0 < 4; ++d0)
#pragma unroll
        for (int q = 0; q < 8; ++q) { const int r = (q >> 1) * 4 + (q & 1);
            const float X = o[d0][r] * rli[r], Y = o[d0][r + 2] * rli[r + 2];
            const float snd = odd ? X : Y;
            const float rcv = __uint_as_float((unsigned)__builtin_amdgcn_update_dpp((int)__float_as_uint(snd), (int)__float_as_uint(snd), 0xB1, 0xf, 0xf, false));
            const unsigned pk = cvt_pk_bf16(odd ? rcv : X, odd ? Y : rcv);
            *(unsigned*)(ot + wbase + ((r & 3) + 8 * (r >> 2)) * OT_RS + d0 * 64) = pk; }
    asm volatile("s_waitcnt lgkmcnt(0)" ::: "memory");
    const unsigned rbase = (unsigned)((elane >> 4) * OT_RS + (elane & 15) * 16);
#pragma unroll
    for (int it = 0; it < 8; ++it) { const u32x4 ov = *(const u32x4*)(ot + rbase + it * 4 * OT_RS), g = gv[it]; u32x4 w;
        w.x = cvt_pk_bf16(bflo(ov.x) * bflo(g.x), bfhi(ov.x) * bfhi(g.x)); w.y = cvt_pk_bf16(bflo(ov.y) * bflo(g.y), bfhi(ov.y) * bfhi(g.y));
        w.z = cvt_pk_bf16(bflo(ov.z) * bflo(g.z), bfhi(ov.z) * bfhi(g.z)); w.w = cvt_pk_bf16(bflo(ov.w) * bflo(g.w), bfhi(ov.w) * bfhi(g.w));
        *(u32x4*)(Ob + (size_t)it * 4 * OROW * 2 + rdo) = w; }
    __syncthreads();
#undef RESC
#undef KBASE
#undef MASKT
#undef SEAM_K0
#undef HALF_STEP
}
#undef LD16
#undef VMW
#undef VMWN
#undef SLOAD_H
#undef SWRITE_HK
#undef SWRITE_HV
#undef SWRITE_H

__device__ __forceinline__ int find_jlo(const float* Ch, const float* kn2, int P0, float rho, float bnd, float* tab) {
    int lane = threadIdx.x & 63; asm volatile("" : "+v"(lane));
    const int nd = P0 / KVBLK; const float c0 = Ch[P0];
    const float thr0 = SKIP_EPS * __builtin_amdgcn_exp2f(-bnd * 1.4426950408889634f);
    float e[4];
#pragma unroll
    for (int g = 0; g < 4; ++g) { const int j = g * 64 + lane; e[g] = 0.f;
        if (j < nd) e[g] = __builtin_amdgcn_exp2f((fmaf(rho, __builtin_sqrtf(kn2[j]), c0) - Ch[j * KVBLK + KVBLK - 1]) * 1.4426950408889634f); }
    int jlo = 4 * 64; float carry = 0.f;
#pragma unroll
    for (int g = 0; g < 4; ++g) { float p = e[g];
#define DPP_ADD(ctrl, rmask) p += __uint_as_float((unsigned)__builtin_amdgcn_update_dpp(0, (int)__float_as_uint(p), ctrl, rmask, 0xf, true))
        DPP_ADD(0x111, 0xf); DPP_ADD(0x112, 0xf); DPP_ADD(0x114, 0xf); DPP_ADD(0x118, 0xf);
        DPP_ADD(0x142, 0xa); DPP_ADD(0x143, 0xc);
#undef DPP_ADD
        p += carry;
        if (tab && threadIdx.x < 64) tab[g * 64 + lane] = p;
        const bool skip = (g * 64 + lane < nd) && (p <= thr0);
        const unsigned long long keep = ~__ballot(skip);
        if (keep && jlo == 4 * 64) jlo = g * 64 + (int)__builtin_ctzll(keep);
        carry = __uint_as_float((unsigned)__builtin_amdgcn_readlane((int)__float_as_uint(p), 63)); }
    if (tab && threadIdx.x == 0) tab[256] = c0;
    return jlo;
}
__device__ __forceinline__ Blk mkblk(int L, const Tensors& T, char* lds, int tb) {
    const int bh = blk_bh(L), P0 = blk_qb(L) * QB;
    const float qn2 = T.nrm[bh * 64 + blk_qb(L)], dneg = T.nrm[NBH * 64 + bh * 64 + blk_qb(L)];
    const float rho = 1.001f * __builtin_sqrtf(qn2), bnd = 1.001f * dneg + 0.05f;
    Blk r; r.L = L; r.tb = tb; r.jlo = __builtin_amdgcn_readfirstlane(find_jlo(T.C + (size_t)bh * SEQ, T.nrm + 2 * NBH * 64 + bh * 256, P0, rho, bnd, (float*)(lds + TBL_OFF + tb * TBL_BYTES)));
    return r;
}
__device__ __forceinline__ void attn_order(char* lds, const Tensors& T) {
    unsigned short* ord = (unsigned short*)(lds + ORD_OFF); int* cap = (int*)(lds + CAP_OFF);
    int tid = threadIdx.x; asm volatile("" : "+v"(tid));
    const int wid = __builtin_amdgcn_readfirstlane(tid >> 6);
#pragma unroll
    for (int k = 0; k < 4; ++k) { const int bh = wid * 4 + k;
        const float qn2 = T.nrm[bh * 64 + 63], dneg = T.nrm[NBH * 64 + bh * 64 + 63];
        const int jl = find_jlo(T.C + (size_t)bh * SEQ, T.nrm + 2 * NBH * 64 + bh * 256, 63 * QB, 1.001f * __builtin_sqrtf(qn2), 1.001f * dneg + 0.05f, nullptr);
        int c = (63 * 4 - jl + 3) >> 2; c = c > 63 ? 63 : c;
        if ((tid & 63) == 0) cap[bh] = c; }
    asm volatile("s_waitcnt lgkmcnt(0)" ::: "memory"); __syncthreads();
    for (int i = tid; i < NBH * NQB; i += NW * 64) { const int bh = i >> 6, qb = i & 63, capb = cap[bh], lev = qb < capb ? qb : capb;
        int pos = lev == capb ? qb - capb : 0;
        for (int h = 0; h < NBH; ++h) { const int c = cap[h];
            if (lev + 1 <= c) pos += 63 - lev;
            if (h < bh) pos += lev < c ? 1 : (lev == c ? 64 - c : 0); }
        ord[pos] = (unsigned short)i; }
    asm volatile("s_waitcnt lgkmcnt(0)" ::: "memory"); __syncthreads();
}
__device__ __forceinline__ void attn_phase(char* lds, const Tensors& T) {
    constexpr int total = NBH * NQB;
    attn_order(lds, T);
    const unsigned short* ord = (const unsigned short*)(lds + ORD_OFF);
    volatile int* qslot = (volatile int*)(lds + LDS_ATT);
    if (threadIdx.x == 0) *qslot = (int)atomicAdd(T.queue, 1u);
    __syncthreads();
    const int L0 = __builtin_amdgcn_readfirstlane(*qslot);
    __syncthreads();
    if (L0 >= total) return;
    Blk cur = mkblk(__builtin_amdgcn_readfirstlane((int)ord[L0]), T, lds, 0);
    Seam S;
    attn_prime(T, cur, lds, S);
    for (;;) {
        if (threadIdx.x == 0) *qslot = (int)atomicAdd(T.queue, 1u);
        __syncthreads();
        const int Ln = __builtin_amdgcn_readfirstlane(*qslot);
        const bool last = Ln >= total;
        Blk nxt = cur; if (!last) nxt = mkblk(__builtin_amdgcn_readfirstlane((int)ord[Ln]), T, lds, cur.tb ^ 1);
        attn_block(T, cur, nxt, lds, S);
        if (last) break;
        cur = nxt;
    }
}
}

struct Args {
    const float* in[25]; float* out; unsigned char* ws; int ph_lo, ph_hi; int alt, pad;
};
enum { I_X = 0, I_ANORM, I_AWIN, I_ACONVW, I_ACONVB, I_AWREC, I_ABREC, I_AWINP, I_ABINP, I_ALAMBDA, I_AWOUT, I_KVNORM, I_KVW, I_KVBF, I_BNORM, I_BWQG, I_BWO,
       I_MNORM, I_MWGROUP, I_MBGROUP, I_MWROUTER, I_MBROUTER, I_MWIN, I_MWOUT, I_FNORM };
constexpr int NPHASES = 21;

__device__ __forceinline__ void cvt_item(const float* src, int ld, const float* gain, bf16_t* dst, int ldd, LAS float* scr, int lane) {
    const int q = lane & 15, kr = lane >> 4;
#pragma unroll
    for (int hb = 0; hb < 2; ++hb) {
        f32x4 v[8];
#pragma unroll
        for (int it = 0; it < 8; ++it) { const int kk = (hb * 8 + it) * 4 + kr; v[it] = *(const f32x4*)(src + (size_t)kk * ld + q * 4); }
#pragma unroll
        for (int it = 0; it < 8; ++it) { const int kk = (hb * 8 + it) * 4 + kr; const float gk = gain ? gain[kk] : 1.0f;
            *(LAS f32x4*)(scr + kk * 64 + ((4 * q) ^ (4 * (kk >> 3)))) = v[it] * gk; }
    }
    LDS_WAIT(); asm volatile("" ::: "memory");
    const int c = lane & 7;
#pragma unroll
    for (int j = 0; j < 8; ++j) { const int n = (lane >> 3) + 8 * j; const LAS float* s = scr + (8 * c) * 64 + (n ^ (4 * c));
        u32x4 o; o.x = cvt_pk_bf16(s[0 * 64], s[1 * 64]); o.y = cvt_pk_bf16(s[2 * 64], s[3 * 64]); o.z = cvt_pk_bf16(s[4 * 64], s[5 * 64]); o.w = cvt_pk_bf16(s[6 * 64], s[7 * 64]);
        *(u32x4*)(dst + (size_t)n * ldd + 8 * c) = o; }
    LDS_WAIT(); asm volatile("" ::: "memory");
}

constexpr int DEFER_ITEMS = 64 * 256, DEFER_ROUTER = 7168, DEFER_SCATTER = 1024;
static_assert(2 * (DEFER_ROUTER + DEFER_SCATTER) == DEFER_ITEMS, "deferred weight items");
__device__ __forceinline__ void cvt_wout_deferred(const float* mwout, bf16_t* WmoT, int first, int count, int w, int nw, LAS float* scr, int wave, int lane) {
    for (int d = first + w * NWAVES + wave; d < first + count; d += nw * NWAVES) {
        const int le = 64 + (d >> 8), rr = d & 255, kb = rr >> 5, nb = rr & 31;
        cvt_item(mwout + (size_t)le * 512 * DM + (size_t)kb * 64 * DM + nb * 64, DM, nullptr, WmoT + (size_t)le * DM * 512 + (size_t)nb * 64 * 512 + kb * 64, 512, scr, lane); }
}
struct MoeCtx {
    LAS unsigned char* lds; volatile LAS unsigned* MISC; unsigned char* ws; int G, bx, vcu, wave, lo, hi;
    const float* bgroup; const float* brouter; const float* fnorm; float* out; const float* mwout;
};
#ifndef PHASE_MASK
#define PHASE_MASK 0x1fffff
#endif
#define PH_ON(k) (((PHASE_MASK) >> (k)) & 1)
#define IN(k) (PH_ON(k) && lo <= (k) && (k) < hi)
#if !MK_PER_PHASE
#define GRID_BAR() xcd_barrier(bar)
#else
#define GRID_BAR() do { } while (0)
#endif
#define SEAM(k) do { if (IN(k) && IN((k) + 1)) GRID_BAR(); } while (0)
template <int layer>
__device__ __forceinline__ void moe_block(const MoeCtx& C, const XcdBarrier& bar) {
    LAS unsigned char* lds = C.lds; volatile LAS unsigned* MISC = C.MISC; const int G = C.G, bx = C.bx, vcu = C.vcu, wave = C.wave, lo = C.lo, hi = C.hi;
    int tid = threadIdx.x; asm volatile("" : "+v"(tid));
    const int lane = tid & 63;
    constexpr int pb = 7 + 9 * layer;
    unsigned char* ws = C.ws; unsigned* ctl = (unsigned*)(ws + WS_CTL);
    const bf16_t* XRB = (const bf16_t*)(ws + (layer ? WS_X3B : WS_X1B));
    unsigned* gcnt = ctl + CW_GCNT + 64 * layer;
    unsigned char* mb = ws + WS_ASG + (size_t)layer * MOE_LAYER_STRIDE;
    int* asg_e = (int*)mb; int* asg_r = asg_e + 2 * NTOK; float* asg_w = (float*)(asg_r + 2 * NTOK); float* rstd_tok = asg_w + 2 * NTOK; int* TH = (int*)(rstd_tok + NTOK); int* asg_g = TH + 128 * 64;
    int* tokl = (int*)(mb + (WS_TOKL - WS_ASG)); float* rsl = (float*)(mb + (WS_RSL - WS_ASG)); bf16_t* ACT = (bf16_t*)(mb + (WS_ACT - WS_ASG)); bf16_t* YB = (bf16_t*)(mb + (WS_YB - WS_ASG));
    float* X2 = (float*)(ws + WS_X2); bf16_t* XN2 = (bf16_t*)(ws + WS_XN2);
    const bf16_t* WrT = (const bf16_t*)(ws + WS_WR); const bf16_t* WmiT = (const bf16_t*)(ws + WS_WMI); const bf16_t* WmoT = (const bf16_t*)(ws + WS_WMO);
    if (IN(pb)) {
        pg8::Gemm g{XRB, WrT + (size_t)layer * 256 * DM, DM, DM, DM, nullptr, nullptr, nullptr}; pg8::DenseSched S; S.o.init(NTOK / 256, 1, G, bx);
        pg8::EpiRouter E{(const float*)(ws + (layer ? WS_PART3 : WS_PART)), C.bgroup + 8 * layer, C.brouter + 64 * layer, TH, asg_e, asg_r, asg_w, rstd_tok};
        pg8::gemm_phase<pg8::EpiRouter, pg8::DenseSched, false, false>(lds, g, S, E);
        if (G >= 256 && bx >= NTOK / 256) {
            int dl = threadIdx.x; asm volatile("" : "+v"(dl));
            cvt_wout_deferred(C.mwout, (bf16_t*)(ws + WS_WMO), layer * (DEFER_ROUTER + DEFER_SCATTER), DEFER_ROUTER, bx - NTOK / 256, G - NTOK / 256, (LAS float*)(lds + wave * 16384), wave, dl & 63); }
    }
    SEAM(pb);
    if (IN(pb + 1)) {
        LAS int* bs = (LAS int*)lds;
        for (int tile = vcu; tile < NTOK / 256; tile += G) {
            if (tid < 64) { int base = 0;
#pragma unroll 16
                for (int tt = 0; tt < tile; ++tt) base += TH[tt * 64 + tid];
                bs[tid] = base; if (tile == NTOK / 256 - 1) gcnt[tid] = (unsigned)(base + TH[tile * 64 + tid]); }
            LDS_WAIT(); __syncthreads();
            if (tid < 256) { const int t = tile * 256 + tid; const float rs = rstd_tok[t];
#pragma unroll
                for (int k = 0; k < 2; ++k) { const int e = asg_e[2 * t + k], r = bs[e] + asg_r[2 * t + k]; asg_g[2 * t + k] = r; __hip_atomic_store(tokl + (size_t)e * LCAP + r, t, __ATOMIC_RELAXED, __HIP_MEMORY_SCOPE_AGENT); __hip_atomic_store(rsl + (size_t)e * LCAP + r, rs, __ATOMIC_RELAXED, __HIP_MEMORY_SCOPE_AGENT); } }
            __syncthreads();
        }
        if (G >= 256 && vcu >= NTOK / 256) {
            int dl = threadIdx.x; asm volatile("" : "+v"(dl));
            cvt_wout_deferred(C.mwout, (bf16_t*)(ws + WS_WMO), layer * (DEFER_ROUTER + DEFER_SCATTER) + DEFER_ROUTER, DEFER_SCATTER, vcu - NTOK / 256, G - NTOK / 256, (LAS float*)(lds + wave * 16384), wave, dl & 63); }
    }
    SEAM(pb + 1);
    if (IN(pb + 2) || IN(pb + 3) || IN(pb + 4)) {
        __syncthreads();
        if (tid < 64) { const int c = (int)__hip_atomic_load(gcnt + tid, __ATOMIC_RELAXED, __HIP_MEMORY_SCOPE_AGENT); const int ntile = (c + 255) >> 8; int incl = ntile;
#pragma unroll
            for (int o = 1; o < 64; o <<= 1) { const int nb = __shfl_up(incl, o); if (lane >= o) incl += nb; }
            MISC[MI_CNT + tid] = (unsigned)c; MISC[MI_TSTART + tid + 1] = (unsigned)incl; if (tid == 0) MISC[MI_TSTART] = 0u; }
        LDS_WAIT(); __syncthreads();
    }
    const LAS int* tstart = (const LAS int*)(lds + MISC_OFF) + MI_TSTART; const LAS int* ecnt = (const LAS int*)(lds + MISC_OFF) + MI_CNT;
    if (IN(pb + 2)) {
        pg8::Gemm g{XRB, WmiT + (size_t)layer * 64 * 1024 * DM, DM, DM, DM, tokl, nullptr, nullptr};
        pg8::MoeSched<true> S{tstart, ecnt, 4, G, bx, tstart[64] * 4, 1024};
        pg8::EpiMoe1 E{rsl, ACT};
        pg8::gemm_phase<pg8::EpiMoe1, pg8::MoeSched<true>, true, true>(lds, g, S, E);
    }
    SEAM(pb + 2);
    if (IN(pb + 3)) {
        pg8::Gemm g{ACT, WmoT + (size_t)layer * 64 * DM * 512, DEXP, DEXP, DEXP, nullptr, nullptr, nullptr};
        pg8::MoeSched<false> S{tstart, ecnt, 8, G, bx, tstart[64] * 8, 2048};
        pg8::EpiMoe2 E{YB};
        pg8::gemm_phase<pg8::EpiMoe2, pg8::MoeSched<false>, false, true>(lds, g, S, E);
    }
    SEAM(pb + 3);
    if (IN(pb + 4)) {
        const int gw = vcu * NWAVES + wave, NGW = G * NWAVES;
        const float* fn = C.fnorm;
        struct Asg { int e0, e1, r0, r1; float w0, w1; };
#define CB_LD_ASG(A_, t_) do { (A_).e0 = asg_e[2 * (t_)]; (A_).e1 = asg_e[2 * (t_) + 1]; (A_).r0 = asg_g[2 * (t_)]; (A_).r1 = asg_g[2 * (t_) + 1]; (A_).w0 = asg_w[2 * (t_)]; (A_).w1 = asg_w[2 * (t_) + 1]; } while (0)
#define CB_LD_ROW(X_, A0_, B0_, A_, t_) do { const size_t p0_ = (size_t)(tstart[(A_).e0] * 256 + (A_).r0), p1_ = (size_t)(tstart[(A_).e1] * 256 + (A_).r1);               \
            const u32x2* xr_ = (const u32x2*)(XRB + (size_t)(t_) * DM) + lane; const u32x2* y0_ = (const u32x2*)(YB + p0_ * DM) + lane; const u32x2* y1_ = (const u32x2*)(YB + p1_ * DM) + lane; \
            _Pragma("unroll") for (int j = 0; j < 8; ++j) { (X_)[j] = __builtin_nontemporal_load(xr_ + 64 * j); (A0_)[j] = __builtin_nontemporal_load(y0_ + 64 * j); (B0_)[j] = __builtin_nontemporal_load(y1_ + 64 * j); } } while (0)
        Asg ac, an; u32x2 xw[8], aw[8], bw[8];
        { const int t0 = gw; ac.e0 = ac.e1 = ac.r0 = ac.r1 = 0; ac.w0 = ac.w1 = 0.f; an = ac;
          if (t0 < NTOK) { CB_LD_ASG(ac, t0); CB_LD_ROW(xw, aw, bw, ac, t0); }
          if (t0 + NGW < NTOK) CB_LD_ASG(an, t0 + NGW); }
        for (int t = gw; t < NTOK; t += NGW) {
            const int tn = t + NGW;
            Asg a2 = an; if (tn + NGW < NTOK) CB_LD_ASG(a2, tn + NGW);
            u32x2 xn[8], yn0[8], yn1[8];
            if (tn < NTOK) CB_LD_ROW(xn, yn0, yn1, an, tn);
            else {
#pragma unroll
                for (int j = 0; j < 8; ++j) { xn[j] = xw[j]; yn0[j] = aw[j]; yn1[j] = bw[j]; } }
            float w0 = ac.w0, w1 = ac.w1;
#ifdef DBG_ZERO_MOE1
                if (layer == 1) { w0 = 0.f; w1 = 0.f; }
#endif
            f32x4 v[8]; float s = 0.f;
#pragma unroll
            for (int j = 0; j < 8; ++j) { const u32x2 xv = xw[j]; v[j] = (f32x4){bflo(xv.x), bfhi(xv.x), bflo(xv.y), bfhi(xv.y)}; const u32x2 a = aw[j], b = bw[j];
                v[j][0] += w0 * bflo(a.x) + w1 * bflo(b.x); v[j][1] += w0 * bfhi(a.x) + w1 * bfhi(b.x); v[j][2] += w0 * bflo(a.y) + w1 * bflo(b.y); v[j][3] += w0 * bfhi(a.y) + w1 * bfhi(b.y);
                s += (v[j][0] * v[j][0] + v[j][1] * v[j][1]) + (v[j][2] * v[j][2] + v[j][3] * v[j][3]); }
            const float rstd = 1.0f / sqrtf(wave_sum(s) * (1.0f / DM) + RMS_EPS);
            if (layer == 0) {
                u32x2* o8 = (u32x2*)(XN2 + (size_t)t * DM) + lane;
#pragma unroll
                for (int j = 0; j < 8; ++j) { u32x2 w; w.x = cvt_pk_bf16(v[j][0], v[j][1]); w.y = cvt_pk_bf16(v[j][2], v[j][3]); __builtin_nontemporal_store(w, o8 + 64 * j); }
                if (lane == 0) X2[t] = rstd;
            } else {
                f32x4* oo = (f32x4*)(C.out + (size_t)t * DM) + lane; const f32x4* fg = (const f32x4*)fn + lane;
#pragma unroll
                for (int j = 0; j < 8; ++j) __builtin_nontemporal_store(v[j] * rstd * fg[64 * j], oo + 64 * j);
            }
            ac = an; an = a2;
#pragma unroll
            for (int j = 0; j < 8; ++j) { xw[j] = xn[j]; aw[j] = yn0[j]; bw[j] = yn1[j]; }
        }
#undef CB_LD_ASG
#undef CB_LD_ROW
    }
    if (layer == 0) SEAM(pb + 4);
}

__global__ void __launch_bounds__(NTHREADS, 2) fwd_kernel(Args args) {
    extern __shared__ __attribute__((aligned(16))) unsigned char lds_raw[];
    LAS unsigned char* lds = (LAS unsigned char*)lds_raw;
    volatile LAS unsigned* MISC = (volatile LAS unsigned*)(lds + MISC_OFF);
    const int tid = threadIdx.x, lane = tid & 63, wave = __builtin_amdgcn_readfirstlane(tid >> 6);
    const int G = gridDim.x; const int bx = blockIdx.x; const int vcu = (G % 8 == 0) ? (bx % 8) * (G / 8) + bx / 8 : bx;
    unsigned char* ws = args.ws;
    unsigned* ctl = (unsigned*)(ws + WS_CTL);
    for (int u = tid; u < (LDS_BYTES - MISC_OFF) / 4; u += NTHREADS) MISC[u] = 0u;
    __syncthreads();
#if !MK_PER_PHASE
    XcdBarrier bar = xcd_barrier_post(ctl + CW_BAR, MISC + MI_BAR);
#else
    XcdBarrier bar; bar.bar = nullptr; bar.x = 0; bar.st = nullptr;
#endif
    const int lo = args.ph_lo, hi = args.ph_hi;

    bf16_t* WinT = (bf16_t*)(ws + WS_WIN); bf16_t* WgT = (bf16_t*)(ws + WS_WG); bf16_t* WoutT = (bf16_t*)(ws + WS_WOUT); bf16_t* WkvqgT = (bf16_t*)(ws + WS_WKVQG);
    bf16_t* WoT = (bf16_t*)(ws + WS_WO); bf16_t* WrT = (bf16_t*)(ws + WS_WR); bf16_t* WmiT = (bf16_t*)(ws + WS_WMI); bf16_t* WmoT = (bf16_t*)(ws + WS_WMO);
    float* Lvec = (float*)(ws + WS_LVEC);
    bf16_t* H0 = (bf16_t*)(ws + WS_H0); bf16_t* Ub = (bf16_t*)(ws + WS_U); bf16_t* GY = (bf16_t*)(ws + WS_GY); bf16_t* UC = (bf16_t*)(ws + WS_UC);
    bf16_t* LAb = (bf16_t*)(ws + WS_LA); bf16_t* BBb = (bf16_t*)(ws + WS_BB); bf16_t* HS = (bf16_t*)(ws + WS_HS);
    bf16_t* X1B = (bf16_t*)(ws + WS_X1B); float* PART = (float*)(ws + WS_PART);
    bf16_t* IDN = (bf16_t*)(ws + WS_X2 + 4 * MiB);
    float* cLA = (float*)(ws + WS_CARRY); float* cH = cLA + 256 * DM;
    int* asg_e = (int*)(ws + WS_ASG); int* asg_r = asg_e + 2 * NTOK; float* asg_w = (float*)(asg_r + 2 * NTOK); float* rstd_tok = asg_w + 2 * NTOK; int* TH = (int*)(rstd_tok + NTOK);
    int* tokl = (int*)(ws + WS_TOKL); float* rsl = (float*)(ws + WS_RSL);
    bf16_t* ACT = (bf16_t*)(ws + (args.alt ? (size_t)3400 * MiB : WS_ACT)); bf16_t* YB = (bf16_t*)(ws + WS_YB);
    float* X2 = (float*)(ws + WS_X2); bf16_t* XN2 = (bf16_t*)(ws + WS_XN2);
    bf16_t* Kb = (bf16_t*)(ws + WS_KB); bf16_t* Vb = (bf16_t*)(ws + WS_VB); bf16_t* Qb = (bf16_t*)(ws + WS_QB); bf16_t* SG = (bf16_t*)(ws + WS_SG);
    float* FLOG = (float*)(ws + WS_FLOG); float* CUM = (float*)(ws + WS_CUM); bf16_t* OG = (bf16_t*)(ws + WS_OG);
    float* RS0 = (float*)(ws + WS_X2 + 2 * MiB);
    float* NRMF = (float*)(ws + WS_X2 + 1 * MiB);
    bf16_t* X3B = (bf16_t*)(ws + WS_X3B); float* PART3 = (float*)(ws + WS_PART3);
    const float* x_in = args.in[I_X];

    if (IN(0)) {
        LAS float* scr = (LAS float*)(lds + wave * 16384);
        const int gw = vcu * NWAVES + wave, NGW = G * NWAVES;
        constexpr int I1 = 32 * 64, I2 = 256, I3 = 32 * 32, I4 = 32 * 64, I5 = 32 * 64, I6 = 32 * 32, I8 = 2 * 64 * 512, I9 = 2 * 64 * 256;
        const int NITEMS = I1 + I2 + I3 + I4 + I5 + I6 + I8 + (G >= 256 ? I9 - DEFER_ITEMS : I9);
        for (int it = gw; it < NITEMS; it += NGW) {
            int r = it; const float* src; const float* gain = nullptr; bf16_t* dst; int ld, ldd;
            if (r < I1) { const int kb = r >> 6, nb = r & 63;
                src = args.in[I_AWIN] + (size_t)kb * 64 * 4096 + nb * 64; ld = 4096; gain = args.in[I_ANORM] + kb * 64; dst = WinT + (size_t)nb * 64 * DM + kb * 64; ldd = DM; }
            else if ((r -= I1) < I2) { const int which = r & 1, kb = (r >> 1) & 3, nh = (r >> 3) & 1, q = (r >> 4) & 1, nblk = r >> 5;
                src = args.in[which ? I_AWINP : I_AWREC] + (size_t)nblk * 65536 + (size_t)kb * 64 * 256 + q * 128 + nh * 64; ld = 256;
                dst = WgT + (size_t)(nblk * 512 + q * 256 + which * 128 + nh * 64) * 256 + kb * 64; ldd = 256; }
            else if ((r -= I2) < I3) { const int kb = r >> 5, nb = r & 31;
                src = args.in[I_AWOUT] + (size_t)kb * 64 * DM + nb * 64; ld = DM; dst = WoutT + (size_t)nb * 64 * DM + kb * 64; ldd = DM; }
            else if ((r -= I3) < I4) { const int kb = r >> 6, nb = r & 63;
                src = args.in[I_KVW] + (size_t)kb * 64 * 4112 + nb * 64; ld = 4112; gain = args.in[I_KVNORM] + kb * 64; dst = WkvqgT + (size_t)nb * 64 * DM + kb * 64; ldd = DM; }
            else if ((r -= I4) < I5) { const int kb = r >> 6, nb = r & 63;
                src = args.in[I_BWQG] + (size_t)kb * 64 * 4096 + nb * 64; ld = 4096; gain = args.in[I_BNORM] + kb * 64; dst = WkvqgT + (size_t)(4352 + nb * 64) * DM + kb * 64; ldd = DM; }
            else if ((r -= I5) < I6) { const int kb = r >> 5, nb = r & 31;
                src = args.in[I_BWO] + (size_t)kb * 64 * DM + nb * 64; ld = DM; dst = WoT + (size_t)nb * 64 * DM + kb * 64; ldd = DM; }
            else if ((r -= I6) < I8) { const int le = r >> 9, rr = r & 511, kb = rr >> 4, nb = rr & 15;
                const int pn = nb >> 2, half = (nb >> 1) & 1, sub = nb & 1; const int scol = half * 512 + pn * 128 + sub * 64, layer = le >> 6;
                src = args.in[I_MWIN] + (size_t)le * 2048 * 1024 + (size_t)kb * 64 * 1024 + scol; ld = 1024; gain = args.in[I_MNORM] + layer * DM + kb * 64;
                dst = WmiT + (size_t)le * 1024 * DM + (size_t)nb * 64 * DM + kb * 64; ldd = DM; }
            else { r -= I8; const int le = r >> 8, rr = r & 255, kb = rr >> 5, nb = rr & 31;
                src = args.in[I_MWOUT] + (size_t)le * 512 * DM + (size_t)kb * 64 * DM + nb * 64; ld = DM; dst = WmoT + (size_t)le * DM * 512 + (size_t)nb * 64 * 512 + kb * 64; ldd = 512; }
            cvt_item(src, ld, gain, dst, ldd, scr, lane);
        }
        const int gt = vcu * NTHREADS + tid, NGT = G * NTHREADS;
        for (int i = gt; i < 256 * DM; i += NGT) {
            const int n = i / DM, k = i % DM; float v = 0.f; if (n < 16) v = args.in[I_KVW][(size_t)k * 4112 + 4096 + n] * args.in[I_KVNORM][k];
            WkvqgT[(size_t)(4096 + n) * DM + k] = (bf16_t)(cvt_pk_bf16(v, 0.f) & 0xffffu); }
        for (int i = gt; i < 2 * 256 * DM; i += NGT) {
            const int layer = i / (256 * DM), n = (i / DM) % 256, k = i % DM; float v = 0.f;
            if (n < 8) v = args.in[I_MWGROUP][(size_t)layer * DM * 8 + (size_t)k * 8 + n]; else if (n < 72) v = args.in[I_MWROUTER][(size_t)layer * DM * 64 + (size_t)k * 64 + (n - 8)];
            v *= args.in[I_MNORM][layer * DM + k];
            WrT[i] = (bf16_t)(cvt_pk_bf16(v, 0.f) & 0xffffu); }
        for (int i = gt; i < 256 * 256; i += NGT) IDN[(size_t)(i >> 8) * DM + (i & 255)] = (bf16_t)((i >> 8) == (i & 255) ? 0x3F80 : 0);
        for (int i = gt; i < DM; i += NGT) { const float lam = args.in[I_ALAMBDA][i]; const float sp = fmaxf(-lam, 0.f) + log1pf(expf(-fabsf(lam))); Lvec[i] = -8.0f * sp; }
        for (int m = gw; m < NTOK; m += NGW) {
            const f32x4* xr = (const f32x4*)(x_in + (size_t)m * DM) + lane; f32x4 v[8]; float s = 0.f;
#pragma unroll
            for (int j = 0; j < 8; ++j) { v[j] = xr[64 * j]; s += (v[j][0] * v[j][0] + v[j][1] * v[j][1]) + (v[j][2] * v[j][2] + v[j][3] * v[j][3]); }
            const float rstd = 1.0f / sqrtf(wave_sum(s) * (1.0f / DM) + RMS_EPS);
            u32x2* o8 = (u32x2*)(H0 + (size_t)m * DM) + lane;
#pragma unroll
            for (int j = 0; j < 8; ++j) { u32x2 w; w.x = cvt_pk_bf16(v[j][0], v[j][1]); w.y = cvt_pk_bf16(v[j][2], v[j][3]); o8[64 * j] = w; }
            if (lane == 0) RS0[m] = rstd;
        }
    }
    SEAM(0);

    if (IN(1)) {
        pg8::Gemm g{H0, WinT, DM, DM, DM, nullptr, nullptr, nullptr}; pg8::DenseSched S; S.o.init(NTOK / 256, 4096 / 256, G, bx);
        pg8::EpiInProj E{Ub, GY, RS0};
        pg8::gemm_phase<pg8::EpiInProj, pg8::DenseSched, false, true>(lds, g, S, E);
    }
    SEAM(1);

    if (IN(2)) {
        const int tc = tid & 255, c0 = tc * 8; const float* cw = args.in[I_ACONVW]; const float* cbp = args.in[I_ACONVB];
        float w[4][8], cb[8];
#pragma unroll
        for (int j = 0; j < 4; ++j) { const f32x4 a = *(const f32x4*)(cw + j * DM + c0), b = *(const f32x4*)(cw + j * DM + c0 + 4);
#pragma unroll
            for (int e = 0; e < 4; ++e) { w[j][e] = a[e]; w[j][4 + e] = b[e]; } }
        { const f32x4 a = *(const f32x4*)(cbp + c0), b = *(const f32x4*)(cbp + c0 + 4);
#pragma unroll
          for (int e = 0; e < 4; ++e) { cb[e] = a[e]; cb[4 + e] = b[e]; } }
        for (int grp = vcu * 2 + (tid >> 8); grp < NTOK / 64; grp += G * 2) {
            const int row0 = grp * 64; float p1[8], p2[8], p3[8];
#pragma unroll
            for (int e = 0; e < 8; ++e) { p1[e] = 0.f; p2[e] = 0.f; p3[e] = 0.f; }
            if ((row0 % SEQ) != 0) {
                const u32x4 a = *(const u32x4*)(Ub + (size_t)(row0 - 1) * DM + c0), b = *(const u32x4*)(Ub + (size_t)(row0 - 2) * DM + c0), c = *(const u32x4*)(Ub + (size_t)(row0 - 3) * DM + c0);
                p1[0] = bflo(a.x); p1[1] = bfhi(a.x); p1[2] = bflo(a.y); p1[3] = bfhi(a.y); p1[4] = bflo(a.z); p1[5] = bfhi(a.z); p1[6] = bflo(a.w); p1[7] = bfhi(a.w);
                p2[0] = bflo(b.x); p2[1] = bfhi(b.x); p2[2] = bflo(b.y); p2[3] = bfhi(b.y); p2[4] = bflo(b.z); p2[5] = bfhi(b.z); p2[6] = bflo(b.w); p2[7] = bfhi(b.w);
                p3[0] = bflo(c.x); p3[1] = bfhi(c.x); p3[2] = bflo(c.y); p3[3] = bfhi(c.y); p3[4] = bflo(c.z); p3[5] = bfhi(c.z); p3[6] = bflo(c.w); p3[7] = bfhi(c.w);
            }
#pragma unroll 4
            for (int i = 0; i < 64; ++i) {
                const u32x4 a = __builtin_nontemporal_load((const u32x4*)(Ub + (size_t)(row0 + i) * DM + c0));
                const float cu[8] = {bflo(a.x), bfhi(a.x), bflo(a.y), bfhi(a.y), bflo(a.z), bfhi(a.z), bflo(a.w), bfhi(a.w)};
                float o[8];
#pragma unroll
                for (int e = 0; e < 8; ++e) { o[e] = cb[e] + w[3][e] * cu[e] + w[2][e] * p1[e] + w[1][e] * p2[e] + w[0][e] * p3[e]; p3[e] = p2[e]; p2[e] = p1[e]; p1[e] = cu[e]; }
                u32x4 ow; ow.x = cvt_pk_bf16(o[0], o[1]); ow.y = cvt_pk_bf16(o[2], o[3]); ow.z = cvt_pk_bf16(o[4], o[5]); ow.w = cvt_pk_bf16(o[6], o[7]);
                __builtin_nontemporal_store(ow, (u32x4*)(UC + (size_t)(row0 + i) * DM + c0));
            }
        }
    }
    SEAM(2);

    if (IN(3)) {
        pg8::Gemm g{UC, WgT, DM, 256, 256, nullptr, nullptr, nullptr}; pg8::GateSched S; S.o.init(NTOK / 256, 16, G, bx);
        pg8::EpiGates E{UC, LAb, BBb, Lvec, args.in[I_ABREC], args.in[I_ABINP]};
        pg8::gemm_phase<pg8::EpiGates, pg8::GateSched, false, true>(lds, g, S, E);
    }
    SEAM(3);

    if (IN(4)) {
        for (int it = vcu; it < 256; it += G) {
            const size_t base = (size_t)it * 128 * DM + 4 * tid;
            float h[4] = {0.f, 0.f, 0.f, 0.f}, sl[4] = {0.f, 0.f, 0.f, 0.f};
#pragma unroll 8
            for (int i = 0; i < 128; ++i) { const u32x2 lw = *(const u32x2*)(LAb + base + (size_t)i * DM), bw = *(const u32x2*)(BBb + base + (size_t)i * DM);
                const float l[4] = {bflo(lw.x), bfhi(lw.x), bflo(lw.y), bfhi(lw.y)}, b[4] = {bflo(bw.x), bfhi(bw.x), bflo(bw.y), bfhi(bw.y)};
#pragma unroll
                for (int e = 0; e < 4; ++e) { h[e] = fast_exp(l[e]) * h[e] + b[e]; sl[e] += l[e]; } }
            *(f32x4*)(cLA + (size_t)it * DM + 4 * tid) = (f32x4){sl[0], sl[1], sl[2], sl[3]}; *(f32x4*)(cH + (size_t)it * DM + 4 * tid) = (f32x4){h[0], h[1], h[2], h[3]};
        }
    }
    SEAM(4);

    if (IN(5)) {
        for (int it = vcu; it < 256; it += G) {
            const int chunk = it & 127, it0 = it - chunk;
            float h[4] = {0.f, 0.f, 0.f, 0.f};
#pragma unroll 4
            for (int j = 0; j < chunk; ++j) { const f32x4 a = *(const f32x4*)(cLA + (size_t)(it0 + j) * DM + 4 * tid), hh = *(const f32x4*)(cH + (size_t)(it0 + j) * DM + 4 * tid);
#pragma unroll
                for (int e = 0; e < 4; ++e) h[e] = fast_exp(a[e]) * h[e] + hh[e]; }
            const size_t base = (size_t)it * 128 * DM + 4 * tid;
#pragma unroll 8
            for (int i = 0; i < 128; ++i) { const u32x2 lw = __builtin_nontemporal_load((const u32x2*)(LAb + base + (size_t)i * DM)), bw = __builtin_nontemporal_load((const u32x2*)(BBb + base + (size_t)i * DM)), gw2 = __builtin_nontemporal_load((const u32x2*)(GY + base + (size_t)i * DM));
                const float l[4] = {bflo(lw.x), bfhi(lw.x), bflo(lw.y), bfhi(lw.y)}, b[4] = {bflo(bw.x), bfhi(bw.x), bflo(bw.y), bfhi(bw.y)}, gy[4] = {bflo(gw2.x), bfhi(gw2.x), bflo(gw2.y), bfhi(gw2.y)};
                float o[4];
#pragma unroll
                for (int e = 0; e < 4; ++e) { h[e] = fast_exp(l[e]) * h[e] + b[e]; o[e] = h[e] * gy[e]; }
                u32x2 ow; ow.x = cvt_pk_bf16(o[0], o[1]); ow.y = cvt_pk_bf16(o[2], o[3]); __builtin_nontemporal_store(ow, (u32x2*)(HS + base + (size_t)i * DM)); }
        }
    }
    SEAM(5);

    if (IN(6)) {
        pg8::Gemm g{HS, WoutT, DM, DM, DM, nullptr, H0, IDN}; pg8::DenseSched S; S.o.init(NTOK / 256, DM / 256, G, bx);
        pg8::EpiStoreRes E{X1B, PART};
        pg8::gemm_phase<pg8::EpiStoreRes, pg8::DenseSched, false, true>(lds, g, S, E);
    }
    SEAM(6);

    { MoeCtx MC{lds, MISC, ws, G, bx, vcu, wave, lo, hi, args.in[I_MBGROUP], args.in[I_MBROUTER], args.in[I_FNORM], args.out, args.in[I_MWOUT]};
      moe_block<0>(MC, bar); }

    if (IN(12)) {
        pg8::Gemm g{XN2, WkvqgT, DM, DM, DM, nullptr, nullptr, nullptr}; pg8::DenseSched S; S.o.init(NTOK / 256, NKVQG / 256, G, bx);
        pg8::EpiKVQG E{Kb, Vb, Qb, SG, FLOG, args.in[I_KVBF], X2};
        pg8::gemm_phase<pg8::EpiKVQG, pg8::DenseSched, false, true>(lds, g, S, E);
    }
    SEAM(12);
    if (IN(13)) {
        LAS float* wt = (LAS float*)lds;
        for (int it = vcu; it < NB * NHEAD; it += G) {
            const int b = it / NHEAD, h = it % NHEAD; float v[32]; float tot = 0.f;
#pragma unroll
            for (int i = 0; i < 32; ++i) { v[i] = FLOG[((size_t)b * SEQ + 32 * tid + i) * 16 + h]; tot += v[i]; v[i] = tot; }
            float incl = tot;
#pragma unroll
            for (int o = 1; o < 64; o <<= 1) { const float nb = __shfl_up(incl, o); if (lane >= o) incl += nb; }
            if (lane == 63) wt[wave] = incl;
            LDS_WAIT(); __syncthreads();
            float off = incl - tot;
            for (int w = 0; w < wave; ++w) off += wt[w];
            float* dst = CUM + (size_t)it * SEQ + 32 * tid;
#pragma unroll
            for (int i = 0; i < 8; ++i) *(f32x4*)(dst + 4 * i) = (f32x4){v[4 * i] + off, v[4 * i + 1] + off, v[4 * i + 2] + off, v[4 * i + 3] + off};
            __syncthreads();
        }
        const int nW = G > 64 ? G - 32 : G, w0 = G > 64 ? vcu - 32 : vcu;
        if (w0 >= 0) {
            LAS float* red = (LAS float*)(lds + 1024);
            float* QN2 = NRMF; float* DNG = NRMF + NB * NHEAD * 64; float* KN2 = NRMF + 2 * NB * NHEAD * 64;
            for (int u = w0; u < NB * NHEAD * 32; u += nW) {
                const int bh = u >> 5, ch = u & 31;
                const size_t base = (((size_t)bh * SEQ + ch * 512 + wave * 64 + (lane >> 4)) * HDIM + (lane & 15) * 8) * 2;
                const char* qp = (const char*)Qb + base; const char* kp = (const char*)Kb + base;
                float mq = 0.f, mk = 0.f, md = 0.f;
#pragma unroll 4
                for (int st = 0; st < 16; ++st) {
                    const u32x4 q = *(const u32x4*)(qp + st * 1024), k = *(const u32x4*)(kp + st * 1024);
                    float qq = 0.f, kk = 0.f, qk = 0.f;
#pragma unroll
                    for (int c = 0; c < 4; ++c) { const float ql = __uint_as_float(q[c] << 16), qh = __uint_as_float(q[c] & 0xffff0000u), kl = __uint_as_float(k[c] << 16), kh = __uint_as_float(k[c] & 0xffff0000u);
                        qq = fmaf(ql, ql, fmaf(qh, qh, qq)); kk = fmaf(kl, kl, fmaf(kh, kh, kk)); qk = fmaf(ql, kl, fmaf(qh, kh, qk)); }
#pragma unroll
                    for (int o = 1; o < 16; o <<= 1) { qq += __shfl_xor(qq, o); kk += __shfl_xor(kk, o); qk += __shfl_xor(qk, o); }
                    mq = fmaxf(mq, qq); mk = fmaxf(mk, kk); md = fmaxf(md, -qk);
                }
#pragma unroll
                for (int o = 16; o < 64; o <<= 1) { mq = fmaxf(mq, __shfl_xor(mq, o)); mk = fmaxf(mk, __shfl_xor(mk, o)); md = fmaxf(md, __shfl_xor(md, o)); }
                if (lane == 0) { KN2[bh * 256 + ch * 8 + wave] = mk; red[wave * 2 + 0] = mq; red[wave * 2 + 1] = md; }
                LDS_WAIT(); __syncthreads();
                if (tid < 4) { const int bq = tid >> 1, wq = tid & 1;
                    const float m = fmaxf(fmaxf(red[(bq * 4 + 0) * 2 + wq], red[(bq * 4 + 1) * 2 + wq]), fmaxf(red[(bq * 4 + 2) * 2 + wq], red[(bq * 4 + 3) * 2 + wq]));
                    (wq ? DNG : QN2)[bh * 64 + ch * 2 + bq] = m; }
                __syncthreads();
            }
        }
    }
    SEAM(13);
    if (IN(14)) {
        att::Tensors T{Qb, Kb, Vb, CUM, SG, OG, NRMF, ctl + CW_AQ};
        att::attn_phase((char*)lds_raw, T);
    }
    SEAM(14);
    if (IN(15)) {
        pg8::Gemm g{OG, WoT, DM, DM, DM, nullptr, XN2, IDN}; pg8::DenseSched S; S.o.init(NTOK / 256, DM / 256, G, bx);
        pg8::EpiStoreRes E{X3B, PART3};
        pg8::gemm_phase<pg8::EpiStoreRes, pg8::DenseSched, false, true>(lds, g, S, E);
    }
    SEAM(15);

    { MoeCtx MC{lds, MISC, ws, G, bx, vcu, wave, lo, hi, args.in[I_MBGROUP], args.in[I_MBROUTER], args.in[I_FNORM], args.out, args.in[I_MWOUT]};
      moe_block<1>(MC, bar); }

#ifdef DBG_CHECK_ATTN
    GRID_BAR();
    if (bx == 0 && threadIdx.x == 0) args.out[0] = 0.f;
    GRID_BAR();
    if (bx < 64) {
        int ctid = threadIdx.x; asm volatile("" : "+v"(ctid));
        LAS float* red = (LAS float*)lds; LAS float* qv = red + 512; LAS float* sc = qv + 128;
        const int smp = bx; const int bh = (smp * 7) % 32;
        const int tlist[16] = {0, 1, 31, 32, 63, 64, 255, 256, 257, 511, 4095, 4096, 8191, 12345, 15000, 16383};
        const int t = tlist[smp % 16]; const int b = bh / 16, h = bh % 16;
        if (ctid < 128) qv[ctid] = bf2f(Qb[((size_t)bh * SEQ + t) * 128 + ctid]);
        LDS_WAIT(); __syncthreads();
        const float ct = CUM[(size_t)bh * SEQ + t];
        float mx = -1e30f;
        for (int s0 = ctid; s0 <= t; s0 += NTHREADS) { float d = 0.f; for (int k = 0; k < 128; ++k) d += qv[k] * bf2f(Kb[((size_t)bh * SEQ + s0) * 128 + k]); d += ct - CUM[(size_t)bh * SEQ + s0]; sc[s0] = d; mx = fmaxf(mx, d); }
        red[ctid] = mx; LDS_WAIT(); __syncthreads(); for (int o = 256; o > 0; o >>= 1) { if (ctid < o) red[ctid] = fmaxf(red[ctid], red[ctid + o]); LDS_WAIT(); __syncthreads(); }
        const float m = red[0]; __syncthreads();
        float ls = 0.f;
        for (int s0 = ctid; s0 <= t; s0 += NTHREADS) { const float p = expf(sc[s0] - m); sc[s0] = p; ls += p; }
        red[ctid] = ls; LDS_WAIT(); __syncthreads(); for (int o = 256; o > 0; o >>= 1) { if (ctid < o) red[ctid] += red[ctid + o]; LDS_WAIT(); __syncthreads(); }
        const float l = red[0]; __syncthreads();
        float err = 0.f;
        if (ctid < 128) { float o = 0.f; for (int s0 = 0; s0 <= t; ++s0) o += sc[s0] * bf2f(Vb[((size_t)bh * SEQ + s0) * 128 + ctid]);
            const size_t gi = ((size_t)b * SEQ + t) * DM + h * 128 + ctid; const float ref = o / l * bf2f(SG[gi]); err = fabsf(ref - bf2f(OG[gi])); }
        red[ctid] = err; LDS_WAIT(); __syncthreads(); for (int o = 256; o > 0; o >>= 1) { if (ctid < o) red[ctid] = fmaxf(red[ctid], red[ctid + o]); LDS_WAIT(); __syncthreads(); }
        if (ctid == 0) atomicMax((int*)args.out, __float_as_int(red[0] * 1000.f));
    }
#endif

#ifdef DBG_CHECK_RGLRU
    GRID_BAR();
    if (bx == 0 && threadIdx.x == 0) args.out[0] = 0.f;
    GRID_BAR();
    if (bx < 16) {
        int ctid = threadIdx.x; asm volatile("" : "+v"(ctid));
        LAS float* lav = (LAS float*)lds; LAS float* bbv = lav + 16384;
        const int clist[8] = {0, 5, 255, 256, 1000, 1029, 1800, 2047};
        const int b = bx >> 3, c = clist[bx & 7], nb = c >> 8, cc = c & 255;
        const float* wr_ = args.in[I_AWREC] + (size_t)nb * 65536 + cc; const float* wi_ = args.in[I_AWINP] + (size_t)nb * 65536 + cc;
        const float brc = args.in[I_ABREC][c], bic = args.in[I_ABINP][c], lam = args.in[I_ALAMBDA][c];
        const float sp = fmaxf(-lam, 0.f) + log1pf(expf(-fabsf(lam)));
        for (int s0 = ctid; s0 < SEQ; s0 += NTHREADS) { const bf16_t* ur = UC + ((size_t)b * SEQ + s0) * DM + nb * 256; float rl = brc, il = bic;
            for (int k = 0; k < 256; ++k) { const float uk = bf2f(ur[k]); rl += uk * wr_[(size_t)k * 256]; il += uk * wi_[(size_t)k * 256]; }
            const float r = 1.f / (1.f + expf(-rl)), ig = 1.f / (1.f + expf(-il)); const float la = -8.f * r * sp; const float a2 = expf(2.f * la);
            lav[s0] = la; bbv[s0] = sqrtf(fmaxf(1.f - a2, 0.f)) * ig * bf2f(ur[cc]); }
        LDS_WAIT(); __syncthreads();
        if (ctid == 0) { float h = 0.f, err = 0.f;
            for (int s0 = 0; s0 < SEQ; ++s0) { h = expf(lav[s0]) * h + bbv[s0];
                if ((s0 & 127) == 127 || (s0 & 127) == 0 || s0 < 8) { const size_t gi = ((size_t)b * SEQ + s0) * DM + c; err = fmaxf(err, fabsf(h * bf2f(GY[gi]) - bf2f(HS[gi]))); } }
            atomicMax((int*)args.out, __float_as_int(err * 1000.f)); }
    }
#endif
#undef IN
#undef SEAM
}


#ifdef DBG_CMP
__global__ void dbg_cmp_kernel(const unsigned* a, const unsigned* b, const unsigned* gcnt, float* out, size_t nout) {
    unsigned long long bad = 0; size_t rows = 0;
    for (int e = 0; e < 64; ++e) rows += ((gcnt[e] + 255u) >> 8) << 8;
    const size_t n = rows * 512 / 2;
    for (size_t i = (size_t)blockIdx.x * blockDim.x + threadIdx.x; i < n; i += (size_t)gridDim.x * blockDim.x) if (a[i] != b[i]) ++bad;
    for (size_t i = (size_t)blockIdx.x * blockDim.x + threadIdx.x; i < nout; i += (size_t)gridDim.x * blockDim.x) out[i] = 0.f;
    if (bad) atomicAdd(out, (float)bad);
}
#endif

#ifdef DBG_VALID
__global__ void dbg_valid_kernel(const unsigned* buf, int nwords, const unsigned* gcnt, unsigned* out, size_t nout) {
    __shared__ int ts[65]; __shared__ int cn[64];
    if (threadIdx.x == 0) { int t = 0; for (int e = 0; e < 64; ++e) { ts[e] = t; cn[e] = (int)gcnt[e]; t += ((int)gcnt[e] + 255) >> 8; } ts[64] = t; }
    __syncthreads();
    for (size_t i = (size_t)blockIdx.x * blockDim.x + threadIdx.x; i < nout; i += (size_t)gridDim.x * blockDim.x) {
        const size_t row = i / nwords; unsigned v = 0u;
        if (row < (size_t)ts[64] * 256) { const int tile = (int)(row >> 8); int e = 0; while (e < 63 && ts[e + 1] <= tile) ++e;
            const int r = (int)(row - (size_t)ts[e] * 256); if (r < cn[e]) v = buf[i]; }
        out[i] = v; }
}
#endif

extern "C" void kernel_launch(void* const* d_in, const int* in_sizes, int n_in, void* d_out, int out_size, void* d_ws, size_t ws_size, hipStream_t stream) {
    static int grid = 0;
    if (grid == 0) {
        if (n_in != 25 || in_sizes[0] != NTOK * DM || out_size != NTOK * DM || ws_size < WS_END) {
            fprintf(stderr, "kernel_launch: unexpected shapes (n_in %d, in0 %d, out %d, ws %zu < %zu); nothing launched\n", n_in, n_in > 0 ? in_sizes[0] : -1, out_size, ws_size, (size_t)WS_END); grid = -1; return; }
        int dev = 0, cus = 0, per_cu = 0;
        if (hipGetDevice(&dev) != hipSuccess || hipDeviceGetAttribute(&cus, hipDeviceAttributeMultiprocessorCount, dev) != hipSuccess) { fprintf(stderr, "kernel_launch: device query failed\n"); grid = -1; return; }
        if (hipFuncSetAttribute((const void*)fwd_kernel, hipFuncAttributeMaxDynamicSharedMemorySize, LDS_BYTES) != hipSuccess) { fprintf(stderr, "kernel_launch: hipFuncSetAttribute failed\n"); grid = -1; return; }
        if (hipOccupancyMaxActiveBlocksPerMultiprocessor(&per_cu, (const void*)fwd_kernel, NTHREADS, LDS_BYTES) != hipSuccess || per_cu < 1)
            fprintf(stderr, "kernel_launch: note: occupancy query reports %d workgroups per CU\n", per_cu);
        (void)hipGetLastError();
        grid = cus;
    }
    if (grid < 0) return;
    if (hipMemsetAsync((char*)d_ws + WS_CTL, 0, CTL_ZERO_BYTES, stream) != hipSuccess) { fprintf(stderr, "kernel_launch: memset failed\n"); return; }
    Args a{};
    for (int i = 0; i < 25; ++i) a.in[i] = (const float*)d_in[i];
    a.out = (float*)d_out; a.ws = (unsigned char*)d_ws;
#if MK_PER_PHASE
#ifndef DBG_LAST
#define DBG_LAST (NPHASES - 1)
#endif
    for (int p = 0; p <= DBG_LAST; ++p) { a.ph_lo = p; a.ph_hi = p + 1; hipLaunchKernelGGL(fwd_kernel, dim3(grid), dim3(NTHREADS), LDS_BYTES, stream, a); }
#ifdef DBG_OUT
    hipMemcpyAsync(d_out, (char*)d_ws + DBG_OUT, (size_t)NTOK * DM * 4, hipMemcpyDeviceToDevice, stream);
#endif
#ifdef DBG_VALID
    hipLaunchKernelGGL(dbg_valid_kernel, dim3(2048), dim3(256), 0, stream, (const unsigned*)((char*)d_ws + DBG_VALID), DBG_VALID_WORDS, (const unsigned*)d_ws + CW_GCNT + 64 * DBG_VALID_LAYER, (unsigned*)d_out, (size_t)NTOK * DM);
#endif
#ifdef DBG_CMP
    a.alt = 1; a.ph_lo = DBG_LAST; a.ph_hi = DBG_LAST + 1; hipLaunchKernelGGL(fwd_kernel, dim3(grid), dim3(NTHREADS), LDS_BYTES, stream, a); a.alt = 0;
    hipLaunchKernelGGL(dbg_cmp_kernel, dim3(1024), dim3(256), 0, stream, (const unsigned*)((char*)d_ws + WS_ACT), (const unsigned*)((char*)d_ws + (size_t)3400 * MiB), (const unsigned*)d_ws + CW_GCNT + 64, (float*)d_out, (size_t)NTOK * DM);
#endif
#else
    a.ph_lo = 0; a.ph_hi = NPHASES;
    hipLaunchKernelGGL(fwd_kernel, dim3(grid), dim3(NTHREADS), LDS_BYTES, stream, a);
#ifdef PROBE_EXTRA
    { const int plist[] = {PROBE_EXTRA}; for (int r = 0; r < PROBE_REPS; ++r) for (int p : plist) { if (p == 14) hipMemsetAsync((char*)d_ws + WS_CTL + CW_AQ * 4, 0, 4, stream); a.ph_lo = p; a.ph_hi = p + 1; hipLaunchKernelGGL(fwd_kernel, dim3(grid), dim3(NTHREADS), LDS_BYTES, stream, a); } }
#endif
#endif
    const hipError_t le = hipPeekAtLastError();
    if (le != hipSuccess) fprintf(stderr, "kernel_launch: launch failed: %s\n", hipGetErrorName(le));
}
```
